# Optimizing an MI355X kernel written in HIP

```python
import jax, jax.numpy as jnp
from jax import lax
import numpy as np

D_MODEL = 1024
BATCH = 2
SEQ = 8192
DEPTH = 1

CHUNK = 64
N_META = 16
Q_BLOCK = 128
SB_HEADS = 8
SB_HEAD_DIM = 64
SB_WIDTH = SB_HEADS * SB_HEAD_DIM
SB_SCALE = SB_HEAD_DIM ** -0.5
HG_HEADS = 4
HG_KEY_DIM = 128
HG_VAL_DIM = 128
HG_KEY_WIDTH = HG_HEADS * HG_KEY_DIM
HG_VAL_WIDTH = HG_HEADS * HG_VAL_DIM
HG_SCALE = HG_KEY_DIM ** -0.5
N_BRANCH = 2
SPLIT_SIZES = (SB_WIDTH, SB_WIDTH, SB_WIDTH, SB_WIDTH,
               HG_KEY_WIDTH, HG_KEY_WIDTH, HG_VAL_WIDTH, HG_VAL_WIDTH,
               D_MODEL, D_MODEL)
IN_COLS = sum(SPLIT_SIZES)
EPS = 1e-6

kernel_name = "hybrid_stickbreak_hgrn2_block"


def _rmsnorm(x, g):
    xf = x.astype(jnp.float32)
    y = xf * lax.rsqrt(jnp.mean(xf * xf, axis=-1, keepdims=True) + EPS)
    return (y * g.astype(jnp.float32)).astype(x.dtype)


def _group_rmsnorm(o, g):
    B, L, _ = o.shape
    oh = o.reshape(B, L, HG_HEADS, HG_VAL_DIM)
    oh = oh * lax.rsqrt(jnp.mean(oh * oh, axis=-1, keepdims=True) + EPS)
    return oh.reshape(B, L, HG_VAL_WIDTH) * g.astype(jnp.float32)


def _stick_breaking(q, k, v):
    B, L, _ = q.shape

    def heads(a):
        return a.astype(jnp.float32).reshape(B, L, SB_HEADS, SB_HEAD_DIM).transpose(0, 2, 1, 3)

    q, k, v = heads(q) * SB_SCALE, heads(k), heads(v)
    nb = L // Q_BLOCK
    q_blocks = q.reshape(B, SB_HEADS, nb, Q_BLOCK, SB_HEAD_DIM).transpose(2, 0, 1, 3, 4)
    starts = jnp.arange(nb, dtype=jnp.int32) * Q_BLOCK
    s_idx = jnp.arange(L, dtype=jnp.int32)

    def block(args):
        qb, t0 = args
        z = jnp.einsum('bhtd,bhsd->bhts', qb, k)
        t_idx = t0 + jnp.arange(Q_BLOCK, dtype=jnp.int32)
        valid = s_idx[None, :] < t_idx[:, None]
        log_beta = jax.nn.log_sigmoid(z)
        log_1mb = jnp.where(valid, jax.nn.log_sigmoid(-z), 0.0)
        later = lax.cumsum(log_1mb, axis=3, reverse=True) - log_1mb
        weights = jnp.where(valid, jnp.exp(log_beta + later), 0.0)
        return jnp.einsum('bhts,bhsd->bhtd', weights, v)

    out = lax.map(block, (q_blocks, starts))
    return out.transpose(1, 0, 3, 2, 4).reshape(B, L, SB_WIDTH)


def _hgrn2(q, f_logit, i, lb):
    B, L, _ = q.shape
    n = L // CHUNK
    f = lb + (1.0 - lb) * jax.nn.sigmoid(f_logit.astype(jnp.float32))
    kk = 1.0 - f
    g = jnp.log(f)
    qf = jax.nn.silu(q.astype(jnp.float32)) * HG_SCALE

    def chunks(a, dh):
        return a.reshape(B, n, CHUNK, HG_HEADS, dh).transpose(1, 0, 3, 2, 4)

    xs = (chunks(qf, HG_KEY_DIM), chunks(kk, HG_KEY_DIM),
          chunks(i.astype(jnp.float32), HG_VAL_DIM), chunks(g, HG_KEY_DIM))
    pos = jnp.arange(CHUNK)
    causal = pos[:, None] >= pos[None, :]

    def step(S, c):
        qc, kc, vc, gc = c
        b = jnp.cumsum(gc, axis=2)
        diff = b[:, :, :, None, :] - b[:, :, None, :, :]
        decay = jnp.exp(jnp.where(causal[:, :, None], diff, -jnp.inf))
        A = jnp.einsum('bhtk,bhtsk,bhsk->bhts', qc, decay, kc)
        o = (jnp.einsum('bhts,bhsv->bhtv', A, vc)
             + jnp.einsum('bhtk,bhkv->bhtv', qc * jnp.exp(b), S))
        b_last = b[:, :, -1:, :]
        S = (jnp.exp(b_last[:, :, 0, :])[..., None] * S
             + jnp.einsum('bhsk,bhsv->bhkv', kc * jnp.exp(b_last - b), vc))
        return S, o

    S0 = jnp.zeros((B, HG_HEADS, HG_KEY_DIM, HG_VAL_DIM), jnp.float32)
    _, o = lax.scan(step, S0, xs)
    return o.transpose(1, 0, 3, 2, 4).reshape(B, L, HG_VAL_WIDTH)


def setup_inputs(seed: int = 0) -> dict:
    key = jax.random.key(seed)
    ks = jax.random.split(key, 10)
    f32 = jnp.float32
    x = jax.random.normal(ks[0], (BATCH, SEQ, D_MODEL), f32)
    meta = jax.random.normal(ks[1], (N_META, D_MODEL), f32)
    norm_g = 1.0 + 0.02 * jax.random.normal(ks[2], (DEPTH, D_MODEL), f32)
    w_in = jax.random.normal(ks[3], (DEPTH, D_MODEL, IN_COLS), f32) * D_MODEL ** -0.5
    w_sb_out = jax.random.normal(ks[4], (DEPTH, SB_WIDTH, D_MODEL), f32) * SB_WIDTH ** -0.5
    w_hg_out = jax.random.normal(ks[5], (DEPTH, HG_VAL_WIDTH, D_MODEL), f32) * HG_VAL_WIDTH ** -0.5
    w_out = jax.random.normal(ks[6], (DEPTH, D_MODEL, D_MODEL), f32) * D_MODEL ** -0.5
    hg_norm_g = 1.0 + 0.02 * jax.random.normal(ks[7], (DEPTH, HG_VAL_WIDTH), f32)
    hg_lb_logits = 0.1 * jax.random.normal(ks[8], (DEPTH + 1, HG_KEY_WIDTH), f32)
    final_norm_g = 1.0 + 0.02 * jax.random.normal(ks[9], (D_MODEL,), f32)
    return {"x": x, "meta": meta, "norm_g": norm_g, "w_in": w_in, "w_sb_out": w_sb_out,
            "w_hg_out": w_hg_out, "w_out": w_out, "hg_norm_g": hg_norm_g,
            "hg_lb_logits": hg_lb_logits, "final_norm_g": final_norm_g}


def reference(x, meta, norm_g, w_in, w_sb_out, w_hg_out, w_out, hg_norm_g, hg_lb_logits, final_norm_g):
    B, S, D = x.shape
    dtype = x.dtype
    L = N_META + S
    Lp = ((L + Q_BLOCK - 1) // Q_BLOCK) * Q_BLOCK
    h = jnp.concatenate([jnp.broadcast_to(meta.astype(dtype)[None], (B, N_META, D)), x], axis=1)
    h = jnp.pad(h, ((0, 0), (0, Lp - L), (0, 0)))

    lb_all = jnp.cumsum(jax.nn.softmax(hg_lb_logits.astype(jnp.float32), axis=0), axis=0)
    bounds = np.cumsum(SPLIT_SIZES)[:-1].tolist()

    for l in range(DEPTH):
        u = _rmsnorm(h, norm_g[l])
        proj = u @ w_in[l]
        (sb_q, sb_k, sb_v, sb_gate, hg_q, hg_f, hg_i, hg_gate,
         gate_sb, gate_hg) = jnp.split(proj, bounds, axis=-1)

        y_sb = (_stick_breaking(sb_q, sb_k, sb_v) * jax.nn.silu(sb_gate.astype(jnp.float32))).astype(dtype)
        o_hg = _group_rmsnorm(_hgrn2(hg_q, hg_f, hg_i, lb_all[l]), hg_norm_g[l])
        y_hg = (o_hg * jax.nn.silu(hg_gate.astype(jnp.float32))).astype(dtype)

        merged = (jax.nn.sigmoid(gate_sb) * (y_sb @ w_sb_out[l])
                  + jax.nn.sigmoid(gate_hg) * (y_hg @ w_hg_out[l]))
        h = h + merged @ w_out[l]

    return _rmsnorm(h, final_norm_g)[:, N_META:N_META + S]
```

```cpp
#include <hip/hip_runtime.h>
#include <hip/hip_cooperative_groups.h>
#include <cstdio>
#include <cstdint>
namespace cg = cooperative_groups;
#ifndef DBG_SKIP
#define DBG_SKIP 0
#endif
namespace pg8 {
#define PG8_LAS __attribute__((address_space(3)))
typedef unsigned short bf16_t;
typedef short bf16x8 __attribute__((ext_vector_type(8)));
typedef float f32x4 __attribute__((ext_vector_type(4)));
typedef unsigned u32x4 __attribute__((ext_vector_type(4)));
constexpr int BM = 256, BK = 64, HALF = 128, HTB = HALF * BK * 2  , STAGE_BYTES = 8 * HTB, NXCD = 8, WGM = 8;

__host__ __device__ __forceinline__ int lds_byte(int r, int c) { const int st = (r >> 4) * 2 + (c >> 5), rr = r & 15, cc = c & 31, ob = rr * 64 + cc * 2; return st * 1024 + (ob ^ (((ob >> 9) & 1) << 5)); }
__host__ __device__ __forceinline__ void stage_rc(int b, int& R, int& C) { const int st = b / 1024, sb = b % 1024, swz = sb ^ (((sb >> 9) & 1) << 5); R = (st >> 1) * 16 + swz / 64; C = (st & 1) * 32 + (swz % 64) / 2; }
__host__ __device__ __forceinline__ int perm32(int rho) { const int n = rho >> 4, i = rho & 15; return 8 * (i >> 2) + 4 * n + (i & 3); }

struct Unit { int pm, pn; };
struct Gemm { const bf16_t* A; const bf16_t* Bt; int M, N, K; };

struct StaticOrder {
    int nM, nN, nwg, G, c;
    __host__ __device__ void init(int M, int N, int G_, int c_) { nM = M / BM; nN = N / BM; nwg = nM * nN; G = G_; c = c_; }
    __host__ __device__ bool next(int i, Unit& u) const {
        const long L = (long)i * G + c; if (L >= nwg) return false;
        int wgid = (int)L; { const int q = nwg / NXCD, r = nwg % NXCD, xcd = wgid % NXCD, off = wgid / NXCD; wgid = (xcd < r ? xcd * (q + 1) : r * (q + 1) + (xcd - r) * q) + off; }
        const int nig = WGM * nN, gid = wgid / nig, fm = gid * WGM, gsz = (nM - fm) < WGM ? (nM - fm) : WGM;
        u.pm = fm + ((wgid % nig) % gsz); u.pn = (wgid % nig) / gsz; if (DBG_SKIP & 65536) u.pn = nN - 1 - u.pn; return true;
    }
    __device__ __forceinline__ void a_ready(const Unit&) const {}
    __device__ __forceinline__ void done(const Unit&) const {}
};

__device__ __forceinline__ unsigned cvt_pk_bf16(float lo, float hi) { unsigned r; asm volatile("v_cvt_pk_bf16_f32 %0, %1, %2" : "=v"(r) : "v"(lo), "v"(hi)); return r; }
typedef float f32x2 __attribute__((ext_vector_type(2)));
template <class Epi, class Sched, bool ALIGN_EPI = false, bool SP2 = false>
__device__ __forceinline__ void gemm_phase(PG8_LAS unsigned char* lds, const Gemm g, const Sched& S, const Epi& E) {
    const int tid = threadIdx.x, wid = __builtin_amdgcn_readfirstlane(tid >> 6), lane = tid & 63, wr = wid >> 2, wc = wid & 3, fr = lane & 15, fq = lane >> 4;
    const int K = g.K, nt = K / BK;
    unsigned voffA[2], voffB[2];
#pragma unroll
    for (int i = 0; i < 2; ++i) { int R, C; stage_rc(tid * 16 + i * 8192, R, C); const int Rb = Epi::PERM ? ((R & ~31) + perm32(R & 31)) : R;
        voffA[i] = (unsigned)(R * K + C) * 2u; voffB[i] = (unsigned)(Rb * K + C) * 2u; }
    const size_t kstep = (size_t)(BK * 2);
    const size_t hstep = (size_t)HALF * K * 2;
    const size_t tstep = 2 * hstep;
    const unsigned ldsw = (unsigned)wid * 1024u;
    const int aoff = lds_byte(wr * 64 + fr, fq * 8), boff = lds_byte(wc * 32 + fr, fq * 8);
#define PG8_SA(b, h) (((b) * 2 + (h)) * HTB)
#define PG8_SB(b, h) ((4 + (b) * 2 + (h)) * HTB)
#define PG8_STAGE(bufoff, gbase, voff) do { _Pragma("unroll") for (int _i = 0; _i < 2; ++_i) \
        __builtin_amdgcn_global_load_lds((const unsigned*)((const char*)(gbase) + (voff)[_i]), (PG8_LAS unsigned*)(lds + (bufoff) + ldsw + _i * 8192), 16, 0, 0); } while (0)
#define PG8_LDA(dst, b, h) do { _Pragma("unroll") for (int m = 0; m < 4; ++m) _Pragma("unroll") for (int k = 0; k < 2; ++k) dst[m][k] = *(const PG8_LAS bf16x8*)(lds + PG8_SA(b, h) + aoff + m * 2048 + k * 1024); } while (0)
#define PG8_LDB(dst, b, h) do { _Pragma("unroll") for (int n = 0; n < 2; ++n) _Pragma("unroll") for (int k = 0; k < 2; ++k) dst[n][k] = *(const PG8_LAS bf16x8*)(lds + PG8_SB(b, h) + boff + n * 2048 + k * 1024); } while (0)
#define PG8_MMA(ai, bj, At, Bt) do { __builtin_amdgcn_s_setprio(1); _Pragma("unroll") for (int m = 0; m < 4; ++m) _Pragma("unroll") for (int n = 0; n < 2; ++n) _Pragma("unroll") for (int k = 0; k < 2; ++k) \
        acc[ai][bj][m][n] = __builtin_amdgcn_mfma_f32_16x16x32_bf16(Bt[n][k], At[m][k], acc[ai][bj][m][n], 0, 0, 0); __builtin_amdgcn_s_setprio(0); } while (0)
#define PG8_WAIT_V(n) asm volatile("s_waitcnt vmcnt(" #n ")" ::: "memory")
#define PG8_WAIT_L(n) asm volatile("s_waitcnt lgkmcnt(" #n ")" ::: "memory")
#define PG8_BAR __builtin_amdgcn_s_barrier()
#define PG8_SCHED __builtin_amdgcn_sched_barrier(0)
    Unit cur, nxt; int ui = 0;
    if (!S.next(0, cur)) return;
    f32x4 acc[2][2][4][2];
#pragma unroll
    for (int a = 0; a < 2; ++a)
#pragma unroll
        for (int b = 0; b < 2; ++b)
#pragma unroll
            for (int m = 0; m < 4; ++m)
#pragma unroll
                for (int n = 0; n < 2; ++n) acc[a][b][m][n] = (f32x4){0.f, 0.f, 0.f, 0.f};
    bf16x8 At[4][2], B0[2][2], B1[2][2];
    const char* cA = (const char*)g.A + (size_t)cur.pm * tstep; const char* cB = (const char*)g.Bt + (size_t)cur.pn * tstep;
    S.a_ready(cur);
    if constexpr (SP2) {
        PG8_STAGE(PG8_SB(0, 0), cB, voffB); PG8_STAGE(PG8_SB(0, 1), cB + hstep, voffB); PG8_STAGE(PG8_SA(0, 0), cA, voffA); PG8_STAGE(PG8_SA(0, 1), cA + hstep, voffA);
        if (wr == 1) PG8_BAR;
        PG8_WAIT_V(2); PG8_BAR;
        PG8_STAGE(PG8_SB(1, 0), cB + kstep, voffB); PG8_STAGE(PG8_SA(1, 0), cA + kstep, voffA); PG8_STAGE(PG8_SB(1, 1), cB + hstep + kstep, voffB);
        PG8_WAIT_V(6); PG8_BAR;
    } else {
        PG8_STAGE(PG8_SB(0, 0), cB, voffB); PG8_STAGE(PG8_SA(0, 0), cA, voffA); PG8_STAGE(PG8_SB(0, 1), cB + hstep, voffB); PG8_STAGE(PG8_SA(0, 1), cA + hstep, voffA);
        if (wr == 1) PG8_BAR;
        PG8_WAIT_V(4); PG8_BAR;
        PG8_STAGE(PG8_SB(1, 0), cB + kstep, voffB); PG8_STAGE(PG8_SA(1, 0), cA + kstep, voffA); PG8_STAGE(PG8_SB(1, 1), cB + hstep + kstep, voffB);
        PG8_WAIT_V(6); PG8_BAR;
    }
    for (;;) {
        const bool has_next = S.next(ui + 1, nxt);
        const char* nA = has_next ? (const char*)g.A + (size_t)nxt.pm * tstep : cA; const char* nB = has_next ? (const char*)g.Bt + (size_t)nxt.pn * tstep : cB;
        for (int half_ = 0; half_ < (Epi::HAS_MID ? 2 : 1); ++half_) {
        if constexpr (Epi::HAS_MID) { if (half_ == 1) { E.mid(acc, cur, wr, wc, fr, fq); asm volatile("" ::: "memory"); } }
        for (int t = Epi::HAS_MID ? half_ * (nt >> 1) : 0; t < (Epi::HAS_MID ? (half_ + 1) * (nt >> 1) : nt); t += 2) {
            const bool last = (t == nt - 2);
            const char* a1 = cA + (size_t)(t + 1) * kstep;
            const char* a2 = last ? nA : cA + (size_t)(t + 2) * kstep; const char* b2 = last ? nB : cB + (size_t)(t + 2) * kstep;
            const char* a3 = a2 + kstep; const char* b3 = b2 + kstep;
            if (last && has_next) S.a_ready(nxt);
            if constexpr (SP2) {
            PG8_LDB(B0, 0, 0); PG8_LDB(B1, 0, 1); PG8_SCHED; PG8_LDA(At, 0, 0); PG8_STAGE(PG8_SA(1, 1), a1 + hstep, voffA);
            PG8_WAIT_V(8); PG8_WAIT_L(0); PG8_BAR; PG8_MMA(0, 0, At, B0); PG8_MMA(0, 1, At, B1); PG8_BAR; PG8_SCHED;
            PG8_LDA(At, 0, 1); PG8_STAGE(PG8_SB(0, 0), b2, voffB); PG8_STAGE(PG8_SB(0, 1), b2 + hstep, voffB); PG8_STAGE(PG8_SA(0, 0), a2, voffA);
            PG8_WAIT_V(8); PG8_WAIT_L(0); PG8_BAR; PG8_MMA(1, 0, At, B0); PG8_MMA(1, 1, At, B1); PG8_BAR; PG8_SCHED;
            PG8_LDB(B0, 1, 0); PG8_LDB(B1, 1, 1); PG8_SCHED; PG8_LDA(At, 1, 0); PG8_STAGE(PG8_SA(0, 1), a2 + hstep, voffA);
            PG8_WAIT_V(8); PG8_WAIT_L(0); PG8_BAR; PG8_MMA(0, 0, At, B0); PG8_MMA(0, 1, At, B1); PG8_BAR; PG8_SCHED;
            PG8_LDA(At, 1, 1); PG8_STAGE(PG8_SB(1, 0), b3, voffB); PG8_STAGE(PG8_SB(1, 1), b3 + hstep, voffB); PG8_STAGE(PG8_SA(1, 0), a3, voffA);
            PG8_WAIT_V(8); PG8_WAIT_L(0); PG8_BAR; PG8_MMA(1, 0, At, B0); PG8_MMA(1, 1, At, B1); PG8_BAR; PG8_SCHED;
            } else {
            PG8_LDB(B0, 0, 0); PG8_SCHED; PG8_LDA(At, 0, 0); PG8_STAGE(PG8_SA(1, 1), a1 + hstep, voffA);
            PG8_WAIT_L(8); PG8_BAR; PG8_WAIT_L(0); PG8_MMA(0, 0, At, B0); PG8_BAR; PG8_SCHED;
            PG8_LDB(B1, 0, 1); PG8_STAGE(PG8_SB(0, 0), b2, voffB);
            PG8_BAR; PG8_WAIT_L(0); PG8_MMA(0, 1, At, B1); PG8_BAR;
            PG8_LDA(At, 0, 1); PG8_STAGE(PG8_SA(0, 0), a2, voffA);
            PG8_BAR; PG8_WAIT_L(0); PG8_MMA(1, 0, At, B0); PG8_BAR; PG8_SCHED;
            PG8_STAGE(PG8_SB(0, 1), b2 + hstep, voffB);
            PG8_WAIT_V(6); PG8_BAR; PG8_MMA(1, 1, At, B1); PG8_BAR;
            PG8_LDB(B0, 1, 0); PG8_SCHED; PG8_LDA(At, 1, 0); PG8_STAGE(PG8_SA(0, 1), a2 + hstep, voffA);
            PG8_WAIT_L(8); PG8_BAR; PG8_WAIT_L(0); PG8_MMA(0, 0, At, B0); PG8_BAR; PG8_SCHED;
            PG8_LDB(B1, 1, 1); PG8_STAGE(PG8_SB(1, 0), b3, voffB);
            PG8_BAR; PG8_WAIT_L(0); PG8_MMA(0, 1, At, B1); PG8_BAR;
            PG8_LDA(At, 1, 1); PG8_STAGE(PG8_SA(1, 0), a3, voffA);
            PG8_BAR; PG8_WAIT_L(0); PG8_MMA(1, 0, At, B0); PG8_BAR; PG8_SCHED;
            PG8_STAGE(PG8_SB(1, 1), b3 + hstep, voffB);
            PG8_WAIT_V(6); PG8_BAR; PG8_MMA(1, 1, At, B1); PG8_BAR;
            }
        }
        }
        if constexpr (ALIGN_EPI) { if (wr == 0) PG8_BAR; }
        if constexpr (!Epi::AFTER_DRAIN) { E(acc, cur, wr, wc, fr, fq); S.done(cur); }
        if (!has_next) break;
#pragma unroll
        for (int a = 0; a < 2; ++a)
#pragma unroll
            for (int b = 0; b < 2; ++b)
#pragma unroll
                for (int m = 0; m < 4; ++m)
#pragma unroll
                    for (int n = 0; n < 2; ++n) acc[a][b][m][n] = (f32x4){0.f, 0.f, 0.f, 0.f};
        cur = nxt; cA = nA; cB = nB; ++ui;
        if constexpr (ALIGN_EPI) { if (wr == 1) PG8_BAR; }
    }
    PG8_WAIT_V(0);
    if constexpr (!ALIGN_EPI) { if (wr == 0) PG8_BAR; }
    PG8_BAR;
    if constexpr (Epi::AFTER_DRAIN) { E.fused(acc, cur, wr, wc, fr, fq, lds, wid, lane); S.done(cur); }
#undef PG8_SA
#undef PG8_SB
#undef PG8_STAGE
#undef PG8_LDA
#undef PG8_LDB
#undef PG8_MMA
#undef PG8_WAIT_V
#undef PG8_WAIT_L
#undef PG8_BAR
#undef PG8_SCHED
}
template <class Epi, class Sched>
__device__ __forceinline__ void gemm_phase2(PG8_LAS unsigned char* lds, const Gemm g, const Sched& S, const Epi& E) {
    const int tid = threadIdx.x, wid = __builtin_amdgcn_readfirstlane(tid >> 6), lane = tid & 63, wr = wid >> 2, wc = wid & 3, fr = lane & 15, fq = lane >> 4;
    const int K = g.K, nt = K / BK;
    unsigned voffA[2], voffB[2];
#pragma unroll
    for (int i = 0; i < 2; ++i) { int R, C; stage_rc(tid * 16 + i * 8192, R, C); const int Rb = Epi::PERM ? ((R & ~31) + perm32(R & 31)) : R;
        voffA[i] = (unsigned)(R * K + C) * 2u; voffB[i] = (unsigned)(Rb * K + C) * 2u; }
    const size_t kstep = (size_t)(BK * 2), hstep = (size_t)HALF * K * 2, tstep = 2 * hstep;
    const unsigned ldsw = (unsigned)wid * 1024u;
    const int aoff = lds_byte(wr * 64 + fr, fq * 8), boff = lds_byte(wc * 32 + fr, fq * 8);
#define G2_SA(b, h) (((b) * 2 + (h)) * HTB)
#define G2_SB(b, h) ((4 + (b) * 2 + (h)) * HTB)
#define G2_STAGE(bufoff, gbase, voff) do { _Pragma("unroll") for (int _i = 0; _i < 2; ++_i) \
        __builtin_amdgcn_global_load_lds((const unsigned*)((const char*)(gbase) + (voff)[_i]), (PG8_LAS unsigned*)(lds + (bufoff) + ldsw + _i * 8192), 16, 0, 0); } while (0)
#define G2_STAGE4(b, pa, pb) do { G2_STAGE(G2_SB(b, 0), (pb), voffB); G2_STAGE(G2_SB(b, 1), (pb) + hstep, voffB); G2_STAGE(G2_SA(b, 0), (pa), voffA); G2_STAGE(G2_SA(b, 1), (pa) + hstep, voffA); } while (0)
#define G2_LDA(dst, b, h) do { _Pragma("unroll") for (int m = 0; m < 4; ++m) _Pragma("unroll") for (int k = 0; k < 2; ++k) dst[m][k] = *(const PG8_LAS bf16x8*)(lds + G2_SA(b, h) + aoff + m * 2048 + k * 1024); } while (0)
#define G2_LDB(dst, b, h) do { _Pragma("unroll") for (int n = 0; n < 2; ++n) _Pragma("unroll") for (int k = 0; k < 2; ++k) dst[n][k] = *(const PG8_LAS bf16x8*)(lds + G2_SB(b, h) + boff + n * 2048 + k * 1024); } while (0)
#define G2_MMA(ai, bj, At, Bt) do { _Pragma("unroll") for (int m = 0; m < 4; ++m) _Pragma("unroll") for (int n = 0; n < 2; ++n) _Pragma("unroll") for (int k = 0; k < 2; ++k) \
        acc[ai][bj][m][n] = __builtin_amdgcn_mfma_f32_16x16x32_bf16(Bt[n][k], At[m][k], acc[ai][bj][m][n], 0, 0, 0); } while (0)
#define G2_COMPUTE(b) do { G2_LDB(B0, b, 0); G2_LDB(B1, b, 1); G2_LDA(At, b, 0); __builtin_amdgcn_s_setprio(1); G2_MMA(0, 0, At, B0); G2_MMA(0, 1, At, B1); G2_LDA(At, b, 1); G2_MMA(1, 0, At, B0); G2_MMA(1, 1, At, B1); __builtin_amdgcn_s_setprio(0); } while (0)
#define G2_SYNC() do { asm volatile("s_waitcnt vmcnt(0) lgkmcnt(0)" ::: "memory"); __builtin_amdgcn_s_barrier(); __builtin_amdgcn_s_sleep(8); __builtin_amdgcn_s_barrier(); asm volatile("" ::: "memory"); } while (0)
    Unit cur, nxt; int ui = 0;
    if (!S.next(0, cur)) return;
    f32x4 acc[2][2][4][2];
#pragma unroll
    for (int a = 0; a < 2; ++a)
#pragma unroll
        for (int b = 0; b < 2; ++b)
#pragma unroll
            for (int m = 0; m < 4; ++m)
#pragma unroll
                for (int n = 0; n < 2; ++n) acc[a][b][m][n] = (f32x4){0.f, 0.f, 0.f, 0.f};
    bf16x8 At[4][2], B0[2][2], B1[2][2];
    const char* cA = (const char*)g.A + (size_t)cur.pm * tstep; const char* cB = (const char*)g.Bt + (size_t)cur.pn * tstep;
    G2_SYNC();
    G2_STAGE4(0, cA, cB);
    G2_SYNC();
    for (;;) {
        const bool has_next = S.next(ui + 1, nxt);
        const char* nA = has_next ? (const char*)g.A + (size_t)nxt.pm * tstep : cA; const char* nB = has_next ? (const char*)g.Bt + (size_t)nxt.pn * tstep : cB;
        for (int t = 0; t < nt; t += 2) {
            const bool last = (t == nt - 2);
            { const char* a1 = cA + (size_t)(t + 1) * kstep; const char* b1 = cB + (size_t)(t + 1) * kstep; G2_STAGE4(1, a1, b1); }
            G2_COMPUTE(0);
            G2_SYNC();
            if (!last || has_next) { const char* a2 = last ? nA : cA + (size_t)(t + 2) * kstep; const char* b2 = last ? nB : cB + (size_t)(t + 2) * kstep; G2_STAGE4(0, a2, b2); }
            G2_COMPUTE(1);
            G2_SYNC();
        }
        E(acc, cur, wr, wc, fr, fq);
        if (!has_next) break;
#pragma unroll
        for (int a = 0; a < 2; ++a)
#pragma unroll
            for (int b = 0; b < 2; ++b)
#pragma unroll
                for (int m = 0; m < 4; ++m)
#pragma unroll
                    for (int n = 0; n < 2; ++n) acc[a][b][m][n] = (f32x4){0.f, 0.f, 0.f, 0.f};
        cur = nxt; cA = nA; cB = nB; ++ui;
    }
    asm volatile("s_waitcnt vmcnt(0)" ::: "memory");
#undef G2_SA
#undef G2_SB
#undef G2_STAGE
#undef G2_STAGE4
#undef G2_LDA
#undef G2_LDB
#undef G2_MMA
#undef G2_COMPUTE
#undef G2_SYNC
}
template <class Epi, class Sched>
__device__ __forceinline__ void gemm_phase3(PG8_LAS unsigned char* lds, const Gemm g, const Sched& S, const Epi& E) {
    typedef int i32x4 __attribute__((ext_vector_type(4)));
    const int tid = threadIdx.x, wid = __builtin_amdgcn_readfirstlane(tid >> 6), lane = tid & 63, wr = wid >> 2, wc = wid & 3, fr = lane & 15, fq = lane >> 4;
    const int K = g.K, nt = K / BK;
    unsigned voffA[2], voffB[2];
#pragma unroll
    for (int i = 0; i < 2; ++i) { int R, C; stage_rc(tid * 16 + i * 8192, R, C); const int Rb = Epi::PERM ? ((R & ~31) + perm32(R & 31)) : R;
        voffA[i] = (unsigned)(R * K + C) * 2u; voffB[i] = (unsigned)(Rb * K + C) * 2u; }
    const size_t kstep = (size_t)(BK * 2), hstep = (size_t)HALF * K * 2, tstep = 2 * hstep;
    const int aoff = lds_byte(wr * 64 + fr, fq * 8), boff = lds_byte(wc * 32 + fr, fq * 8);
#define G3_SA(b, h) (((b) * 2 + (h)) * HTB)
#define G3_SB(b, h) ((4 + (b) * 2 + (h)) * HTB)
#define G3_ISSUE(pa, pb) do { _Pragma("unroll") for (int h = 0; h < 2; ++h) _Pragma("unroll") for (int i = 0; i < 2; ++i) { \
        sa[h * 2 + i] = *(const i32x4*)((pa) + h * hstep + voffA[i]); sb[h * 2 + i] = *(const i32x4*)((pb) + h * hstep + voffB[i]); } } while (0)
#define G3_WRITE(b) do { _Pragma("unroll") for (int h = 0; h < 2; ++h) _Pragma("unroll") for (int i = 0; i < 2; ++i) { \
        *(PG8_LAS i32x4*)(lds + G3_SA(b, h) + tid * 16 + i * 8192) = sa[h * 2 + i]; *(PG8_LAS i32x4*)(lds + G3_SB(b, h) + tid * 16 + i * 8192) = sb[h * 2 + i]; } } while (0)
#define G3_LDA(dst, b, h) do { _Pragma("unroll") for (int m = 0; m < 4; ++m) _Pragma("unroll") for (int k = 0; k < 2; ++k) dst[m][k] = *(const PG8_LAS bf16x8*)(lds + G3_SA(b, h) + aoff + m * 2048 + k * 1024); } while (0)
#define G3_LDB(dst, b, h) do { _Pragma("unroll") for (int n = 0; n < 2; ++n) _Pragma("unroll") for (int k = 0; k < 2; ++k) dst[n][k] = *(const PG8_LAS bf16x8*)(lds + G3_SB(b, h) + boff + n * 2048 + k * 1024); } while (0)
#define G3_MMA(ai, bj, At, Bt) do { _Pragma("unroll") for (int m = 0; m < 4; ++m) _Pragma("unroll") for (int n = 0; n < 2; ++n) _Pragma("unroll") for (int k = 0; k < 2; ++k) \
        acc[ai][bj][m][n] = __builtin_amdgcn_mfma_f32_16x16x32_bf16(Bt[n][k], At[m][k], acc[ai][bj][m][n], 0, 0, 0); } while (0)
#define G3_COMPUTE(b) do { bf16x8 At[4][2], B0[2][2], B1[2][2]; G3_LDB(B0, b, 0); G3_LDB(B1, b, 1); G3_LDA(At, b, 0); G3_MMA(0, 0, At, B0); G3_MMA(0, 1, At, B1); G3_LDA(At, b, 1); G3_MMA(1, 0, At, B0); G3_MMA(1, 1, At, B1); } while (0)
    Unit cur, nxt; int ui = 0;
    if (!S.next(0, cur)) return;
    f32x4 acc[2][2][4][2];
#pragma unroll
    for (int a = 0; a < 2; ++a)
#pragma unroll
        for (int b = 0; b < 2; ++b)
#pragma unroll
            for (int m = 0; m < 4; ++m)
#pragma unroll
                for (int n = 0; n < 2; ++n) acc[a][b][m][n] = (f32x4){0.f, 0.f, 0.f, 0.f};
    i32x4 sa[4], sb[4];
    const char* cA = (const char*)g.A + (size_t)cur.pm * tstep; const char* cB = (const char*)g.Bt + (size_t)cur.pn * tstep;
    __syncthreads();
    G3_ISSUE(cA, cB); G3_WRITE(0); G3_ISSUE(cA + kstep, cB + kstep);
    __syncthreads();
    for (;;) {
        const bool has_next = S.next(ui + 1, nxt);
        const char* nA = has_next ? (const char*)g.A + (size_t)nxt.pm * tstep : cA; const char* nB = has_next ? (const char*)g.Bt + (size_t)nxt.pn * tstep : cB;
        for (int t = 0; t < nt; t += 2) {
            const bool last = (t == nt - 2);
            G3_WRITE(1);
            if (!last || has_next) { const char* a2 = last ? nA : cA + (size_t)(t + 2) * kstep; const char* b2 = last ? nB : cB + (size_t)(t + 2) * kstep; G3_ISSUE(a2, b2); }
            G3_COMPUTE(0);
            __syncthreads();
            if (!last || has_next) { G3_WRITE(0);
                const char* a3 = last ? nA + kstep : cA + (size_t)(t + 3) * kstep; const char* b3 = last ? nB + kstep : cB + (size_t)(t + 3) * kstep; G3_ISSUE(a3, b3); }
            G3_COMPUTE(1);
            __syncthreads();
        }
        E(acc, cur, wr, wc, fr, fq);
        if (!has_next) break;
#pragma unroll
        for (int a = 0; a < 2; ++a)
#pragma unroll
            for (int b = 0; b < 2; ++b)
#pragma unroll
                for (int m = 0; m < 4; ++m)
#pragma unroll
                    for (int n = 0; n < 2; ++n) acc[a][b][m][n] = (f32x4){0.f, 0.f, 0.f, 0.f};
        cur = nxt; cA = nA; cB = nB; ++ui;
    }
#undef G3_SA
#undef G3_SB
#undef G3_ISSUE
#undef G3_WRITE
#undef G3_LDA
#undef G3_LDB
#undef G3_MMA
#undef G3_COMPUTE
}
}


constexpr int NWAVES = 8;
constexpr int BATCH = 2, SEQ = 8192, DM = 1024, NMETA = 16, LPOS = SEQ + NMETA, MX = BATCH * SEQ, RP = BATCH * LPOS, INC = 6144;
constexpr int NCH = 129;
constexpr float EPS = 1e-6f;
constexpr float LOG2E = 1.4426950408889634f;
constexpr float QSCALE = 0.125f * LOG2E;
constexpr float HG_SCALE = 0.08838834764831845f;
constexpr float EXIT_BITS = 126.0f;

#define GAS __attribute__((address_space(1)))
#define LAS __attribute__((address_space(3)))
typedef unsigned short bf16;
typedef unsigned v4u __attribute__((ext_vector_type(4)));
typedef unsigned v2u __attribute__((ext_vector_type(2)));
typedef float f32x4 __attribute__((ext_vector_type(4)));
typedef float f32x2 __attribute__((ext_vector_type(2)));
typedef float f32x16 __attribute__((ext_vector_type(16)));
typedef short bf16x8 __attribute__((ext_vector_type(8)));
typedef short bf16x4 __attribute__((ext_vector_type(4)));

constexpr size_t MiB = 1u << 20;
constexpr size_t WS_WIN = 1 * MiB, WS_WSB = 13 * MiB, WS_WHG = 14 * MiB, WS_WO = 15 * MiB;
constexpr size_t WS_U = 17 * MiB;
constexpr size_t WS_Q = 49 * MiB;
constexpr size_t WS_K = 65 * MiB;
constexpr size_t WS_V = 82 * MiB;
constexpr size_t WS_SG = 99 * MiB;
constexpr size_t WS_HQ = 197 * MiB;
constexpr size_t WS_HI = 213 * MiB;
constexpr size_t WS_HGT = 148 * MiB;
constexpr size_t WS_G = 164 * MiB;
constexpr size_t WS_GH = 115 * MiB;
constexpr size_t WS_DC = 230 * MiB;
constexpr size_t WS_T1 = WS_Q;
constexpr size_t WS_MG = WS_G;
constexpr size_t WS_END = 232 * MiB;
constexpr size_t DO_ST = 0, DO_GS = 32 * MiB;

constexpr int RING_BYTES = 131072, LDS_BYTES = 147456;

__device__ __forceinline__ unsigned f2bf(float f) { unsigned u = __builtin_bit_cast(unsigned, f); return (u + 0x7fffu + ((u >> 16) & 1u)) >> 16; }
__device__ __forceinline__ unsigned pk2(float lo, float hi) { return pg8::cvt_pk_bf16(lo, hi); }
__device__ __forceinline__ float bf2f(unsigned short h) { return __builtin_bit_cast(float, (unsigned)h << 16); }
__device__ __forceinline__ float bflo(unsigned w) { return __builtin_bit_cast(float, w << 16); }
__device__ __forceinline__ float bfhi(unsigned w) { return __builtin_bit_cast(float, w & 0xffff0000u); }
__device__ __forceinline__ float fsigmoid(float v) { return __builtin_amdgcn_rcpf(1.0f + __builtin_amdgcn_exp2f(-v * LOG2E)); }
__device__ __forceinline__ float fsilu(float v) { return v * fsigmoid(v); }
__device__ __forceinline__ float wave_sum(float v) {
#pragma unroll
    for (int o = 1; o < 64; o <<= 1) v += __shfl_xor(v, o);
    return v;
}
#define LDS_WAIT() asm volatile("s_waitcnt lgkmcnt(0)" ::: "memory")

struct Frame {
    LAS unsigned char* lds;
    int tid, lane, wave, vcu, G;
    const float *x, *meta, *norm_g, *w_in, *w_sb_out, *w_hg_out, *w_out, *hg_norm_g, *lbl, *final_g;
    float* out; unsigned char* ws;
    bf16 *WinT, *WsbT, *WhgT, *WoT, *U, *Q, *K, *V, *SG, *HQ, *HI, *HGT, *GH, *GS, *T1, *MG, *ST, *Y;
    bf16* Gf; float* DC;
};

__device__ __forceinline__ void store8bf(bf16* p, f32x4 a, f32x4 b) { v4u w; w.x = pk2(a[0], a[1]); w.y = pk2(a[2], a[3]); w.z = pk2(b[0], b[1]); w.w = pk2(b[2], b[3]); *(v4u*)p = w; }
template <int ACT> __device__ __forceinline__ float actf(float v) {
    if (ACT == 0) return v;
    if (ACT == 1) return v * QSCALE;
    if (ACT == 2) return fsilu(v);
    if (ACT == 3) return fsilu(v) * HG_SCALE;
    return fsigmoid(v);
}
struct EpiProj {
    static constexpr bool PERM = true, AFTER_DRAIN = false, HAS_MID = false;
    bf16 *Q, *K, *V, *SG, *HQ, *HI, *HGT, *GS, *GH; bf16* Gf; const float* lbl; unsigned char* wsb;
    template <int ACT> __device__ __forceinline__ void emit(const f32x4 (&acc)[2][2][4][2], bf16* base, int ldc, int row0, int col0) const {
#pragma unroll
        for (int ai = 0; ai < 2; ++ai)
#pragma unroll
            for (int m = 0; m < 4; ++m) { bf16* rowp = base + (size_t)(row0 + ai * 128 + m * 16) * ldc + col0;
#pragma unroll
                for (int bj = 0; bj < 2; ++bj) { f32x4 a = acc[ai][bj][m][0], b = acc[ai][bj][m][1];
#pragma unroll
                    for (int j = 0; j < 4; ++j) { a[j] = actf<ACT>(a[j]); b[j] = actf<ACT>(b[j]); }
                    store8bf(rowp + bj * 128, a, b); } }
    }
    __device__ __forceinline__ void operator()(const f32x4 (&acc)[2][2][4][2], const pg8::Unit& u, int wr, int wc, int fr, int fq) const {
        const int pn = u.pn, bb = u.pm >> 5;
        const int rowm = u.pm * 256 + wr * 64 + fr, rowp = rowm + 16 * (1 + bb);
        const int cin = wc * 32 + 8 * fq;
        int act, ldc, row0, col0; bf16* base;
        if (pn < 16) { const int grp = pn >> 1; col0 = (pn & 1) * 256 + cin; ldc = 512;
            act = (grp == 0) ? 1 : (grp == 3 || grp == 7) ? 2 : (grp == 4) ? 3 : (grp == 5) ? 5 : 0;
            const size_t boff = (grp == 0) ? WS_Q : (grp == 1) ? WS_K : (grp == 2) ? WS_V : (grp == 3) ? WS_SG : (grp == 4) ? WS_HQ : (grp == 6) ? WS_HI : WS_HGT; base = (bf16*)(wsb + boff);
            row0 = (grp == 1 || grp == 2 || grp == 5 || grp == 6) ? rowp : rowm;
        } else { act = 4; ldc = 1024; row0 = rowm; base = (pn < 20) ? GS : GH; col0 = ((pn - 16) & 3) * 256 + cin; }
        if (act == 5) {
#pragma unroll
            for (int bj = 0; bj < 2; ++bj) { float lb[8];
#pragma unroll
                for (int j = 0; j < 8; ++j) { const int c = col0 + bj * 128 + j; lb[j] = fsigmoid(lbl[c] - lbl[512 + c]); }
#pragma unroll
                for (int ai = 0; ai < 2; ++ai)
#pragma unroll
                    for (int m = 0; m < 4; ++m) { bf16* o = Gf + (size_t)(row0 + ai * 128 + m * 16) * 512 + col0 + bj * 128; f32x4 a = acc[ai][bj][m][0], b = acc[ai][bj][m][1];
#pragma unroll
                        for (int j = 0; j < 4; ++j) { a[j] = __logf(lb[j] + (1.0f - lb[j]) * fsigmoid(a[j])); b[j] = __logf(lb[4 + j] + (1.0f - lb[4 + j]) * fsigmoid(b[j])); }
                        store8bf(o, a, b); } }
            return;
        }
        if (act == 4) {
            unsigned char* gbase = (unsigned char*)base;
#pragma unroll
            for (int ai = 0; ai < 2; ++ai)
#pragma unroll
                for (int m = 0; m < 4; ++m) { unsigned char* rowq = gbase + (size_t)(row0 + ai * 128 + m * 16) * 1024 + col0;
#pragma unroll
                    for (int bj = 0; bj < 2; ++bj) { const f32x4 a = acc[ai][bj][m][0], b = acc[ai][bj][m][1]; unsigned qa[4], qb_[4];
#pragma unroll
                        for (int j = 0; j < 4; ++j) { qa[j] = (unsigned)fminf(fmaxf(fsigmoid(a[j]) * 255.0f + 0.5f, 1.0f), 255.0f); qb_[j] = (unsigned)fminf(fmaxf(fsigmoid(b[j]) * 255.0f + 0.5f, 1.0f), 255.0f); }
                        v2u w; w.x = qa[0] | (qa[1] << 8) | (qa[2] << 16) | (qa[3] << 24); w.y = qb_[0] | (qb_[1] << 8) | (qb_[2] << 16) | (qb_[3] << 24);
                        *(v2u*)(rowq + bj * 128) = w; } }
            return;
        }
        if (act <= 1) {
            const float lin = (act == 0) ? 1.0f : QSCALE;
#pragma unroll
            for (int ai = 0; ai < 2; ++ai)
#pragma unroll
                for (int m = 0; m < 4; ++m) { bf16* rowq = base + (size_t)(row0 + ai * 128 + m * 16) * ldc + col0;
#pragma unroll
                    for (int bj = 0; bj < 2; ++bj) store8bf(rowq + bj * 128, acc[ai][bj][m][0] * lin, acc[ai][bj][m][1] * lin); }
            return;
        }
        const float vs = (act == 2) ? 1.0f : HG_SCALE;
#pragma unroll
        for (int ai = 0; ai < 2; ++ai)
#pragma unroll
            for (int m = 0; m < 4; ++m) { bf16* rowq = base + (size_t)(row0 + ai * 128 + m * 16) * ldc + col0;
#pragma unroll
                for (int bj = 0; bj < 2; ++bj) { f32x4 a = acc[ai][bj][m][0], b = acc[ai][bj][m][1];
#pragma unroll
                    for (int j = 0; j < 4; ++j) { a[j] = vs * a[j] * fsigmoid(a[j]); b[j] = vs * b[j] * fsigmoid(b[j]); }
                    store8bf(rowq + bj * 128, a, b); } }
    }
};
template <int MODE> struct EpiGate {
    static constexpr bool PERM = true, AFTER_DRAIN = false, HAS_MID = false;
    const bf16* gate; const bf16* prev; bf16* O;
    __device__ __forceinline__ void operator()(const f32x4 (&acc)[2][2][4][2], const pg8::Unit& u, int wr, int wc, int fr, int fq) const {
        const int row0 = u.pm * 256 + wr * 64 + fr, col0 = u.pn * 256 + wc * 32 + 8 * fq;
#pragma unroll
        for (int ai = 0; ai < 2; ++ai)
#pragma unroll
            for (int m = 0; m < 4; ++m)
#pragma unroll
                for (int bj = 0; bj < 2; ++bj) { const size_t off = (size_t)(row0 + ai * 128 + m * 16) * 1024 + col0 + bj * 128;
                    const v4u g = *(const v4u*)(gate + off); f32x4 a = acc[ai][bj][m][0], b = acc[ai][bj][m][1];
                    a[0] *= bflo(g.x); a[1] *= bfhi(g.x); a[2] *= bflo(g.y); a[3] *= bfhi(g.y); b[0] *= bflo(g.z); b[1] *= bfhi(g.z); b[2] *= bflo(g.w); b[3] *= bfhi(g.w);
                    if (MODE == 1) { const v4u p = *(const v4u*)(prev + off);
                        a[0] += bflo(p.x); a[1] += bfhi(p.x); a[2] += bflo(p.y); a[3] += bfhi(p.y); b[0] += bflo(p.z); b[1] += bfhi(p.z); b[2] += bflo(p.w); b[3] += bfhi(p.w); }
                    store8bf(O + off, a, b); }
    }
};
struct EpiRes {
    static constexpr bool PERM = true, AFTER_DRAIN = false, HAS_MID = false;
    const float* x; float* out;
    __device__ __forceinline__ void operator()(const f32x4 (&acc)[2][2][4][2], const pg8::Unit& u, int wr, int wc, int fr, int fq) const {
        const int row0 = u.pm * 256 + wr * 64 + fr, col0 = u.pn * 256 + wc * 32 + 8 * fq;
#pragma unroll
        for (int ai = 0; ai < 2; ++ai)
#pragma unroll
            for (int m = 0; m < 4; ++m)
#pragma unroll
                for (int bj = 0; bj < 2; ++bj) { const size_t off = (size_t)(row0 + ai * 128 + m * 16) * 1024 + col0 + bj * 128;
                    const f32x4 x0 = *(const f32x4*)(x + off), x1 = *(const f32x4*)(x + off + 4);
                    f32x4 c0 = acc[ai][bj][m][0], c1 = acc[ai][bj][m][1];
                    if (DBG_SKIP & 32768) { for (int j = 0; j < 4; ++j) { c0[j] = fminf(fmaxf(c0[j], -1.5f), 1.5f); c1[j] = fminf(fmaxf(c1[j], -1.5f), 1.5f); } }
                    *(f32x4*)(out + off) = x0 + c0; *(f32x4*)(out + off + 4) = x1 + c1; }
    }
};

struct EpiMerge {
    static constexpr bool PERM = true, AFTER_DRAIN = false, HAS_MID = true;
    const unsigned char* GS; const unsigned char* GH; bf16* O;
    __device__ __forceinline__ void mid(f32x4 (&acc)[2][2][4][2], const pg8::Unit& u, int wr, int wc, int fr, int fq) const {
        int row0 = u.pm * 256 + wr * 64 + fr, col0 = u.pn * 256 + wc * 32 + 8 * fq;
        asm volatile("" : "+v"(row0), "+v"(col0));
#pragma unroll
        for (int ai = 0; ai < 2; ++ai)
#pragma unroll
            for (int m = 0; m < 4; ++m)
#pragma unroll
                for (int bj = 0; bj < 2; ++bj) { const size_t off = (size_t)(row0 + ai * 128 + m * 16) * 1024 + col0 + bj * 128; const v2u s_ = *(const v2u*)(GS + off), h_ = *(const v2u*)(GH + off);
#pragma unroll
                    for (int n = 0; n < 2; ++n) { const unsigned sw = n ? s_.y : s_.x, hw = n ? h_.y : h_.x; f32x4 a = acc[ai][bj][m][n];
#pragma unroll
                        for (int e = 0; e < 4; ++e) a[e] *= (float)((sw >> (8 * e)) & 255u) * __builtin_amdgcn_rcpf((float)((hw >> (8 * e)) & 255u));
                        asm volatile("" : "+v"(a) :: "memory"); acc[ai][bj][m][n] = a; } }
    }
    __device__ __forceinline__ void operator()(const f32x4 (&acc)[2][2][4][2], const pg8::Unit& u, int wr, int wc, int fr, int fq) const {
        const int row0 = u.pm * 256 + wr * 64 + fr, col0 = u.pn * 256 + wc * 32 + 8 * fq;
#pragma unroll
        for (int ai = 0; ai < 2; ++ai)
#pragma unroll
            for (int m = 0; m < 4; ++m)
#pragma unroll
                for (int bj = 0; bj < 2; ++bj) { const size_t off = (size_t)(row0 + ai * 128 + m * 16) * 1024 + col0 + bj * 128; const v2u h_ = *(const v2u*)(GH + off); f32x4 a = acc[ai][bj][m][0], b = acc[ai][bj][m][1];
#pragma unroll
                    for (int e = 0; e < 4; ++e) { a[e] *= (float)((h_.x >> (8 * e)) & 255u) * (1.0f / 255.0f); b[e] *= (float)((h_.y >> (8 * e)) & 255u) * (1.0f / 255.0f); }
                    store8bf(O + off, a, b); }
    }
};

__device__ __forceinline__ void p0_transpose_item(const float* W, int K, int N, bf16* WT, int ldt, LAS float* scr, int item, int lane) {
    const int nblk = N / 32, kb = item / nblk, nb = item % nblk, k0 = 64 * kb, n0 = 32 * nb;
#pragma unroll 8
    for (int i = 0; i < 32; ++i) { const int kk = 2 * i + (lane >> 5); scr[kk * 33 + (lane & 31)] = W[(size_t)(k0 + kk) * N + n0 + (lane & 31)]; }
    LDS_WAIT();
    const int c = lane & 7;
#pragma unroll
    for (int j = 0; j < 4; ++j) { const int n = (lane >> 3) + 8 * j; const LAS float* s = scr + (8 * c) * 33 + n;
        v4u o; o.x = pk2(s[0 * 33], s[1 * 33]); o.y = pk2(s[2 * 33], s[3 * 33]); o.z = pk2(s[4 * 33], s[5 * 33]); o.w = pk2(s[6 * 33], s[7 * 33]);
        *(v4u*)(WT + (size_t)(n0 + n) * ldt + k0 + 8 * c) = o; }
    LDS_WAIT();
}
__device__ __forceinline__ void meta_item(Frame& F, int it) {
    LAS float* um = (LAS float*)F.lds;
    LAS float* red = (LAS float*)(F.lds + 65536);
#pragma unroll
    for (int rr = 0; rr < 2; ++rr) { const int row = F.wave * 2 + rr; const f32x4* xr = (const f32x4*)(F.meta + row * 1024) + F.lane; const f32x4* gr = (const f32x4*)F.norm_g + F.lane;
        f32x4 v[4]; float s = 0.f;
#pragma unroll
        for (int j = 0; j < 4; ++j) { v[j] = xr[64 * j]; s += (v[j][0] * v[j][0] + v[j][1] * v[j][1]) + (v[j][2] * v[j][2] + v[j][3] * v[j][3]); }
        const float rstd = rsqrtf(wave_sum(s) * (1.0f / 1024.0f) + EPS);
#pragma unroll
        for (int j = 0; j < 4; ++j) { const f32x4 g = gr[64 * j];
#pragma unroll
            for (int e = 0; e < 4; ++e) um[(4 * (F.lane + 64 * j) + e) * 16 + row] = v[j][e] * rstd * g[e]; } }
    __syncthreads();
    const int cl = F.tid & 63, kg = F.tid >> 6;
    const int c0 = (it < 16) ? 512 + 64 * it : 2560 + 64 * (it - 16);
    float acc[16];
#pragma unroll
    for (int r = 0; r < 16; ++r) acc[r] = 0.f;
    const float* wp = F.w_in + (size_t)(kg * 128) * INC + c0 + cl;
#pragma unroll 4
    for (int k = 0; k < 128; ++k) { const float w = wp[(size_t)k * INC]; const LAS f32x4* up = (const LAS f32x4*)(um + (kg * 128 + k) * 16);
#pragma unroll
        for (int q = 0; q < 4; ++q) { const f32x4 u = up[q];
#pragma unroll
            for (int e = 0; e < 4; ++e) acc[4 * q + e] += u[e] * w; } }
#pragma unroll
    for (int r = 0; r < 16; ++r) red[(kg * 16 + r) * 64 + cl] = acc[r];
    __syncthreads();
    for (int o = F.tid; o < 1024; o += 512) { const int r = o >> 6, c = o & 63; float s = 0.f;
#pragma unroll
        for (int k2 = 0; k2 < 8; ++k2) s += red[(k2 * 16 + r) * 64 + c];
        const int col = c0 + c;
#pragma unroll
        for (int b = 0; b < 2; ++b) { const size_t prow = (size_t)b * LPOS + r;
            if (col < 1024) F.K[prow * 512 + col - 512] = (bf16)f2bf(s);
            else if (col < 1536) F.V[prow * 512 + col - 1024] = (bf16)f2bf(s);
            else if (col < 3072) { const int cc = col - 2560; const float lb = fsigmoid(F.lbl[cc] - F.lbl[512 + cc]); F.Gf[prow * 512 + cc] = (bf16)f2bf(__logf(lb + (1.0f - lb) * fsigmoid(s))); }
            else F.HI[prow * 512 + col - 3072] = (bf16)f2bf(s); } }
    __syncthreads();
}
__device__ __forceinline__ void p0_prologue(Frame& F) {
    if (blockIdx.x < 32) meta_item(F, blockIdx.x);
    LAS float* scr = (LAS float*)(F.lds + F.wave * 16384);
    const int gw = F.vcu * NWAVES + F.wave, NGW = F.G * NWAVES;
    constexpr int I_IN = (1024 / 64) * (INC / 32), I_SB = (512 / 64) * (1024 / 32), I_O = (1024 / 64) * (1024 / 32);
    constexpr int NITEMS = I_IN + 2 * I_SB + I_O;
    for (int it = gw; it < NITEMS; it += NGW) {
        int r = it;
        if (r < I_IN) { p0_transpose_item(F.w_in, 1024, INC, F.WinT, 1024, scr, r, F.lane); continue; } r -= I_IN;
        if (r < I_SB) { p0_transpose_item(F.w_sb_out, 512, 1024, F.WsbT, 1024, scr, r, F.lane); continue; } r -= I_SB;
        if (r < I_SB) { p0_transpose_item(F.w_hg_out, 512, 1024, F.WsbT + 512, 1024, scr, r, F.lane); continue; } r -= I_SB;
        p0_transpose_item(F.w_out, 1024, 1024, F.WoT, 1024, scr, r, F.lane);
    }
    for (int m = gw; m < MX; m += 2 * NGW) {
        const int m2 = m + NGW; const bool has2 = m2 < MX;
        const f32x4* xr = (const f32x4*)(F.x + (size_t)m * DM) + F.lane; const f32x4* xr2 = (const f32x4*)(F.x + (size_t)(has2 ? m2 : m) * DM) + F.lane; const f32x4* gr = (const f32x4*)F.norm_g + F.lane;
        f32x4 v[4], w2[4]; float s = 0.f, s2 = 0.f;
#pragma unroll
        for (int j = 0; j < 4; ++j) { v[j] = xr[64 * j]; w2[j] = xr2[64 * j]; }
#pragma unroll
        for (int j = 0; j < 4; ++j) { s += (v[j][0] * v[j][0] + v[j][1] * v[j][1]) + (v[j][2] * v[j][2] + v[j][3] * v[j][3]); s2 += (w2[j][0] * w2[j][0] + w2[j][1] * w2[j][1]) + (w2[j][2] * w2[j][2] + w2[j][3] * w2[j][3]); }
        const float rstd = rsqrtf(wave_sum(s) * (1.0f / 1024.0f) + EPS), rstd2 = rsqrtf(wave_sum(s2) * (1.0f / 1024.0f) + EPS);
        v2u* o8 = (v2u*)(F.U + (size_t)m * DM) + F.lane; v2u* o82 = (v2u*)(F.U + (size_t)m2 * DM) + F.lane;
#pragma unroll
        for (int j = 0; j < 4; ++j) { const f32x4 g = gr[64 * j]; v2u w; w.x = pk2(v[j][0] * rstd * g[0], v[j][1] * rstd * g[1]); w.y = pk2(v[j][2] * rstd * g[2], v[j][3] * rstd * g[3]); o8[64 * j] = w;
            if (has2) { v2u u; u.x = pk2(w2[j][0] * rstd2 * g[0], w2[j][1] * rstd2 * g[1]); u.y = pk2(w2[j][2] * rstd2 * g[2], w2[j][3] * rstd2 * g[3]); o82[64 * j] = u; } }
    }
}

#define ATT_PROCESS(qf_, o0_, o1_, R_, qpos_, masked_) do { \
    f32x16 z; _Pragma("unroll") for (int i = 0; i < 16; ++i) z[i] = 0.f; \
    _Pragma("unroll") for (int s = 0; s < 4; ++s) z = __builtin_amdgcn_mfma_f32_32x32x16_bf16(kf[s], qf_[s], z, 0, 0, 0); \
    float sp[16], lbv[16]; \
    if (masked_) { _Pragma("unroll") for (int i = 0; i < 16; ++i) { const int kpos = kb + (i & 3) + 8 * (i >> 2) + 4 * hh; const bool valid = (kpos < (qpos_)) && (kpos >= 0); \
            const float zz = fminf(z[i], 126.f); float s_; asm("v_log_f32 %0, %1" : "=v"(s_) : "v"(1.0f + __builtin_amdgcn_exp2f(zz))); sp[i] = valid ? s_ : 0.f; lbv[i] = valid ? (zz - s_) : -INFINITY; } } \
    else { _Pragma("unroll") for (int i = 0; i < 16; ++i) { const float zz = fminf(z[i], 126.f); float s_; asm("v_log_f32 %0, %1" : "=v"(s_) : "v"(1.0f + __builtin_amdgcn_exp2f(zz))); sp[i] = s_; lbv[i] = zz - s_; } } \
    float gs[4], ps[4], after[4]; \
    _Pragma("unroll") for (int g = 0; g < 4; ++g) { gs[g] = (sp[4 * g] + sp[4 * g + 1]) + (sp[4 * g + 2] + sp[4 * g + 3]); ps[g] = __shfl_xor(gs[g], 32); } \
    float tot = 0.f; \
    _Pragma("unroll") for (int g = 3; g >= 0; --g) { after[g] = tot + (hh == 0 ? ps[g] : 0.f); tot += gs[g] + ps[g]; } \
    float w[16]; \
    _Pragma("unroll") for (int g = 0; g < 4; ++g) { float run = (R_) + after[g]; \
        _Pragma("unroll") for (int ii = 3; ii >= 0; --ii) { const int i = 4 * g + ii; w[i] = __builtin_amdgcn_exp2f(lbv[i] - run); run += sp[i]; } } \
    (R_) += tot; \
    _Pragma("unroll") for (int s = 0; s < 2; ++s) { v4u t_; t_.x = pk2(w[8 * s], w[8 * s + 1]); t_.y = pk2(w[8 * s + 2], w[8 * s + 3]); t_.z = pk2(w[8 * s + 4], w[8 * s + 5]); t_.w = pk2(w[8 * s + 6], w[8 * s + 7]); \
        const bf16x8 wf_ = __builtin_bit_cast(bf16x8, t_); \
        o0_ = __builtin_amdgcn_mfma_f32_32x32x16_bf16(vfr[s][0], wf_, o0_, 0, 0, 0); o1_ = __builtin_amdgcn_mfma_f32_32x32x16_bf16(vfr[s][1], wf_, o1_, 0, 0, 0); } } while (0)
template <int DUMMY> __device__ __forceinline__ void attn_phase_t(Frame& F) {
    LAS bf16* vt = (LAS bf16*)(F.lds + F.wave * 8192);
    const int lane = F.lane, r = lane & 31, hh = lane >> 5;
    const int gw = F.vcu * NWAVES + F.wave, NGW = F.G * NWAVES;
#define ATT_LOADK(kb_, kf_) do { int kp_ = (kb_) + r; kp_ = kp_ < 0 ? 0 : kp_; const bf16* krow_ = F.K + (prow0 + kp_) * 512 + h * 64 + 8 * hh; \
            _Pragma("unroll") for (int s_ = 0; s_ < 4; ++s_) kf_[s_] = *(const bf16x8*)(krow_ + 16 * s_); } while (0)
#define ATT_LOADV(kb_, vv_) do { _Pragma("unroll") for (int i_ = 0; i_ < 4; ++i_) { const int idx_ = lane + 64 * i_, key_ = idx_ & 31, c_ = idx_ >> 5; int vp_ = (kb_) + key_; vp_ = vp_ < 0 ? 0 : vp_; \
                vv_[i_] = *(const v4u*)(F.V + (prow0 + vp_) * 512 + h * 64 + 8 * c_); } } while (0)
    for (int it = gw; it < 2048; it += NGW) {
        const int qb = it & 127, h = (it >> 7) & 7, b = it >> 10; const int mA = b * SEQ + qb * 64 + r, mB = mA + 32; const size_t prow0 = (size_t)b * LPOS;
        const int kbA0 = NMETA + qb * 64, kbB0 = kbA0 + 32, qposA = kbA0 + r, qposB = kbB0 + r;
        bf16x8 qfA[4], qfB[4], kf[4], kfn[4]; v4u vv[4];
#pragma unroll
        for (int s = 0; s < 4; ++s) { qfA[s] = *(const bf16x8*)(F.Q + (size_t)mA * 512 + h * 64 + 8 * hh + 16 * s); qfB[s] = *(const bf16x8*)(F.Q + (size_t)mB * 512 + h * 64 + 8 * hh + 16 * s); }
        ATT_LOADK(kbB0, kf); ATT_LOADV(kbB0, vv);
        f32x16 oA0, oA1, oB0, oB1;
#pragma unroll
        for (int i = 0; i < 16; ++i) { oA0[i] = 0.f; oA1[i] = 0.f; oB0[i] = 0.f; oB1[i] = 0.f; }
        float RA = 0.f, RB = 0.f; bool doneB = false;
        for (int kb = kbB0;; kb -= 32) {
            ATT_LOADK(kb - 32, kfn);
#pragma unroll
            for (int i = 0; i < 4; ++i) { const int idx = lane + 64 * i, key = idx & 31, c = idx >> 5; const unsigned ww[4] = {vv[i].x, vv[i].y, vv[i].z, vv[i].w};
#pragma unroll
                for (int j = 0; j < 4; ++j) { vt[(8 * c + 2 * j) * 36 + key] = (bf16)(ww[j] & 0xffffu); vt[(8 * c + 2 * j + 1) * 36 + key] = (bf16)(ww[j] >> 16); } }
            ATT_LOADV(kb - 32, vv);
            LDS_WAIT();
            bf16x8 vfr[2][2];
#pragma unroll
            for (int s = 0; s < 2; ++s)
#pragma unroll
                for (int db = 0; db < 2; ++db) { const LAS bf16* vp = vt + (32 * db + r) * 36 + 16 * s + 4 * hh; const bf16x4 lo = *(const LAS bf16x4*)vp, hi = *(const LAS bf16x4*)(vp + 8);
                    vfr[s][db] = (bf16x8){lo[0], lo[1], lo[2], lo[3], hi[0], hi[1], hi[2], hi[3]}; }
            LDS_WAIT();
            if (!doneB) { if (kb == kbB0 || kb < 0) ATT_PROCESS(qfB, oB0, oB1, RB, qposB, true); else ATT_PROCESS(qfB, oB0, oB1, RB, qposB, false); }
            if (kb <= kbA0) { if (kb == kbA0 || kb < 0) ATT_PROCESS(qfA, oA0, oA1, RA, qposA, true); else ATT_PROCESS(qfA, oA0, oA1, RA, qposA, false); }
            if (kb <= 0) break;
            doneB = __all(RB >= EXIT_BITS);
            if (doneB && kb <= kbA0 && __all(RA >= EXIT_BITS)) break;
#pragma unroll
            for (int s = 0; s < 4; ++s) kf[s] = kfn[s];
        }
#pragma unroll
        for (int g = 0; g < 8; ++g) { const int db = g >> 2, gg = g & 3; const int d0 = h * 64 + 32 * db + 8 * gg + 4 * hh;
            const v2u sga = *(const v2u*)(F.SG + (size_t)mA * 512 + d0), sgb = *(const v2u*)(F.SG + (size_t)mB * 512 + d0);
            const f32x16& oa = db ? oA1 : oA0; const f32x16& ob = db ? oB1 : oB0; v2u ya, yb;
            ya.x = pk2(oa[4 * gg] * bflo(sga.x), oa[4 * gg + 1] * bfhi(sga.x)); ya.y = pk2(oa[4 * gg + 2] * bflo(sga.y), oa[4 * gg + 3] * bfhi(sga.y));
            yb.x = pk2(ob[4 * gg] * bflo(sgb.x), ob[4 * gg + 1] * bfhi(sgb.x)); yb.y = pk2(ob[4 * gg + 2] * bflo(sgb.y), ob[4 * gg + 3] * bfhi(sgb.y));
            if (DUMMY) { *(v2u*)((bf16*)(F.ws + 231 * MiB) + (size_t)(mA % 12288) * 1024 + d0) = ya; } else { *(v2u*)(F.Y + (size_t)mA * 1024 + d0) = ya; *(v2u*)(F.Y + (size_t)mB * 1024 + d0) = yb; } }
    }
}
__device__ __forceinline__ void attn_phase(Frame& F) { attn_phase_t<0>(F); }
__device__ __forceinline__ void stage_iT(Frame& F, LAS bf16* iT, size_t prow, int hh, int nv) {
#pragma unroll
    for (int q = 0; q < 2; ++q) { const int idx = F.tid + 512 * q, s = idx & 63, c8 = idx >> 6;
        v4u w = {0u, 0u, 0u, 0u}; if (s < nv) w = *(const v4u*)(F.HI + (prow + s) * 512 + hh * 128 + 8 * c8);
        const unsigned ww[4] = {w.x, w.y, w.z, w.w};
#pragma unroll
        for (int j = 0; j < 4; ++j) { iT[(8 * c8 + 2 * j) * 72 + s] = (bf16)(ww[j] & 0xffffu); iT[(8 * c8 + 2 * j + 1) * 72 + s] = (bf16)(ww[j] >> 16); } }
}
__device__ __forceinline__ void hgrn_local_phase(Frame& F) {
    LAS bf16* KhT = (LAS bf16*)(F.lds);
    LAS bf16* iT = (LAS bf16*)(F.lds + 18432);
    LAS float* seg = (LAS float*)(F.lds + 36864);
    const int r = F.lane & 31, h2 = F.lane >> 5, wv = F.wave >> 1, wk = F.wave & 1;
    for (int un = F.vcu; un < 1024; un += F.G) {
        const int stream = un >> 7, c_ = un & 127, b = stream >> 2, hh = stream & 3, nvl = c_ ? 64 : NMETA; const size_t prow = (size_t)b * LPOS + (c_ ? NMETA + 64 * (c_ - 1) : 0);
        stage_iT(F, iT, prow, hh, nvl);
        { const int kp = F.tid & 63, q = F.tid >> 6; float g0[8], g1[8], c0[8], c1[8]; float run0 = 0.f, run1 = 0.f;
#pragma unroll
            for (int jj = 0; jj < 8; ++jj) { const int t = 8 * q + jj; unsigned gg = 0u; if (t < nvl) gg = *(const unsigned*)(F.Gf + (prow + t) * 512 + hh * 128 + 2 * kp); g0[jj] = bflo(gg); g1[jj] = bfhi(gg); }
#pragma unroll
            for (int jj = 0; jj < 8; ++jj) { run0 += g0[jj]; run1 += g1[jj]; c0[jj] = run0; c1[jj] = run1; }
            *(LAS f32x2*)(seg + q * 128 + 2 * kp) = (f32x2){run0, run1};
            __syncthreads();
            float pre0 = 0.f, pre1 = 0.f, bl0 = 0.f, bl1 = 0.f;
#pragma unroll
            for (int qq = 0; qq < 8; ++qq) { const f32x2 sv = *(const LAS f32x2*)(seg + qq * 128 + 2 * kp); bl0 += sv[0]; bl1 += sv[1]; if (qq < q) { pre0 += sv[0]; pre1 += sv[1]; } }
            if (q == 0) *(f32x2*)(F.DC + (stream * 128 + c_) * 128 + 2 * kp) = (f32x2){__expf(bl0), __expf(bl1)};
            float k0[8], k1[8];
#pragma unroll
            for (int jj = 0; jj < 8; ++jj) { k0[jj] = (1.0f - __expf(g0[jj])) * __expf(bl0 - (pre0 + c0[jj])); k1[jj] = (1.0f - __expf(g1[jj])) * __expf(bl1 - (pre1 + c1[jj])); }
            v4u w0, w1; w0.x = pk2(k0[0], k0[1]); w0.y = pk2(k0[2], k0[3]); w0.z = pk2(k0[4], k0[5]); w0.w = pk2(k0[6], k0[7]); w1.x = pk2(k1[0], k1[1]); w1.y = pk2(k1[2], k1[3]); w1.z = pk2(k1[4], k1[5]); w1.w = pk2(k1[6], k1[7]);
            *(LAS v4u*)(KhT + (2 * kp) * 72 + 8 * q) = w0; *(LAS v4u*)(KhT + (2 * kp + 1) * 72 + 8 * q) = w1; }
        __syncthreads();
        f32x16 a0, a1;
#pragma unroll
        for (int i = 0; i < 16; ++i) { a0[i] = 0.f; a1[i] = 0.f; }
#pragma unroll
        for (int ks = 0; ks < 4; ++ks) { const bf16x8 af = *(const LAS bf16x8*)(iT + (32 * wv + r) * 72 + 16 * ks + 8 * h2);
            const bf16x8 b0 = *(const LAS bf16x8*)(KhT + (64 * wk + r) * 72 + 16 * ks + 8 * h2), b1 = *(const LAS bf16x8*)(KhT + (64 * wk + 32 + r) * 72 + 16 * ks + 8 * h2);
            a0 = __builtin_amdgcn_mfma_f32_32x32x16_bf16(af, b0, a0, 0, 0, 0); a1 = __builtin_amdgcn_mfma_f32_32x32x16_bf16(af, b1, a1, 0, 0, 0); }
        bf16* st = F.ST + (size_t)(stream * 128 + c_) * 16384;
#pragma unroll
        for (int i = 0; i < 16; ++i) { const int v = 32 * wv + (i & 3) + 8 * (i >> 2) + 4 * h2; st[v * 128 + 64 * wk + r] = (bf16)f2bf(a0[i]); st[v * 128 + 64 * wk + 32 + r] = (bf16)f2bf(a1[i]); }
        __syncthreads();
    }
}
__device__ __forceinline__ void hgrn_scan_phase(Frame& F, bf16* OUT) {
    LAS float* ldc = (LAS float*)F.lds;
    for (int blk = F.vcu; blk < 256; blk += F.G) {
        const int stream = blk >> 5, e = (blk & 31) * 512 + F.tid, k = e & 127; bf16* st = F.ST + (size_t)stream * 128 * 16384 + e; bf16* so = OUT + (size_t)stream * 128 * 16384 + e;
        const f32x4* dsrc = (const f32x4*)(F.DC + stream * 16384);
#pragma unroll
        for (int i = 0; i < 8; ++i) ((LAS f32x4*)ldc)[F.tid + 512 * i] = dsrc[F.tid + 512 * i];
        float S = 0.f;
#pragma unroll 1
        for (int c0 = 0; c0 < 128; c0 += 32) {
            unsigned u[32];
#pragma unroll
            for (int c = 0; c < 32; ++c) u[c] = st[(size_t)(c0 + c) * 16384];
            if (c0 == 0) __syncthreads();
#pragma unroll
            for (int c = 0; c < 32; ++c) { S = ldc[(c0 + c) * 128 + k] * S + __builtin_bit_cast(float, u[c] << 16); so[(size_t)(c0 + c) * 16384] = (bf16)f2bf(S); }
        }
        __syncthreads();
    }
}
#define P4_BAR() do { asm volatile("s_waitcnt lgkmcnt(0)" ::: "memory"); __builtin_amdgcn_s_barrier(); asm volatile("" ::: "memory"); } while (0)
#define P4_DECODE(un_, stream_, c_, nv_, b_, hh_, prow_, m0_) \
    const int stream_ = (un_) >> 7, c_ = (un_) & 127; \
    const int nv_ = 64, b_ = stream_ >> 2, hh_ = stream_ & 3; const size_t prow_ = (size_t)b_ * LPOS + NMETA + 64 * c_; const int m0_ = b_ * SEQ + 64 * c_;
#define P4_LOAD(un_, iw_, g_, qh_) do { P4_DECODE(un_, st_, cc_, nv_, b_, hh_, prow_, m0_) \
    _Pragma("unroll") for (int q2 = 0; q2 < 2; ++q2) { const int idx = F.tid + 512 * q2, s_ = idx & 63, c8 = idx >> 6; iw_[q2] = (v4u){0u, 0u, 0u, 0u}; if (s_ < nv_) iw_[q2] = *(const v4u*)(F.HI + (prow_ + s_) * 512 + hh_ * 128 + 8 * c8); } \
    { const int kp = F.tid & 63, q = F.tid >> 6; _Pragma("unroll") for (int jj = 0; jj < 8; ++jj) { const int t = 8 * q + jj; \
        const unsigned gg = *(const unsigned*)(F.Gf + (prow_ + t) * 512 + hh_ * 128 + 2 * kp); g_[2 * jj] = bflo(gg); g_[2 * jj + 1] = bfhi(gg); \
        const unsigned qq = *(const unsigned*)(F.HQ + (size_t)(m0_ + t) * 512 + hh_ * 128 + 2 * kp); qh_[2 * jj] = qq & 0xffffu; qh_[2 * jj + 1] = qq >> 16; } } } while (0)
__device__ __forceinline__ void hgrn_out_phase(Frame& F) {
    LAS bf16* Qt = (LAS bf16*)(F.lds);
    LAS bf16* Kt = (LAS bf16*)(F.lds + 17408);
    LAS bf16* iT = (LAS bf16*)(F.lds + 34816);
    LAS bf16* As = (LAS bf16*)(F.lds + 53248);
    LAS float* Of = (LAS float*)(F.lds + 62464);
    LAS float* seg = (LAS float*)(F.lds + 96256);
    const int r = F.lane & 31, h2 = F.lane >> 5;
    v4u iw[2]; float g[16]; unsigned qh[16];
    if (F.vcu < 1024) P4_LOAD(F.vcu, iw, g, qh);
    for (int un = F.vcu; un < 1024; un += F.G) {
        P4_DECODE(un, stream, c, nv, b, hh, prow, m0)
#pragma unroll
        for (int q2 = 0; q2 < 2; ++q2) { const int idx = F.tid + 512 * q2, s_ = idx & 63, c8 = idx >> 6; const unsigned ww[4] = {iw[q2].x, iw[q2].y, iw[q2].z, iw[q2].w};
#pragma unroll
            for (int j = 0; j < 4; ++j) { iT[(8 * c8 + 2 * j) * 72 + s_] = (bf16)(ww[j] & 0xffffu); iT[(8 * c8 + 2 * j + 1) * 72 + s_] = (bf16)(ww[j] >> 16); } }
        float cs[16], qv[16], gk[16];
        { const int kp = F.tid & 63, q = F.tid >> 6; float run0 = 0.f, run1 = 0.f;
#pragma unroll
            for (int jj = 0; jj < 8; ++jj) { gk[2 * jj] = g[2 * jj]; gk[2 * jj + 1] = g[2 * jj + 1]; qv[2 * jj] = __builtin_bit_cast(float, qh[2 * jj] << 16); qv[2 * jj + 1] = __builtin_bit_cast(float, qh[2 * jj + 1] << 16);
                run0 += gk[2 * jj]; run1 += gk[2 * jj + 1]; cs[2 * jj] = run0; cs[2 * jj + 1] = run1; }
            *(LAS f32x2*)(seg + q * 128 + 2 * kp) = (f32x2){run0, run1}; }
        bf16x8 sbc[8]; v4u gate0 = {0u, 0u, 0u, 0u}, gate1 = {0u, 0u, 0u, 0u};
        { const int wv = F.wave & 3; const bf16* sp = F.ST + (size_t)(stream * 128 + c) * 16384 + (32 * wv + r) * 128 + 8 * h2;
#pragma unroll
          for (int ks = 0; ks < 8; ++ks) sbc[ks] = *(const bf16x8*)(sp + 16 * ks);
          const int t = F.tid >> 3, sg_ = F.tid & 7; const int mrow = m0 + t;
          if ((t < nv) && (mrow >= b * SEQ)) { const v4u* gp_ = (const v4u*)(F.HGT + (size_t)mrow * 512 + hh * 128 + 16 * sg_); gate0 = gp_[0]; gate1 = gp_[1]; } }
        if (un + F.G < 1024) P4_LOAD(un + F.G, iw, g, qh);
        P4_BAR();
        { const int kp = F.tid & 63, q = F.tid >> 6; float pre0 = 0.f, pre1 = 0.f;
#pragma unroll
            for (int qq = 0; qq < 7; ++qq) { const f32x2 sv = *(const LAS f32x2*)(seg + qq * 128 + 2 * kp); if (qq < q) { pre0 += sv[0]; pre1 += sv[1]; } }
#pragma unroll
            for (int jj = 0; jj < 8; ++jj) { const int t = 8 * q + jj; const float b0 = pre0 + cs[2 * jj], b1 = pre1 + cs[2 * jj + 1];
                *(LAS unsigned*)(Qt + t * 136 + 2 * kp) = pk2(qv[2 * jj] * __expf(b0), qv[2 * jj + 1] * __expf(b1));
                *(LAS unsigned*)(Kt + t * 136 + 2 * kp) = pk2((1.0f - __expf(gk[2 * jj])) * __expf(-b0), (1.0f - __expf(gk[2 * jj + 1])) * __expf(-b1)); } }
        P4_BAR();
        if (F.wave < 3) { const int tt = F.wave > 0, ts = F.wave == 2; f32x16 a;
#pragma unroll
            for (int i = 0; i < 16; ++i) a[i] = 0.f;
#pragma unroll
            for (int ks = 0; ks < 8; ++ks) { const bf16x8 af = *(const LAS bf16x8*)(Qt + (32 * tt + r) * 136 + 16 * ks + 8 * h2), bfr = *(const LAS bf16x8*)(Kt + (32 * ts + r) * 136 + 16 * ks + 8 * h2);
                a = __builtin_amdgcn_mfma_f32_32x32x16_bf16(af, bfr, a, 0, 0, 0); }
#pragma unroll
            for (int i = 0; i < 16; ++i) { const int t = 32 * tt + (i & 3) + 8 * (i >> 2) + 4 * h2, s_ = 32 * ts + r; As[t * 72 + s_] = (s_ <= t) ? (bf16)f2bf(a[i]) : (bf16)0; }
        } else if (F.wave == 3) {
#pragma unroll
            for (int i = 0; i < 16; ++i) { const int t = (i & 3) + 8 * (i >> 2) + 4 * h2; As[t * 72 + 32 + r] = (bf16)0; }
        }
        P4_BAR();
        { const int wt = F.wave >> 2, wv = F.wave & 3; f32x16 o;
#pragma unroll
            for (int i = 0; i < 16; ++i) o[i] = 0.f;
#pragma unroll
            for (int ks = 0; ks < 4; ++ks) { const bf16x8 af = *(const LAS bf16x8*)(As + (32 * wt + r) * 72 + 16 * ks + 8 * h2), bfr = *(const LAS bf16x8*)(iT + (32 * wv + r) * 72 + 16 * ks + 8 * h2);
                o = __builtin_amdgcn_mfma_f32_32x32x16_bf16(af, bfr, o, 0, 0, 0); }
#pragma unroll
            for (int ks = 0; ks < 8; ++ks) { const bf16x8 af = *(const LAS bf16x8*)(Qt + (32 * wt + r) * 136 + 16 * ks + 8 * h2);
                o = __builtin_amdgcn_mfma_f32_32x32x16_bf16(af, sbc[ks], o, 0, 0, 0); }
#pragma unroll
            for (int i = 0; i < 16; ++i) { const int t = 32 * wt + (i & 3) + 8 * (i >> 2) + 4 * h2; Of[t * 132 + 32 * wv + r] = o[i]; } }
        P4_BAR();
        { const int t = F.tid >> 3, sg_ = F.tid & 7; const LAS f32x4* op = (const LAS f32x4*)(Of + t * 132 + 16 * sg_); f32x4 v[4]; float ss = 0.f;
#pragma unroll
            for (int j = 0; j < 4; ++j) { v[j] = op[j]; ss += (v[j][0] * v[j][0] + v[j][1] * v[j][1]) + (v[j][2] * v[j][2] + v[j][3] * v[j][3]); }
            ss += __shfl_xor(ss, 1); ss += __shfl_xor(ss, 2); ss += __shfl_xor(ss, 4);
            const float rstd = rsqrtf(ss * (1.0f / 128.0f) + EPS); const int mrow = m0 + t;
            if (t < nv && mrow >= b * SEQ) { const int cv = hh * 128 + 16 * sg_; const f32x4* gn = (const f32x4*)(F.hg_norm_g + cv);
#pragma unroll
                for (int q = 0; q < 2; ++q) { const v4u gq = q ? gate1 : gate0; const f32x4 n0 = gn[2 * q], n1 = gn[2 * q + 1]; const f32x4 a = v[2 * q], bq = v[2 * q + 1]; v4u y;
                    y.x = pk2(a[0] * rstd * n0[0] * bflo(gq.x), a[1] * rstd * n0[1] * bfhi(gq.x)); y.y = pk2(a[2] * rstd * n0[2] * bflo(gq.y), a[3] * rstd * n0[3] * bfhi(gq.y));
                    y.z = pk2(bq[0] * rstd * n1[0] * bflo(gq.z), bq[1] * rstd * n1[1] * bfhi(gq.z)); y.w = pk2(bq[2] * rstd * n1[2] * bflo(gq.w), bq[3] * rstd * n1[3] * bfhi(gq.w));
                    *(v4u*)(F.Y + (size_t)mrow * 1024 + 512 + cv + 8 * q) = y; } } }
        P4_BAR();
    }
    asm volatile("s_waitcnt vmcnt(0)" ::: "memory");
}
__device__ __forceinline__ void final_norm_phase(Frame& F) {
    const int gw = F.vcu * NWAVES + F.wave, NGW = F.G * NWAVES;
    for (int m = gw; m < MX; m += NGW) { f32x4* xr = (f32x4*)(F.out + (size_t)m * DM) + F.lane; const f32x4* gr = (const f32x4*)F.final_g + F.lane; f32x4 v[4]; float s = 0.f;
#pragma unroll
        for (int j = 0; j < 4; ++j) { v[j] = xr[64 * j]; s += (v[j][0] * v[j][0] + v[j][1] * v[j][1]) + (v[j][2] * v[j][2] + v[j][3] * v[j][3]); }
        const float rstd = rsqrtf(wave_sum(s) * (1.0f / 1024.0f) + EPS);
#pragma unroll
        for (int j = 0; j < 4; ++j) { f32x4 o = v[j] * rstd * gr[64 * j];
            if (DBG_SKIP & (1024 | 2048 | 16384)) { const unsigned fl = *(const unsigned*)(F.ws + 64); float sc = 1.f; if (fl) { const unsigned nbad = *(const unsigned*)(F.ws + 68); const int g0 = __builtin_ctz(fl); sc = 3.f + 2.f * (float)g0; } o = o * sc; }
            if (DBG_SKIP & 32) { const int c = 4 * (F.lane + 64 * j); for (int e = 0; e < 4; ++e) o[e] = bf2f(F.U[(size_t)m * 1024 + c + e]) + bf2f(F.WinT[(size_t)(m % 6144) * 1024 + c + e]) + bf2f(F.WoT[(size_t)(m & 1023) * 1024 + c + e]); }
            else if (DBG_SKIP & 16) { const int c = 4 * (F.lane + 64 * j); for (int e = 0; e < 4; ++e) o[e] = bf2f(F.HGT[(size_t)m * 512 + ((c + e) & 511)]) + bf2f(F.GH[(size_t)m * 1024 + c + e]); }
            xr[64 * j] = o; } }
}


#define XB_TMO      128
#define XB_XCNT(j)  (256  + 64 * (j))
#define XB_XSUB(j)  (1280 + 64 * (j))
#define XB_XGEN(j)  (2304 + 64 * (j))
#define XB_TOP      3328
#define XB_TOPGEN   3392
#define XCD_BAR_WORDS 3456
#define XB_SPIN_CAP (1u << 18)

__device__ __forceinline__ unsigned xb_ld(unsigned* p)              { return __hip_atomic_load(p, __ATOMIC_RELAXED, __HIP_MEMORY_SCOPE_AGENT); }
__device__ __forceinline__ unsigned xb_add(unsigned* p, unsigned v) { return __hip_atomic_fetch_add(p, v, __ATOMIC_RELAXED, __HIP_MEMORY_SCOPE_AGENT); }
__device__ __forceinline__ unsigned xb_xcc_id() { return (unsigned)__builtin_amdgcn_s_getreg((3 << 11) | 20) & 0xFu; }
#define XB_SPIN(cond, bar) do { unsigned _sp = 0; while (cond) { __builtin_amdgcn_s_sleep(1); \
    if ((++_sp & 255u) == 0u) { if (xb_ld(&(bar)[XB_TMO])) break; if (_sp > XB_SPIN_CAP) { atomicAdd(&(bar)[XB_TMO], 1u); break; } } } } while (0)

struct XcdBarrier {
    unsigned* bar; unsigned x;
    volatile LAS unsigned* st;
};

__device__ __forceinline__ XcdBarrier xcd_barrier_post(unsigned* bar, volatile LAS unsigned* st) {
    XcdBarrier b; b.bar = bar; b.x = xb_xcc_id(); b.st = st;
    if (threadIdx.x == 0) (void)xb_add(&bar[XB_XCNT(b.x)], 1u);
    return b;
}
__device__ __forceinline__ void xcd_barrier_complete(unsigned* bar, unsigned x, unsigned& nloc, unsigned& nx) {
    const unsigned G = gridDim.x * gridDim.y * gridDim.z;
    unsigned sum, cnt, mine, sp = 0u;
    for (;;) {
        sum = 0u; cnt = 0u; mine = 0u;
#pragma unroll
        for (unsigned j = 0; j < 16; ++j) { const unsigned c = xb_ld(&bar[XB_XCNT(j)]); sum += c; cnt += (c > 0u) ? 1u : 0u; mine = (j == x) ? c : mine; }
        if (sum == G) break;
        __builtin_amdgcn_s_sleep(1);
        if ((++sp & 255u) == 0u) { if (xb_ld(&bar[XB_TMO])) break; if (sp > XB_SPIN_CAP) { atomicAdd(&bar[XB_TMO], 1u); break; } }
    }
    nloc = mine > 0u ? mine : 1u; nx = cnt > 0u ? cnt : 1u;
}

__device__ __forceinline__ void xcd_barrier(const XcdBarrier& b) {
    asm volatile("s_waitcnt vmcnt(0)" ::: "memory");
    __syncthreads();
    if (threadIdx.x == 0) {
        unsigned* bar = b.bar;
        __builtin_amdgcn_s_waitcnt(0);
        unsigned nloc = b.st[0], nx = b.st[1];
        if (nloc == 0u) { xcd_barrier_complete(bar, b.x, nloc, nx); b.st[0] = nloc; b.st[1] = nx; }
        const unsigned old = xb_add(&bar[XB_XSUB(b.x)], 1u);
        const unsigned gen = old / nloc;
        if (old + 1u == (gen + 1u) * nloc) {
            __builtin_amdgcn_fence(__ATOMIC_RELEASE, "agent");
            asm volatile("s_waitcnt vmcnt(0)" ::: "memory");
            const unsigned og = xb_add(&bar[XB_TOP], 1u);
            const unsigned tg = og / nx;
            if (og + 1u == (tg + 1u) * nx) xb_add(&bar[XB_TOPGEN], 1u);
            else XB_SPIN(xb_ld(&bar[XB_TOPGEN]) == tg, bar);
            __builtin_amdgcn_fence(__ATOMIC_ACQUIRE, "agent");
            xb_add(&bar[XB_XGEN(b.x)], 1u);
            asm volatile("s_waitcnt vmcnt(0)" ::: "memory");
        } else {
            XB_SPIN(xb_ld(&bar[XB_XGEN(b.x)]) == gen, bar);
            __builtin_amdgcn_fence(__ATOMIC_ACQUIRE, "agent");
            asm volatile("s_waitcnt vmcnt(0)" ::: "memory");
        }
    }
    __syncthreads();
}


struct EpiResNorm {
    static constexpr bool PERM = true, AFTER_DRAIN = false, HAS_MID = false;
    const float* x; float* out; const float* fg; float* rowss; const XcdBarrier* bar;
    __device__ __forceinline__ void operator()(f32x4 (&acc)[2][2][4][2], const pg8::Unit& u, int wr, int wc, int fr, int fq) const {
        const int row0 = u.pm * 256 + wr * 64 + fr, col0 = u.pn * 256 + wc * 32 + 8 * fq;
#pragma unroll
        for (int ai = 0; ai < 2; ++ai)
#pragma unroll
            for (int m = 0; m < 4; ++m) { const int row = row0 + ai * 128 + m * 16; float ss = 0.f;
#pragma unroll
                for (int bj = 0; bj < 2; ++bj) { const size_t off = (size_t)row * 1024 + col0 + bj * 128; const f32x4 x0 = *(const f32x4*)(x + off), x1 = *(const f32x4*)(x + off + 4);
                    f32x4 a = acc[ai][bj][m][0] + x0, b = acc[ai][bj][m][1] + x1; acc[ai][bj][m][0] = a; acc[ai][bj][m][1] = b;
                    ss += (a[0] * a[0] + a[1] * a[1]) + (a[2] * a[2] + a[3] * a[3]) + (b[0] * b[0] + b[1] * b[1]) + (b[2] * b[2] + b[3] * b[3]); }
                ss += __shfl_xor(ss, 16); ss += __shfl_xor(ss, 32);
                if (fq == 0) __hip_atomic_fetch_add(rowss + row, ss, __ATOMIC_RELAXED, __HIP_MEMORY_SCOPE_AGENT); }
        xcd_barrier(*bar);
        f32x4 g0[2], g1[2];
#pragma unroll
        for (int bj = 0; bj < 2; ++bj) { g0[bj] = *(const f32x4*)(fg + col0 + bj * 128); g1[bj] = *(const f32x4*)(fg + col0 + bj * 128 + 4); }
#pragma unroll
        for (int ai = 0; ai < 2; ++ai)
#pragma unroll
            for (int m = 0; m < 4; ++m) { const int row = row0 + ai * 128 + m * 16; const float rstd = rsqrtf(__hip_atomic_load(rowss + row, __ATOMIC_RELAXED, __HIP_MEMORY_SCOPE_AGENT) * (1.0f / 1024.0f) + EPS);
#pragma unroll
                for (int bj = 0; bj < 2; ++bj) { const size_t off = (size_t)row * 1024 + col0 + bj * 128;
                    *(f32x4*)(out + off) = acc[ai][bj][m][0] * rstd * g0[bj]; *(f32x4*)(out + off + 4) = acc[ai][bj][m][1] * rstd * g1[bj]; } }
    }
};

#ifndef MK_N_LAUNCHES
#define MK_N_LAUNCHES 1
#endif
constexpr int N_PHASES = 7;
struct Args { const float* in[10]; float* out; unsigned char* ws; int ph_lo, ph_hi; };
__global__ void __launch_bounds__(NWAVES * 64, 2) mk_fwd(Args args) {
    extern __shared__ __attribute__((aligned(16))) unsigned char lds[];
    Frame F;
    F.lds = (LAS unsigned char*)lds;
    F.tid = threadIdx.x; F.lane = F.tid & 63; F.wave = __builtin_amdgcn_readfirstlane(F.tid >> 6);
    F.G = gridDim.x; { const int bx = blockIdx.x; F.vcu = (F.G % 8 == 0) ? (bx % 8) * (F.G / 8) + bx / 8 : bx; }
    unsigned char* ws = args.ws; F.ws = ws;
    F.x = args.in[0]; F.meta = args.in[1]; F.norm_g = args.in[2]; F.w_in = args.in[3]; F.w_sb_out = args.in[4]; F.w_hg_out = args.in[5]; F.w_out = args.in[6];
    F.hg_norm_g = args.in[7]; F.lbl = args.in[8]; F.final_g = args.in[9]; F.out = args.out;
    F.WinT = (bf16*)(ws + WS_WIN); F.WsbT = (bf16*)(ws + WS_WSB); F.WhgT = (bf16*)(ws + WS_WHG); F.WoT = (bf16*)(ws + WS_WO);
    F.U = (bf16*)(ws + WS_U); F.Y = (bf16*)(ws + WS_U); F.Q = (bf16*)(ws + WS_Q); F.K = (bf16*)(ws + WS_K); F.V = (bf16*)(ws + WS_V); F.SG = (bf16*)(ws + WS_SG);
    F.HQ = (bf16*)(ws + WS_HQ); F.HI = (bf16*)(ws + WS_HI); F.HGT = (bf16*)(ws + WS_HGT); F.Gf = (bf16*)(ws + WS_G); F.GH = (bf16*)(ws + WS_GH); F.DC = (float*)(ws + WS_DC);
    F.T1 = (bf16*)(ws + WS_T1); F.MG = (bf16*)(ws + WS_MG); F.ST = (bf16*)((unsigned char*)args.out + DO_ST); F.GS = (bf16*)((unsigned char*)args.out + DO_GS);
    const int lo = args.ph_lo, hi = args.ph_hi;
    volatile LAS unsigned* MISC = (volatile LAS unsigned*)(F.lds + 131072 + 320);
    if (F.tid < 32) MISC[F.tid] = 0u;
    __syncthreads();
    XcdBarrier bar; bar.bar = (unsigned*)(ws + 16384); bar.x = 0; bar.st = nullptr;
    if (MK_N_LAUNCHES == 1) bar = xcd_barrier_post((unsigned*)(ws + 16384), MISC + 8);
    if (DBG_SKIP & 256) { for (int i = F.tid; i < LDS_BYTES / 16; i += NWAVES * 64) ((LAS v4u*)F.lds)[i] = (v4u){0u, 0u, 0u, 0u}; __syncthreads(); }
#define IN(k) (lo <= (k) && (k) < hi)
#define SEAM(k) do { if (IN(k) && IN((k) + 1)) { xcd_barrier(bar); } } while (0)
    if (args.ph_hi < 0) cg::this_grid().sync();
    if (IN(0)) { p0_prologue(F); if (DBG_SKIP & (1 << 23)) { __syncthreads(); p0_prologue(F); } } SEAM(0);
    if (IN(1)) {
        pg8::Gemm g{F.U, F.WinT, MX, INC, 1024}; pg8::StaticOrder S; S.init(MX, INC, F.G, (int)blockIdx.x);
        EpiProj E{F.Q, F.K, F.V, F.SG, F.HQ, F.HI, F.HGT, F.GS, F.GH, F.Gf, F.lbl, F.ws};
        pg8::gemm_phase<EpiProj, pg8::StaticOrder, true, true>(F.lds, g, S, E);
        if (DBG_SKIP & (1 << 22)) { __syncthreads(); pg8::gemm_phase<EpiProj, pg8::StaticOrder, true, true>(F.lds, g, S, E); }
    } SEAM(1);
    if (DBG_SKIP & 128) {
        pg8::StaticOrder S; S.init(MX, INC, F.G, (int)blockIdx.x); pg8::Unit u;
        for (int i = 0; S.next(i, u); ++i) { if (u.pn < 20) continue;
            for (int e = F.tid; e < 256 * 256; e += 512) { const int rr = e >> 8, cc = e & 255; const size_t off = (size_t)(u.pm * 256 + rr) * 1024 + (u.pn - 20) * 256 + cc; F.out[off] = bf2f(F.GH[off]); } }
        return;
    }
    if (IN(2) && !(DBG_SKIP & (64 | 16384))) { hgrn_local_phase(F); attn_phase(F); if (DBG_SKIP & (1 << 20)) { __syncthreads(); hgrn_local_phase(F); } if (DBG_SKIP & (1 << 19)) { __syncthreads(); attn_phase_t<1>(F); } if (DBG_SKIP & (1 << 18)) { __syncthreads(); attn_phase_t<2>(F); } } SEAM(2);

    if (IN(3) && !(DBG_SKIP & (64 | 16384))) { hgrn_scan_phase(F, F.ST); if (DBG_SKIP & (1 << 28)) { __syncthreads(); hgrn_scan_phase(F, F.Q); } } SEAM(3);
    if (IN(4) && !(DBG_SKIP & (64 | 16384))) { hgrn_out_phase(F); if (DBG_SKIP & (1 << 21)) { __syncthreads(); hgrn_out_phase(F); } } SEAM(4);
    if (IN(5) && !(DBG_SKIP & (64 | 2048 | 16384))) {
        pg8::Gemm g{F.Y, F.WsbT, MX, 1024, 1024}; pg8::StaticOrder S; S.init(MX, 1024, F.G, (int)blockIdx.x); EpiMerge E{(const unsigned char*)F.GS, (const unsigned char*)F.GH, F.MG};
        pg8::gemm_phase<EpiMerge, pg8::StaticOrder, true, true>(F.lds, g, S, E);
    } SEAM(5);
    if (IN(6) && (DBG_SKIP & (2048 | 16384))) { for (size_t i = (size_t)blockIdx.x * 512 + F.tid; i < (size_t)MX * 256; i += (size_t)F.G * 512) ((f32x4*)F.out)[i] = ((const f32x4*)F.x)[i]; }
    const bool fuse_norm = (MK_N_LAUNCHES == 1) && (F.G == 256);
    if (IN(6) && fuse_norm) {
        pg8::Gemm g{F.MG, F.WoT, MX, 1024, 1024}; pg8::StaticOrder S; S.init(MX, 1024, F.G, (int)blockIdx.x); EpiResNorm E{F.x, F.out, F.final_g, (float*)(ws + 65536), &bar};
        pg8::gemm_phase<EpiResNorm, pg8::StaticOrder, true, true>(F.lds, g, S, E);
    }
    if (IN(6) && !fuse_norm) {
        pg8::Gemm g{F.MG, F.WoT, MX, 1024, 1024}; pg8::StaticOrder S; S.init(MX, 1024, F.G, (int)blockIdx.x); EpiRes E{F.x, F.out};
        pg8::gemm_phase<EpiRes, pg8::StaticOrder, true, true>(F.lds, g, S, E);
    }
    if (!fuse_norm) { SEAM(6); }
    if (IN(7) && !fuse_norm) { final_norm_phase(F); }

#undef IN
#undef SEAM
}

extern "C" void kernel_launch(void* const* d_in, const int* in_sizes, int n_in, void* d_out, int out_size, void* d_ws, size_t ws_size, hipStream_t stream) {
    static int grid = 0;
    if (grid == 0) {
        if (n_in != 10 || in_sizes[0] != MX * DM || out_size != MX * DM || ws_size < WS_END) { fprintf(stderr, "kernel_launch: unexpected shapes (n_in %d in0 %d out %d ws %zu)\n", n_in, n_in > 0 ? in_sizes[0] : -1, out_size, ws_size); grid = -1; return; }
        int dev = 0, cus = 0, per_cu = 0;
        if (hipGetDevice(&dev) != hipSuccess || hipDeviceGetAttribute(&cus, hipDeviceAttributeMultiprocessorCount, dev) != hipSuccess) { grid = -1; return; }
        if (hipFuncSetAttribute((const void*)mk_fwd, hipFuncAttributeMaxDynamicSharedMemorySize, LDS_BYTES) != hipSuccess) { fprintf(stderr, "kernel_launch: hipFuncSetAttribute failed\n"); grid = -1; return; }
        if (hipOccupancyMaxActiveBlocksPerMultiprocessor(&per_cu, (const void*)mk_fwd, NWAVES * 64, LDS_BYTES) != hipSuccess || per_cu < 1) { fprintf(stderr, "kernel_launch: occupancy query says %d\n", per_cu); per_cu = 1; }
        (void)hipGetLastError();
        grid = cus;
    }
    if (grid < 0) return;
    Args a{};
    for (int i = 0; i < 10; ++i) a.in[i] = (const float*)d_in[i];
    a.out = (float*)d_out; a.ws = (unsigned char*)d_ws;
#if MK_N_LAUNCHES == 1
    (void)hipMemsetAsync(d_ws, 0, 131072, stream);
    a.ph_lo = 0; a.ph_hi = N_PHASES + 1;
    void* kargs[] = {&a};
    hipError_t e = hipLaunchCooperativeKernel((const void*)mk_fwd, dim3(grid), dim3(NWAVES * 64), kargs, LDS_BYTES, stream);
    if (e != hipSuccess) fprintf(stderr, "kernel_launch: cooperative launch failed: %s (grid %d)\n", hipGetErrorString(e), grid);
#else
    for (int p = 0; p <= N_PHASES; ++p) { if ((DBG_SKIP & 32) && p >= 1 && p <= 6) continue; a.ph_lo = p; a.ph_hi = p + 1; hipLaunchKernelGGL(mk_fwd, dim3(grid), dim3(NWAVES * 64), LDS_BYTES, stream, a); }
#endif
}
```

```cpp
#include <hip/hip_runtime.h>
#include <hip/hip_cooperative_groups.h>
#include <cstdio>
#include <cstdint>
namespace cg = cooperative_groups;
#ifndef DBG_SKIP
#define DBG_SKIP 0
#endif
namespace pg8 {
#define PG8_LAS __attribute__((address_space(3)))
typedef unsigned short bf16_t;
typedef short bf16x8 __attribute__((ext_vector_type(8)));
typedef float f32x4 __attribute__((ext_vector_type(4)));
typedef unsigned u32x4 __attribute__((ext_vector_type(4)));
constexpr int BM = 256, BK = 64, HALF = 128, HTB = HALF * BK * 2  , STAGE_BYTES = 8 * HTB, NXCD = 8, WGM = 8;

__host__ __device__ __forceinline__ int lds_byte(int r, int c) { const int st = (r >> 4) * 2 + (c >> 5), rr = r & 15, cc = c & 31, ob = rr * 64 + cc * 2; return st * 1024 + (ob ^ (((ob >> 9) & 1) << 5)); }
__host__ __device__ __forceinline__ void stage_rc(int b, int& R, int& C) { const int st = b / 1024, sb = b % 1024, swz = sb ^ (((sb >> 9) & 1) << 5); R = (st >> 1) * 16 + swz / 64; C = (st & 1) * 32 + (swz % 64) / 2; }
__host__ __device__ __forceinline__ int perm32(int rho) { const int n = rho >> 4, i = rho & 15; return 8 * (i >> 2) + 4 * n + (i & 3); }

struct Unit { int pm, pn; };
struct Gemm { const bf16_t* A; const bf16_t* Bt; int M, N, K; };

struct StaticOrder {
    int nM, nN, nwg, G, c;
    __host__ __device__ void init(int M, int N, int G_, int c_) { nM = M / BM; nN = N / BM; nwg = nM * nN; G = G_; c = c_; }
    __host__ __device__ bool next(int i, Unit& u) const {
        const long L = (long)i * G + c; if (L >= nwg) return false;
        int wgid = (int)L; { const int q = nwg / NXCD, r = nwg % NXCD, xcd = wgid % NXCD, off = wgid / NXCD; wgid = (xcd < r ? xcd * (q + 1) : r * (q + 1) + (xcd - r) * q) + off; }
        const int nig = WGM * nN, gid = wgid / nig, fm = gid * WGM, gsz = (nM - fm) < WGM ? (nM - fm) : WGM;
        u.pm = fm + ((wgid % nig) % gsz); u.pn = (wgid % nig) / gsz; if (DBG_SKIP & 65536) u.pn = nN - 1 - u.pn; return true;
    }
    __device__ __forceinline__ void a_ready(const Unit&) const {}
    __device__ __forceinline__ void done(const Unit&) const {}
};

__device__ __forceinline__ unsigned cvt_pk_bf16(float lo, float hi) { unsigned r; asm volatile("v_cvt_pk_bf16_f32 %0, %1, %2" : "=v"(r) : "v"(lo), "v"(hi)); return r; }
typedef float f32x2 __attribute__((ext_vector_type(2)));
template <class Epi, class Sched, bool ALIGN_EPI = false, bool SP2 = false>
__device__ __forceinline__ void gemm_phase(PG8_LAS unsigned char* lds, const Gemm g, const Sched& S, const Epi& E) {
    const int tid = threadIdx.x, wid = __builtin_amdgcn_readfirstlane(tid >> 6), lane = tid & 63, wr = wid >> 2, wc = wid & 3, fr = lane & 15, fq = lane >> 4;
    const int K = g.K, nt = K / BK;
    unsigned voffA[2], voffB[2];
#pragma unroll
    for (int i = 0; i < 2; ++i) { int R, C; stage_rc(tid * 16 + i * 8192, R, C); const int Rb = Epi::PERM ? ((R & ~31) + perm32(R & 31)) : R;
        voffA[i] = (unsigned)(R * K + C) * 2u; voffB[i] = (unsigned)(Rb * K + C) * 2u; }
    const size_t kstep = (size_t)(BK * 2);
    const size_t hstep = (size_t)HALF * K * 2;
    const size_t tstep = 2 * hstep;
    const unsigned ldsw = (unsigned)wid * 1024u;
    const int aoff = lds_byte(wr * 64 + fr, fq * 8), boff = lds_byte(wc * 32 + fr, fq * 8);
#define PG8_SA(b, h) (((b) * 2 + (h)) * HTB)
#define PG8_SB(b, h) ((4 + (b) * 2 + (h)) * HTB)
#define PG8_STAGE(bufoff, gbase, voff) do { _Pragma("unroll") for (int _i = 0; _i < 2; ++_i) \
        __builtin_amdgcn_global_load_lds((const unsigned*)((const char*)(gbase) + (voff)[_i]), (PG8_LAS unsigned*)(lds + (bufoff) + ldsw + _i * 8192), 16, 0, 0); } while (0)
#define PG8_LDA(dst, b, h) do { _Pragma("unroll") for (int m = 0; m < 4; ++m) _Pragma("unroll") for (int k = 0; k < 2; ++k) dst[m][k] = *(const PG8_LAS bf16x8*)(lds + PG8_SA(b, h) + aoff + m * 2048 + k * 1024); } while (0)
#define PG8_LDB(dst, b, h) do { _Pragma("unroll") for (int n = 0; n < 2; ++n) _Pragma("unroll") for (int k = 0; k < 2; ++k) dst[n][k] = *(const PG8_LAS bf16x8*)(lds + PG8_SB(b, h) + boff + n * 2048 + k * 1024); } while (0)
#define PG8_MMA(ai, bj, At, Bt) do { __builtin_amdgcn_s_setprio(1); _Pragma("unroll") for (int m = 0; m < 4; ++m) _Pragma("unroll") for (int n = 0; n < 2; ++n) _Pragma("unroll") for (int k = 0; k < 2; ++k) \
        acc[ai][bj][m][n] = __builtin_amdgcn_mfma_f32_16x16x32_bf16(Bt[n][k], At[m][k], acc[ai][bj][m][n], 0, 0, 0); __builtin_amdgcn_s_setprio(0); } while (0)
#define PG8_WAIT_V(n) asm volatile("s_waitcnt vmcnt(" #n ")" ::: "memory")
#define PG8_WAIT_L(n) asm volatile("s_waitcnt lgkmcnt(" #n ")" ::: "memory")
#define PG8_BAR __builtin_amdgcn_s_barrier()
#define PG8_SCHED __builtin_amdgcn_sched_barrier(0)
    Unit cur, nxt; int ui = 0;
    if (!S.next(0, cur)) return;
    f32x4 acc[2][2][4][2];
#pragma unroll
    for (int a = 0; a < 2; ++a)
#pragma unroll
        for (int b = 0; b < 2; ++b)
#pragma unroll
            for (int m = 0; m < 4; ++m)
#pragma unroll
                for (int n = 0; n < 2; ++n) acc[a][b][m][n] = (f32x4){0.f, 0.f, 0.f, 0.f};
    bf16x8 At[4][2], B0[2][2], B1[2][2];
    const char* cA = (const char*)g.A + (size_t)cur.pm * tstep; const char* cB = (const char*)g.Bt + (size_t)cur.pn * tstep;
    S.a_ready(cur);
    if constexpr (SP2) {
        PG8_STAGE(PG8_SB(0, 0), cB, voffB); PG8_STAGE(PG8_SB(0, 1), cB + hstep, voffB); PG8_STAGE(PG8_SA(0, 0), cA, voffA); PG8_STAGE(PG8_SA(0, 1), cA + hstep, voffA);
        if (wr == 1) PG8_BAR;
        PG8_WAIT_V(2); PG8_BAR;
        PG8_STAGE(PG8_SB(1, 0), cB + kstep, voffB); PG8_STAGE(PG8_SA(1, 0), cA + kstep, voffA); PG8_STAGE(PG8_SB(1, 1), cB + hstep + kstep, voffB);
        PG8_WAIT_V(6); PG8_BAR;
    } else {
        PG8_STAGE(PG8_SB(0, 0), cB, voffB); PG8_STAGE(PG8_SA(0, 0), cA, voffA); PG8_STAGE(PG8_SB(0, 1), cB + hstep, voffB); PG8_STAGE(PG8_SA(0, 1), cA + hstep, voffA);
        if (wr == 1) PG8_BAR;
        PG8_WAIT_V(4); PG8_BAR;
        PG8_STAGE(PG8_SB(1, 0), cB + kstep, voffB); PG8_STAGE(PG8_SA(1, 0), cA + kstep, voffA); PG8_STAGE(PG8_SB(1, 1), cB + hstep + kstep, voffB);
        PG8_WAIT_V(6); PG8_BAR;
    }
    for (;;) {
        const bool has_next = S.next(ui + 1, nxt);
        const char* nA = has_next ? (const char*)g.A + (size_t)nxt.pm * tstep : cA; const char* nB = has_next ? (const char*)g.Bt + (size_t)nxt.pn * tstep : cB;
        for (int half_ = 0; half_ < (Epi::HAS_MID ? 2 : 1); ++half_) {
        if constexpr (Epi::HAS_MID) { if (half_ == 1) { E.mid(acc, cur, wr, wc, fr, fq); asm volatile("" ::: "memory"); } }
        for (int t = Epi::HAS_MID ? half_ * (nt >> 1) : 0; t < (Epi::HAS_MID ? (half_ + 1) * (nt >> 1) : nt); t += 2) {
            const bool last = (t == nt - 2);
            const char* a1 = cA + (size_t)(t + 1) * kstep;
            const char* a2 = last ? nA : cA + (size_t)(t + 2) * kstep; const char* b2 = last ? nB : cB + (size_t)(t + 2) * kstep;
            const char* a3 = a2 + kstep; const char* b3 = b2 + kstep;
            if (last && has_next) S.a_ready(nxt);
            if constexpr (SP2) {
            PG8_LDB(B0, 0, 0); PG8_LDB(B1, 0, 1); PG8_SCHED; PG8_LDA(At, 0, 0); PG8_STAGE(PG8_SA(1, 1), a1 + hstep, voffA);
            PG8_WAIT_V(8); PG8_WAIT_L(0); PG8_BAR; PG8_MMA(0, 0, At, B0); PG8_MMA(0, 1, At, B1); PG8_BAR; PG8_SCHED;
            PG8_LDA(At, 0, 1); PG8_STAGE(PG8_SB(0, 0), b2, voffB); PG8_STAGE(PG8_SB(0, 1), b2 + hstep, voffB); PG8_STAGE(PG8_SA(0, 0), a2, voffA);
            PG8_WAIT_V(8); PG8_WAIT_L(0); PG8_BAR; PG8_MMA(1, 0, At, B0); PG8_MMA(1, 1, At, B1); PG8_BAR; PG8_SCHED;
            PG8_LDB(B0, 1, 0); PG8_LDB(B1, 1, 1); PG8_SCHED; PG8_LDA(At, 1, 0); PG8_STAGE(PG8_SA(0, 1), a2 + hstep, voffA);
            PG8_WAIT_V(8); PG8_WAIT_L(0); PG8_BAR; PG8_MMA(0, 0, At, B0); PG8_MMA(0, 1, At, B1); PG8_BAR; PG8_SCHED;
            PG8_LDA(At, 1, 1); PG8_STAGE(PG8_SB(1, 0), b3, voffB); PG8_STAGE(PG8_SB(1, 1), b3 + hstep, voffB); PG8_STAGE(PG8_SA(1, 0), a3, voffA);
            PG8_WAIT_V(8); PG8_WAIT_L(0); PG8_BAR; PG8_MMA(1, 0, At, B0); PG8_MMA(1, 1, At, B1); PG8_BAR; PG8_SCHED;
            } else {
            PG8_LDB(B0, 0, 0); PG8_SCHED; PG8_LDA(At, 0, 0); PG8_STAGE(PG8_SA(1, 1), a1 + hstep, voffA);
            PG8_WAIT_L(8); PG8_BAR; PG8_WAIT_L(0); PG8_MMA(0, 0, At, B0); PG8_BAR; PG8_SCHED;
            PG8_LDB(B1, 0, 1); PG8_STAGE(PG8_SB(0, 0), b2, voffB);
            PG8_BAR; PG8_WAIT_L(0); PG8_MMA(0, 1, At, B1); PG8_BAR;
            PG8_LDA(At, 0, 1); PG8_STAGE(PG8_SA(0, 0), a2, voffA);
            PG8_BAR; PG8_WAIT_L(0); PG8_MMA(1, 0, At, B0); PG8_BAR; PG8_SCHED;
            PG8_STAGE(PG8_SB(0, 1), b2 + hstep, voffB);
            PG8_WAIT_V(6); PG8_BAR; PG8_MMA(1, 1, At, B1); PG8_BAR;
            PG8_LDB(B0, 1, 0); PG8_SCHED; PG8_LDA(At, 1, 0); PG8_STAGE(PG8_SA(0, 1), a2 + hstep, voffA);
            PG8_WAIT_L(8); PG8_BAR; PG8_WAIT_L(0); PG8_MMA(0, 0, At, B0); PG8_BAR; PG8_SCHED;
            PG8_LDB(B1, 1, 1); PG8_STAGE(PG8_SB(1, 0), b3, voffB);
            PG8_BAR; PG8_WAIT_L(0); PG8_MMA(0, 1, At, B1); PG8_BAR;
            PG8_LDA(At, 1, 1); PG8_STAGE(PG8_SA(1, 0), a3, voffA);
            PG8_BAR; PG8_WAIT_L(0); PG8_MMA(1, 0, At, B0); PG8_BAR; PG8_SCHED;
            PG8_STAGE(PG8_SB(1, 1), b3 + hstep, voffB);
            PG8_WAIT_V(6); PG8_BAR; PG8_MMA(1, 1, At, B1); PG8_BAR;
            }
        }
        }
        if constexpr (ALIGN_EPI) { if (wr == 0) PG8_BAR; }
        if constexpr (!Epi::AFTER_DRAIN) { E(acc, cur, wr, wc, fr, fq); S.done(cur); }
        if (!has_next) break;
#pragma unroll
        for (int a = 0; a < 2; ++a)
#pragma unroll
            for (int b = 0; b < 2; ++b)
#pragma unroll
                for (int m = 0; m < 4; ++m)
#pragma unroll
                    for (int n = 0; n < 2; ++n) acc[a][b][m][n] = (f32x4){0.f, 0.f, 0.f, 0.f};
        cur = nxt; cA = nA; cB = nB; ++ui;
        if constexpr (ALIGN_EPI) { if (wr == 1) PG8_BAR; }
    }
    PG8_WAIT_V(0);
    if constexpr (!ALIGN_EPI) { if (wr == 0) PG8_BAR; }
    PG8_BAR;
    if constexpr (Epi::AFTER_DRAIN) { E.fused(acc, cur, wr, wc, fr, fq, lds, wid, lane); S.done(cur); }
#undef PG8_SA
#undef PG8_SB
#undef PG8_STAGE
#undef PG8_LDA
#undef PG8_LDB
#undef PG8_MMA
#undef PG8_WAIT_V
#undef PG8_WAIT_L
#undef PG8_BAR
#undef PG8_SCHED
}
template <class Epi, class Sched>
__device__ __forceinline__ void gemm_phase2(PG8_LAS unsigned char* lds, const Gemm g, const Sched& S, const Epi& E) {
    const int tid = threadIdx.x, wid = __builtin_amdgcn_readfirstlane(tid >> 6), lane = tid & 63, wr = wid >> 2, wc = wid & 3, fr = lane & 15, fq = lane >> 4;
    const int K = g.K, nt = K / BK;
    unsigned voffA[2], voffB[2];
#pragma unroll
    for (int i = 0; i < 2; ++i) { int R, C; stage_rc(tid * 16 + i * 8192, R, C); const int Rb = Epi::PERM ? ((R & ~31) + perm32(R & 31)) : R;
        voffA[i] = (unsigned)(R * K + C) * 2u; voffB[i] = (unsigned)(Rb * K + C) * 2u; }
    const size_t kstep = (size_t)(BK * 2), hstep = (size_t)HALF * K * 2, tstep = 2 * hstep;
    const unsigned ldsw = (unsigned)wid * 1024u;
    const int aoff = lds_byte(wr * 64 + fr, fq * 8), boff = lds_byte(wc * 32 + fr, fq * 8);
#define G2_SA(b, h) (((b) * 2 + (h)) * HTB)
#define G2_SB(b, h) ((4 + (b) * 2 + (h)) * HTB)
#define G2_STAGE(bufoff, gbase, voff) do { _Pragma("unroll") for (int _i = 0; _i < 2; ++_i) \
        __builtin_amdgcn_global_load_lds((const unsigned*)((const char*)(gbase) + (voff)[_i]), (PG8_LAS unsigned*)(lds + (bufoff) + ldsw + _i * 8192), 16, 0, 0); } while (0)
#define G2_STAGE4(b, pa, pb) do { G2_STAGE(G2_SB(b, 0), (pb), voffB); G2_STAGE(G2_SB(b, 1), (pb) + hstep, voffB); G2_STAGE(G2_SA(b, 0), (pa), voffA); G2_STAGE(G2_SA(b, 1), (pa) + hstep, voffA); } while (0)
#define G2_LDA(dst, b, h) do { _Pragma("unroll") for (int m = 0; m < 4; ++m) _Pragma("unroll") for (int k = 0; k < 2; ++k) dst[m][k] = *(const PG8_LAS bf16x8*)(lds + G2_SA(b, h) + aoff + m * 2048 + k * 1024); } while (0)
#define G2_LDB(dst, b, h) do { _Pragma("unroll") for (int n = 0; n < 2; ++n) _Pragma("unroll") for (int k = 0; k < 2; ++k) dst[n][k] = *(const PG8_LAS bf16x8*)(lds + G2_SB(b, h) + boff + n * 2048 + k * 1024); } while (0)
#define G2_MMA(ai, bj, At, Bt) do { _Pragma("unroll") for (int m = 0; m < 4; ++m) _Pragma("unroll") for (int n = 0; n < 2; ++n) _Pragma("unroll") for (int k = 0; k < 2; ++k) \
        acc[ai][bj][m][n] = __builtin_amdgcn_mfma_f32_16x16x32_bf16(Bt[n][k], At[m][k], acc[ai][bj][m][n], 0, 0, 0); } while (0)
#define G2_COMPUTE(b) do { G2_LDB(B0, b, 0); G2_LDB(B1, b, 1); G2_LDA(At, b, 0); __builtin_amdgcn_s_setprio(1); G2_MMA(0, 0, At, B0); G2_MMA(0, 1, At, B1); G2_LDA(At, b, 1); G2_MMA(1, 0, At, B0); G2_MMA(1, 1, At, B1); __builtin_amdgcn_s_setprio(0); } while (0)
#define G2_SYNC() do { asm volatile("s_waitcnt vmcnt(0) lgkmcnt(0)" ::: "memory"); __builtin_amdgcn_s_barrier(); __builtin_amdgcn_s_sleep(8); __builtin_amdgcn_s_barrier(); asm volatile("" ::: "memory"); } while (0)
    Unit cur, nxt; int ui = 0;
    if (!S.next(0, cur)) return;
    f32x4 acc[2][2][4][2];
#pragma unroll
    for (int a = 0; a < 2; ++a)
#pragma unroll
        for (int b = 0; b < 2; ++b)
#pragma unroll
            for (int m = 0; m < 4; ++m)
#pragma unroll
                for (int n = 0; n < 2; ++n) acc[a][b][m][n] = (f32x4){0.f, 0.f, 0.f, 0.f};
    bf16x8 At[4][2], B0[2][2], B1[2][2];
    const char* cA = (const char*)g.A + (size_t)cur.pm * tstep; const char* cB = (const char*)g.Bt + (size_t)cur.pn * tstep;
    G2_SYNC();
    G2_STAGE4(0, cA, cB);
    G2_SYNC();
    for (;;) {
        const bool has_next = S.next(ui + 1, nxt);
        const char* nA = has_next ? (const char*)g.A + (size_t)nxt.pm * tstep : cA; const char* nB = has_next ? (const char*)g.Bt + (size_t)nxt.pn * tstep : cB;
        for (int t = 0; t < nt; t += 2) {
            const bool last = (t == nt - 2);
            { const char* a1 = cA + (size_t)(t + 1) * kstep; const char* b1 = cB + (size_t)(t + 1) * kstep; G2_STAGE4(1, a1, b1); }
            G2_COMPUTE(0);
            G2_SYNC();
            if (!last || has_next) { const char* a2 = last ? nA : cA + (size_t)(t + 2) * kstep; const char* b2 = last ? nB : cB + (size_t)(t + 2) * kstep; G2_STAGE4(0, a2, b2); }
            G2_COMPUTE(1);
            G2_SYNC();
        }
        E(acc, cur, wr, wc, fr, fq);
        if (!has_next) break;
#pragma unroll
        for (int a = 0; a < 2; ++a)
#pragma unroll
            for (int b = 0; b < 2; ++b)
#pragma unroll
                for (int m = 0; m < 4; ++m)
#pragma unroll
                    for (int n = 0; n < 2; ++n) acc[a][b][m][n] = (f32x4){0.f, 0.f, 0.f, 0.f};
        cur = nxt; cA = nA; cB = nB; ++ui;
    }
    asm volatile("s_waitcnt vmcnt(0)" ::: "memory");
#undef G2_SA
#undef G2_SB
#undef G2_STAGE
#undef G2_STAGE4
#undef G2_LDA
#undef G2_LDB
#undef G2_MMA
#undef G2_COMPUTE
#undef G2_SYNC
}
template <class Epi, class Sched>
__device__ __forceinline__ void gemm_phase3(PG8_LAS unsigned char* lds, const Gemm g, const Sched& S, const Epi& E) {
    typedef int i32x4 __attribute__((ext_vector_type(4)));
    const int tid = threadIdx.x, wid = __builtin_amdgcn_readfirstlane(tid >> 6), lane = tid & 63, wr = wid >> 2, wc = wid & 3, fr = lane & 15, fq = lane >> 4;
    const int K = g.K, nt = K / BK;
    unsigned voffA[2], voffB[2];
#pragma unroll
    for (int i = 0; i < 2; ++i) { int R, C; stage_rc(tid * 16 + i * 8192, R, C); const int Rb = Epi::PERM ? ((R & ~31) + perm32(R & 31)) : R;
        voffA[i] = (unsigned)(R * K + C) * 2u; voffB[i] = (unsigned)(Rb * K + C) * 2u; }
    const size_t kstep = (size_t)(BK * 2), hstep = (size_t)HALF * K * 2, tstep = 2 * hstep;
    const int aoff = lds_byte(wr * 64 + fr, fq * 8), boff = lds_byte(wc * 32 + fr, fq * 8);
#define G3_SA(b, h) (((b) * 2 + (h)) * HTB)
#define G3_SB(b, h) ((4 + (b) * 2 + (h)) * HTB)
#define G3_ISSUE(pa, pb) do { _Pragma("unroll") for (int h = 0; h < 2; ++h) _Pragma("unroll") for (int i = 0; i < 2; ++i) { \
        sa[h * 2 + i] = *(const i32x4*)((pa) + h * hstep + voffA[i]); sb[h * 2 + i] = *(const i32x4*)((pb) + h * hstep + voffB[i]); } } while (0)
#define G3_WRITE(b) do { _Pragma("unroll") for (int h = 0; h < 2; ++h) _Pragma("unroll") for (int i = 0; i < 2; ++i) { \
        *(PG8_LAS i32x4*)(lds + G3_SA(b, h) + tid * 16 + i * 8192) = sa[h * 2 + i]; *(PG8_LAS i32x4*)(lds + G3_SB(b, h) + tid * 16 + i * 8192) = sb[h * 2 + i]; } } while (0)
#define G3_LDA(dst, b, h) do { _Pragma("unroll") for (int m = 0; m < 4; ++m) _Pragma("unroll") for (int k = 0; k < 2; ++k) dst[m][k] = *(const PG8_LAS bf16x8*)(lds + G3_SA(b, h) + aoff + m * 2048 + k * 1024); } while (0)
#define G3_LDB(dst, b, h) do { _Pragma("unroll") for (int n = 0; n < 2; ++n) _Pragma("unroll") for (int k = 0; k < 2; ++k) dst[n][k] = *(const PG8_LAS bf16x8*)(lds + G3_SB(b, h) + boff + n * 2048 + k * 1024); } while (0)
#define G3_MMA(ai, bj, At, Bt) do { _Pragma("unroll") for (int m = 0; m < 4; ++m) _Pragma("unroll") for (int n = 0; n < 2; ++n) _Pragma("unroll") for (int k = 0; k < 2; ++k) \
        acc[ai][bj][m][n] = __builtin_amdgcn_mfma_f32_16x16x32_bf16(Bt[n][k], At[m][k], acc[ai][bj][m][n], 0, 0, 0); } while (0)
#define G3_COMPUTE(b) do { bf16x8 At[4][2], B0[2][2], B1[2][2]; G3_LDB(B0, b, 0); G3_LDB(B1, b, 1); G3_LDA(At, b, 0); G3_MMA(0, 0, At, B0); G3_MMA(0, 1, At, B1); G3_LDA(At, b, 1); G3_MMA(1, 0, At, B0); G3_MMA(1, 1, At, B1); } while (0)
    Unit cur, nxt; int ui = 0;
    if (!S.next(0, cur)) return;
    f32x4 acc[2][2][4][2];
#pragma unroll
    for (int a = 0; a < 2; ++a)
#pragma unroll
        for (int b = 0; b < 2; ++b)
#pragma unroll
            for (int m = 0; m < 4; ++m)
#pragma unroll
                for (int n = 0; n < 2; ++n) acc[a][b][m][n] = (f32x4){0.f, 0.f, 0.f, 0.f};
    i32x4 sa[4], sb[4];
    const char* cA = (const char*)g.A + (size_t)cur.pm * tstep; const char* cB = (const char*)g.Bt + (size_t)cur.pn * tstep;
    __syncthreads();
    G3_ISSUE(cA, cB); G3_WRITE(0); G3_ISSUE(cA + kstep, cB + kstep);
    __syncthreads();
    for (;;) {
        const bool has_next = S.next(ui + 1, nxt);
        const char* nA = has_next ? (const char*)g.A + (size_t)nxt.pm * tstep : cA; const char* nB = has_next ? (const char*)g.Bt + (size_t)nxt.pn * tstep : cB;
        for (int t = 0; t < nt; t += 2) {
            const bool last = (t == nt - 2);
            G3_WRITE(1);
            if (!last || has_next) { const char* a2 = last ? nA : cA + (size_t)(t + 2) * kstep; const char* b2 = last ? nB : cB + (size_t)(t + 2) * kstep; G3_ISSUE(a2, b2); }
            G3_COMPUTE(0);
            __syncthreads();
            if (!last || has_next) { G3_WRITE(0);
                const char* a3 = last ? nA + kstep : cA + (size_t)(t + 3) * kstep; const char* b3 = last ? nB + kstep : cB + (size_t)(t + 3) * kstep; G3_ISSUE(a3, b3); }
            G3_COMPUTE(1);
            __syncthreads();
        }
        E(acc, cur, wr, wc, fr, fq);
        if (!has_next) break;
#pragma unroll
        for (int a = 0; a < 2; ++a)
#pragma unroll
            for (int b = 0; b < 2; ++b)
#pragma unroll
                for (int m = 0; m < 4; ++m)
#pragma unroll
                    for (int n = 0; n < 2; ++n) acc[a][b][m][n] = (f32x4){0.f, 0.f, 0.f, 0.f};
        cur = nxt; cA = nA; cB = nB; ++ui;
    }
#undef G3_SA
#undef G3_SB
#undef G3_ISSUE
#undef G3_WRITE
#undef G3_LDA
#undef G3_LDB
#undef G3_MMA
#undef G3_COMPUTE
}
}


constexpr int NWAVES = 8;
constexpr int BATCH = 2, SEQ = 8192, DM = 1024, NMETA = 16, LPOS = SEQ + NMETA, MX = BATCH * SEQ, RP = BATCH * LPOS, INC = 6144;
constexpr int NCH = 129;
constexpr float EPS = 1e-6f;
constexpr float LOG2E = 1.4426950408889634f;
constexpr float QSCALE = 0.125f * LOG2E;
constexpr float HG_SCALE = 0.08838834764831845f;
constexpr float EXIT_BITS = 126.0f;

#define GAS __attribute__((address_space(1)))
#define LAS __attribute__((address_space(3)))
typedef unsigned short bf16;
typedef unsigned v4u __attribute__((ext_vector_type(4)));
typedef unsigned v2u __attribute__((ext_vector_type(2)));
typedef float f32x4 __attribute__((ext_vector_type(4)));
typedef float f32x2 __attribute__((ext_vector_type(2)));
typedef float f32x16 __attribute__((ext_vector_type(16)));
typedef short bf16x8 __attribute__((ext_vector_type(8)));
typedef short bf16x4 __attribute__((ext_vector_type(4)));

constexpr size_t MiB = 1u << 20;
constexpr size_t WS_WIN = 1 * MiB, WS_WSB = 13 * MiB, WS_WHG = 14 * MiB, WS_WO = 15 * MiB;
constexpr size_t WS_U = 17 * MiB;
constexpr size_t WS_Q = 49 * MiB;
constexpr size_t WS_K = 65 * MiB;
constexpr size_t WS_V = 82 * MiB;
constexpr size_t WS_SG = 99 * MiB;
constexpr size_t WS_HQ = 197 * MiB;
constexpr size_t WS_HI = 213 * MiB;
constexpr size_t WS_HGT = 148 * MiB;
constexpr size_t WS_G = 164 * MiB;
constexpr size_t WS_GH = 115 * MiB;
constexpr size_t WS_DC = 230 * MiB;
constexpr size_t WS_T1 = WS_Q;
constexpr size_t WS_MG = WS_G;
constexpr size_t WS_END = 232 * MiB;
constexpr size_t DO_ST = 0, DO_GS = 32 * MiB;

constexpr int RING_BYTES = 131072, LDS_BYTES = 147456;

__device__ __forceinline__ unsigned f2bf(float f) { unsigned u = __builtin_bit_cast(unsigned, f); return (u + 0x7fffu + ((u >> 16) & 1u)) >> 16; }
__device__ __forceinline__ unsigned pk2(float lo, float hi) { return pg8::cvt_pk_bf16(lo, hi); }
__device__ __forceinline__ float bf2f(unsigned short h) { return __builtin_bit_cast(float, (unsigned)h << 16); }
__device__ __forceinline__ float bflo(unsigned w) { return __builtin_bit_cast(float, w << 16); }
__device__ __forceinline__ float bfhi(unsigned w) { return __builtin_bit_cast(float, w & 0xffff0000u); }
__device__ __forceinline__ float fsigmoid(float v) { return __builtin_amdgcn_rcpf(1.0f + __builtin_amdgcn_exp2f(-v * LOG2E)); }
__device__ __forceinline__ float fsilu(float v) { return v * fsigmoid(v); }
__device__ __forceinline__ float wave_sum(float v) {
#pragma unroll
    for (int o = 1; o < 64; o <<= 1) v += __shfl_xor(v, o);
    return v;
}
#define LDS_WAIT() asm volatile("s_waitcnt lgkmcnt(0)" ::: "memory")

struct Frame {
    LAS unsigned char* lds;
    int tid, lane, wave, vcu, G;
    const float *x, *meta, *norm_g, *w_in, *w_sb_out, *w_hg_out, *w_out, *hg_norm_g, *lbl, *final_g;
    float* out; unsigned char* ws;
    bf16 *WinT, *WsbT, *WhgT, *WoT, *U, *Q, *K, *V, *SG, *HQ, *HI, *HGT, *GH, *GS, *T1, *MG, *ST, *Y;
    bf16* Gf; float* DC;
};

__device__ __forceinline__ void store8bf(bf16* p, f32x4 a, f32x4 b) { v4u w; w.x = pk2(a[0], a[1]); w.y = pk2(a[2], a[3]); w.z = pk2(b[0], b[1]); w.w = pk2(b[2], b[3]); *(v4u*)p = w; }
template <int ACT> __device__ __forceinline__ float actf(float v) {
    if (ACT == 0) return v;
    if (ACT == 1) return v * QSCALE;
    if (ACT == 2) return fsilu(v);
    if (ACT == 3) return fsilu(v) * HG_SCALE;
    return fsigmoid(v);
}
struct EpiProj {
    static constexpr bool PERM = true, AFTER_DRAIN = false, HAS_MID = false;
    bf16 *Q, *K, *V, *SG, *HQ, *HI, *HGT, *GS, *GH; bf16* Gf; const float* lbl; unsigned char* wsb;
    template <int ACT> __device__ __forceinline__ void emit(const f32x4 (&acc)[2][2][4][2], bf16* base, int ldc, int row0, int col0) const {
#pragma unroll
        for (int ai = 0; ai < 2; ++ai)
#pragma unroll
            for (int m = 0; m < 4; ++m) { bf16* rowp = base + (size_t)(row0 + ai * 128 + m * 16) * ldc + col0;
#pragma unroll
                for (int bj = 0; bj < 2; ++bj) { f32x4 a = acc[ai][bj][m][0], b = acc[ai][bj][m][1];
#pragma unroll
                    for (int j = 0; j < 4; ++j) { a[j] = actf<ACT>(a[j]); b[j] = actf<ACT>(b[j]); }
                    store8bf(rowp + bj * 128, a, b); } }
    }
    __device__ __forceinline__ void operator()(const f32x4 (&acc)[2][2][4][2], const pg8::Unit& u, int wr, int wc, int fr, int fq) const {
        const int pn = u.pn, bb = u.pm >> 5;
        const int rowm = u.pm * 256 + wr * 64 + fr, rowp = rowm + 16 * (1 + bb);
        const int cin = wc * 32 + 8 * fq;
        int act, ldc, row0, col0; bf16* base;
        if (pn < 16) { const int grp = pn >> 1; col0 = (pn & 1) * 256 + cin; ldc = 512;
            act = (grp == 0) ? 1 : (grp == 3 || grp == 7) ? 2 : (grp == 4) ? 3 : (grp == 5) ? 5 : 0;
            const size_t boff = (grp == 0) ? WS_Q : (grp == 1) ? WS_K : (grp == 2) ? WS_V : (grp == 3) ? WS_SG : (grp == 4) ? WS_HQ : (grp == 6) ? WS_HI : WS_HGT; base = (bf16*)(wsb + boff);
            row0 = (grp == 1 || grp == 2 || grp == 5 || grp == 6) ? rowp : rowm;
        } else { act = 4; ldc = 1024; row0 = rowm; base = (pn < 20) ? GS : GH; col0 = ((pn - 16) & 3) * 256 + cin; }
        if (act == 5) {
#pragma unroll
            for (int bj = 0; bj < 2; ++bj) { float lb[8];
#pragma unroll
                for (int j = 0; j < 8; ++j) { const int c = col0 + bj * 128 + j; lb[j] = fsigmoid(lbl[c] - lbl[512 + c]); }
#pragma unroll
                for (int ai = 0; ai < 2; ++ai)
#pragma unroll
                    for (int m = 0; m < 4; ++m) { bf16* o = Gf + (size_t)(row0 + ai * 128 + m * 16) * 512 + col0 + bj * 128; f32x4 a = acc[ai][bj][m][0], b = acc[ai][bj][m][1];
#pragma unroll
                        for (int j = 0; j < 4; ++j) { a[j] = __logf(lb[j] + (1.0f - lb[j]) * fsigmoid(a[j])); b[j] = __logf(lb[4 + j] + (1.0f - lb[4 + j]) * fsigmoid(b[j])); }
                        store8bf(o, a, b); } }
            return;
        }
        if (act == 4) {
            unsigned char* gbase = (unsigned char*)base;
#pragma unroll
            for (int ai = 0; ai < 2; ++ai)
#pragma unroll
                for (int m = 0; m < 4; ++m) { unsigned char* rowq = gbase + (size_t)(row0 + ai * 128 + m * 16) * 1024 + col0;
#pragma unroll
                    for (int bj = 0; bj < 2; ++bj) { const f32x4 a = acc[ai][bj][m][0], b = acc[ai][bj][m][1]; unsigned qa[4], qb_[4];
#pragma unroll
                        for (int j = 0; j < 4; ++j) { qa[j] = (unsigned)fminf(fmaxf(fsigmoid(a[j]) * 255.0f + 0.5f, 1.0f), 255.0f); qb_[j] = (unsigned)fminf(fmaxf(fsigmoid(b[j]) * 255.0f + 0.5f, 1.0f), 255.0f); }
                        v2u w; w.x = qa[0] | (qa[1] << 8) | (qa[2] << 16) | (qa[3] << 24); w.y = qb_[0] | (qb_[1] << 8) | (qb_[2] << 16) | (qb_[3] << 24);
                        *(v2u*)(rowq + bj * 128) = w; } }
            return;
        }
        if (act <= 1) {
            const float lin = (act == 0) ? 1.0f : QSCALE;
#pragma unroll
            for (int ai = 0; ai < 2; ++ai)
#pragma unroll
                for (int m = 0; m < 4; ++m) { bf16* rowq = base + (size_t)(row0 + ai * 128 + m * 16) * ldc + col0;
#pragma unroll
                    for (int bj = 0; bj < 2; ++bj) store8bf(rowq + bj * 128, acc[ai][bj][m][0] * lin, acc[ai][bj][m][1] * lin); }
            return;
        }
        const float vs = (act == 2) ? 1.0f : HG_SCALE;
#pragma unroll
        for (int ai = 0; ai < 2; ++ai)
#pragma unroll
            for (int m = 0; m < 4; ++m) { bf16* rowq = base + (size_t)(row0 + ai * 128 + m * 16) * ldc + col0;
#pragma unroll
                for (int bj = 0; bj < 2; ++bj) { f32x4 a = acc[ai][bj][m][0], b = acc[ai][bj][m][1];
#pragma unroll
                    for (int j = 0; j < 4; ++j) { a[j] = vs * a[j] * fsigmoid(a[j]); b[j] = vs * b[j] * fsigmoid(b[j]); }
                    store8bf(rowq + bj * 128, a, b); } }
    }
};
template <int MODE> struct EpiGate {
    static constexpr bool PERM = true, AFTER_DRAIN = false, HAS_MID = false;
    const bf16* gate; const bf16* prev; bf16* O;
    __device__ __forceinline__ void operator()(const f32x4 (&acc)[2][2][4][2], const pg8::Unit& u, int wr, int wc, int fr, int fq) const {
        const int row0 = u.pm * 256 + wr * 64 + fr, col0 = u.pn * 256 + wc * 32 + 8 * fq;
#pragma unroll
        for (int ai = 0; ai < 2; ++ai)
#pragma unroll
            for (int m = 0; m < 4; ++m)
#pragma unroll
                for (int bj = 0; bj < 2; ++bj) { const size_t off = (size_t)(row0 + ai * 128 + m * 16) * 1024 + col0 + bj * 128;
                    const v4u g = *(const v4u*)(gate + off); f32x4 a = acc[ai][bj][m][0], b = acc[ai][bj][m][1];
                    a[0] *= bflo(g.x); a[1] *= bfhi(g.x); a[2] *= bflo(g.y); a[3] *= bfhi(g.y); b[0] *= bflo(g.z); b[1] *= bfhi(g.z); b[2] *= bflo(g.w); b[3] *= bfhi(g.w);
                    if (MODE == 1) { const v4u p = *(const v4u*)(prev + off);
                        a[0] += bflo(p.x); a[1] += bfhi(p.x); a[2] += bflo(p.y); a[3] += bfhi(p.y); b[0] += bflo(p.z); b[1] += bfhi(p.z); b[2] += bflo(p.w); b[3] += bfhi(p.w); }
                    store8bf(O + off, a, b); }
    }
};
struct EpiRes {
    static constexpr bool PERM = true, AFTER_DRAIN = false, HAS_MID = false;
    const float* x; float* out;
    __device__ __forceinline__ void operator()(const f32x4 (&acc)[2][2][4][2], const pg8::Unit& u, int wr, int wc, int fr, int fq) const {
        const int row0 = u.pm * 256 + wr * 64 + fr, col0 = u.pn * 256 + wc * 32 + 8 * fq;
#pragma unroll
        for (int ai = 0; ai < 2; ++ai)
#pragma unroll
            for (int m = 0; m < 4; ++m)
#pragma unroll
                for (int bj = 0; bj < 2; ++bj) { const size_t off = (size_t)(row0 + ai * 128 + m * 16) * 1024 + col0 + bj * 128;
                    const f32x4 x0 = *(const f32x4*)(x + off), x1 = *(const f32x4*)(x + off + 4);
                    f32x4 c0 = acc[ai][bj][m][0], c1 = acc[ai][bj][m][1];
                    if (DBG_SKIP & 32768) { for (int j = 0; j < 4; ++j) { c0[j] = fminf(fmaxf(c0[j], -1.5f), 1.5f); c1[j] = fminf(fmaxf(c1[j], -1.5f), 1.5f); } }
                    *(f32x4*)(out + off) = x0 + c0; *(f32x4*)(out + off + 4) = x1 + c1; }
    }
};

struct EpiMerge {
    static constexpr bool PERM = true, AFTER_DRAIN = false, HAS_MID = true;
    const unsigned char* GS; const unsigned char* GH; bf16* O;
    __device__ __forceinline__ void mid(f32x4 (&acc)[2][2][4][2], const pg8::Unit& u, int wr, int wc, int fr, int fq) const {
        int row0 = u.pm * 256 + wr * 64 + fr, col0 = u.pn * 256 + wc * 32 + 8 * fq;
        asm volatile("" : "+v"(row0), "+v"(col0));
#pragma unroll
        for (int ai = 0; ai < 2; ++ai)
#pragma unroll
            for (int m = 0; m < 4; ++m)
#pragma unroll
                for (int bj = 0; bj < 2; ++bj) { const size_t off = (size_t)(row0 + ai * 128 + m * 16) * 1024 + col0 + bj * 128; const v2u s_ = *(const v2u*)(GS + off), h_ = *(const v2u*)(GH + off);
#pragma unroll
                    for (int n = 0; n < 2; ++n) { const unsigned sw = n ? s_.y : s_.x, hw = n ? h_.y : h_.x; f32x4 a = acc[ai][bj][m][n];
#pragma unroll
                        for (int e = 0; e < 4; ++e) a[e] *= (float)((sw >> (8 * e)) & 255u) * __builtin_amdgcn_rcpf((float)((hw >> (8 * e)) & 255u));
                        asm volatile("" : "+v"(a) :: "memory"); acc[ai][bj][m][n] = a; } }
    }
    __device__ __forceinline__ void operator()(const f32x4 (&acc)[2][2][4][2], const pg8::Unit& u, int wr, int wc, int fr, int fq) const {
        const int row0 = u.pm * 256 + wr * 64 + fr, col0 = u.pn * 256 + wc * 32 + 8 * fq;
#pragma unroll
        for (int ai = 0; ai < 2; ++ai)
#pragma unroll
            for (int m = 0; m < 4; ++m)
#pragma unroll
                for (int bj = 0; bj < 2; ++bj) { const size_t off = (size_t)(row0 + ai * 128 + m * 16) * 1024 + col0 + bj * 128; const v2u h_ = *(const v2u*)(GH + off); f32x4 a = acc[ai][bj][m][0], b = acc[ai][bj][m][1];
#pragma unroll
                    for (int e = 0; e < 4; ++e) { a[e] *= (float)((h_.x >> (8 * e)) & 255u) * (1.0f / 255.0f); b[e] *= (float)((h_.y >> (8 * e)) & 255u) * (1.0f / 255.0f); }
                    store8bf(O + off, a, b); }
    }
};

__device__ __forceinline__ void p0_transpose_item(const float* W, int K, int N, bf16* WT, int ldt, LAS float* scr, int item, int lane) {
    const int nblk = N / 32, kb = item / nblk, nb = item % nblk, k0 = 64 * kb, n0 = 32 * nb;
#pragma unroll 8
    for (int i = 0; i < 32; ++i) { const int kk = 2 * i + (lane >> 5); scr[kk * 33 + (lane & 31)] = W[(size_t)(k0 + kk) * N + n0 + (lane & 31)]; }
    LDS_WAIT();
    const int c = lane & 7;
#pragma unroll
    for (int j = 0; j < 4; ++j) { const int n = (lane >> 3) + 8 * j; const LAS float* s = scr + (8 * c) * 33 + n;
        v4u o; o.x = pk2(s[0 * 33], s[1 * 33]); o.y = pk2(s[2 * 33], s[3 * 33]); o.z = pk2(s[4 * 33], s[5 * 33]); o.w = pk2(s[6 * 33], s[7 * 33]);
        *(v4u*)(WT + (size_t)(n0 + n) * ldt + k0 + 8 * c) = o; }
    LDS_WAIT();
}
__device__ __forceinline__ void meta_item(Frame& F, int it) {
    LAS float* um = (LAS float*)F.lds;
    LAS float* red = (LAS float*)(F.lds + 65536);
#pragma unroll
    for (int rr = 0; rr < 2; ++rr) { const int row = F.wave * 2 + rr; const f32x4* xr = (const f32x4*)(F.meta + row * 1024) + F.lane; const f32x4* gr = (const f32x4*)F.norm_g + F.lane;
        f32x4 v[4]; float s = 0.f;
#pragma unroll
        for (int j = 0; j < 4; ++j) { v[j] = xr[64 * j]; s += (v[j][0] * v[j][0] + v[j][1] * v[j][1]) + (v[j][2] * v[j][2] + v[j][3] * v[j][3]); }
        const float rstd = rsqrtf(wave_sum(s) * (1.0f / 1024.0f) + EPS);
#pragma unroll
        for (int j = 0; j < 4; ++j) { const f32x4 g = gr[64 * j];
#pragma unroll
            for (int e = 0; e < 4; ++e) um[(4 * (F.lane + 64 * j) + e) * 16 + row] = v[j][e] * rstd * g[e]; } }
    __syncthreads();
    const int cl = F.tid & 63, kg = F.tid >> 6;
    const int c0 = (it < 16) ? 512 + 64 * it : 2560 + 64 * (it - 16);
    float acc[16];
#pragma unroll
    for (int r = 0; r < 16; ++r) acc[r] = 0.f;
    const float* wp = F.w_in + (size_t)(kg * 128) * INC + c0 + cl;
#pragma unroll 4
    for (int k = 0; k < 128; ++k) { const float w = wp[(size_t)k * INC]; const LAS f32x4* up = (const LAS f32x4*)(um + (kg * 128 + k) * 16);
#pragma unroll
        for (int q = 0; q < 4; ++q) { const f32x4 u = up[q];
#pragma unroll
            for (int e = 0; e < 4; ++e) acc[4 * q + e] += u[e] * w; } }
#pragma unroll
    for (int r = 0; r < 16; ++r) red[(kg * 16 + r) * 64 + cl] = acc[r];
    __syncthreads();
    for (int o = F.tid; o < 1024; o += 512) { const int r = o >> 6, c = o & 63; float s = 0.f;
#pragma unroll
        for (int k2 = 0; k2 < 8; ++k2) s += red[(k2 * 16 + r) * 64 + c];
        const int col = c0 + c;
#pragma unroll
        for (int b = 0; b < 2; ++b) { const size_t prow = (size_t)b * LPOS + r;
            if (col < 1024) F.K[prow * 512 + col - 512] = (bf16)f2bf(s);
            else if (col < 1536) F.V[prow * 512 + col - 1024] = (bf16)f2bf(s);
            else if (col < 3072) { const int cc = col - 2560; const float lb = fsigmoid(F.lbl[cc] - F.lbl[512 + cc]); F.Gf[prow * 512 + cc] = (bf16)f2bf(__logf(lb + (1.0f - lb) * fsigmoid(s))); }
            else F.HI[prow * 512 + col - 3072] = (bf16)f2bf(s); } }
    __syncthreads();
}
__device__ __forceinline__ void p0_prologue(Frame& F) {
    if (blockIdx.x < 32) meta_item(F, blockIdx.x);
    LAS float* scr = (LAS float*)(F.lds + F.wave * 16384);
    const int gw = F.vcu * NWAVES + F.wave, NGW = F.G * NWAVES;
    constexpr int I_IN = (1024 / 64) * (INC / 32), I_SB = (512 / 64) * (1024 / 32), I_O = (1024 / 64) * (1024 / 32);
    constexpr int NITEMS = I_IN + 2 * I_SB + I_O;
    for (int it = gw; it < NITEMS; it += NGW) {
        int r = it;
        if (r < I_IN) { p0_transpose_item(F.w_in, 1024, INC, F.WinT, 1024, scr, r, F.lane); continue; } r -= I_IN;
        if (r < I_SB) { p0_transpose_item(F.w_sb_out, 512, 1024, F.WsbT, 1024, scr, r, F.lane); continue; } r -= I_SB;
        if (r < I_SB) { p0_transpose_item(F.w_hg_out, 512, 1024, F.WsbT + 512, 1024, scr, r, F.lane); continue; } r -= I_SB;
        p0_transpose_item(F.w_out, 1024, 1024, F.WoT, 1024, scr, r, F.lane);
    }
    for (int m = gw; m < MX; m += 2 * NGW) {
        const int m2 = m + NGW; const bool has2 = m2 < MX;
        const f32x4* xr = (const f32x4*)(F.x + (size_t)m * DM) + F.lane; const f32x4* xr2 = (const f32x4*)(F.x + (size_t)(has2 ? m2 : m) * DM) + F.lane; const f32x4* gr = (const f32x4*)F.norm_g + F.lane;
        f32x4 v[4], w2[4]; float s = 0.f, s2 = 0.f;
#pragma unroll
        for (int j = 0; j < 4; ++j) { v[j] = xr[64 * j]; w2[j] = xr2[64 * j]; }
#pragma unroll
        for (int j = 0; j < 4; ++j) { s += (v[j][0] * v[j][0] + v[j][1] * v[j][1]) + (v[j][2] * v[j][2] + v[j][3] * v[j][3]); s2 += (w2[j][0] * w2[j][0] + w2[j][1] * w2[j][1]) + (w2[j][2] * w2[j][2] + w2[j][3] * w2[j][3]); }
        const float rstd = rsqrtf(wave_sum(s) * (1.0f / 1024.0f) + EPS), rstd2 = rsqrtf(wave_sum(s2) * (1.0f / 1024.0f) + EPS);
        v2u* o8 = (v2u*)(F.U + (size_t)m * DM) + F.lane; v2u* o82 = (v2u*)(F.U + (size_t)m2 * DM) + F.lane;
#pragma unroll
        for (int j = 0; j < 4; ++j) { const f32x4 g = gr[64 * j]; v2u w; w.x = pk2(v[j][0] * rstd * g[0], v[j][1] * rstd * g[1]); w.y = pk2(v[j][2] * rstd * g[2], v[j][3] * rstd * g[3]); o8[64 * j] = w;
            if (has2) { v2u u; u.x = pk2(w2[j][0] * rstd2 * g[0], w2[j][1] * rstd2 * g[1]); u.y = pk2(w2[j][2] * rstd2 * g[2], w2[j][3] * rstd2 * g[3]); o82[64 * j] = u; } }
    }
}

#define ATT_PROCESS(qf_, o0_, o1_, R_, qpos_, masked_) do { \
    f32x16 z; _Pragma("unroll") for (int i = 0; i < 16; ++i) z[i] = 0.f; \
    _Pragma("unroll") for (int s = 0; s < 4; ++s) z = __builtin_amdgcn_mfma_f32_32x32x16_bf16(kf[s], qf_[s], z, 0, 0, 0); \
    float sp[16], lbv[16]; \
    if (masked_) { _Pragma("unroll") for (int i = 0; i < 16; ++i) { const int kpos = kb + (i & 3) + 8 * (i >> 2) + 4 * hh; const bool valid = (kpos < (qpos_)) && (kpos >= 0); \
            const float zz = fminf(z[i], 126.f); float s_; asm("v_log_f32 %0, %1" : "=v"(s_) : "v"(1.0f + __builtin_amdgcn_exp2f(zz))); sp[i] = valid ? s_ : 0.f; lbv[i] = valid ? (zz - s_) : -INFINITY; } } \
    else { _Pragma("unroll") for (int i = 0; i < 16; ++i) { const float zz = fminf(z[i], 126.f); float s_; asm("v_log_f32 %0, %1" : "=v"(s_) : "v"(1.0f + __builtin_amdgcn_exp2f(zz))); sp[i] = s_; lbv[i] = zz - s_; } } \
    float gs[4], ps[4], after[4]; \
    _Pragma("unroll") for (int g = 0; g < 4; ++g) { gs[g] = (sp[4 * g] + sp[4 * g + 1]) + (sp[4 * g + 2] + sp[4 * g + 3]); ps[g] = __shfl_xor(gs[g], 32); } \
    float tot = 0.f; \
    _Pragma("unroll") for (int g = 3; g >= 0; --g) { after[g] = tot + (hh == 0 ? ps[g] : 0.f); tot += gs[g] + ps[g]; } \
    float w[16]; \
    _Pragma("unroll") for (int g = 0; g < 4; ++g) { float run = (R_) + after[g]; \
        _Pragma("unroll") for (int ii = 3; ii >= 0; --ii) { const int i = 4 * g + ii; w[i] = __builtin_amdgcn_exp2f(lbv[i] - run); run += sp[i]; } } \
    (R_) += tot; \
    _Pragma("unroll") for (int s = 0; s < 2; ++s) { v4u t_; t_.x = pk2(w[8 * s], w[8 * s + 1]); t_.y = pk2(w[8 * s + 2], w[8 * s + 3]); t_.z = pk2(w[8 * s + 4], w[8 * s + 5]); t_.w = pk2(w[8 * s + 6], w[8 * s + 7]); \
        const bf16x8 wf_ = __builtin_bit_cast(bf16x8, t_); \
        o0_ = __builtin_amdgcn_mfma_f32_32x32x16_bf16(vfr[s][0], wf_, o0_, 0, 0, 0); o1_ = __builtin_amdgcn_mfma_f32_32x32x16_bf16(vfr[s][1], wf_, o1_, 0, 0, 0); } } while (0)
template <int DUMMY> __device__ __forceinline__ void attn_phase_t(Frame& F) {
    LAS bf16* vt = (LAS bf16*)(F.lds + F.wave * 8192);
    const int lane = F.lane, r = lane & 31, hh = lane >> 5;
    const int gw = F.vcu * NWAVES + F.wave, NGW = F.G * NWAVES;
#define ATT_LOADK(kb_, kf_) do { int kp_ = (kb_) + r; kp_ = kp_ < 0 ? 0 : kp_; const bf16* krow_ = F.K + (prow0 + kp_) * 512 + h * 64 + 8 * hh; \
            _Pragma("unroll") for (int s_ = 0; s_ < 4; ++s_) kf_[s_] = *(const bf16x8*)(krow_ + 16 * s_); } while (0)
#define ATT_LOADV(kb_, vv_) do { _Pragma("unroll") for (int i_ = 0; i_ < 4; ++i_) { const int idx_ = lane + 64 * i_, key_ = idx_ & 31, c_ = idx_ >> 5; int vp_ = (kb_) + key_; vp_ = vp_ < 0 ? 0 : vp_; \
                vv_[i_] = *(const v4u*)(F.V + (prow0 + vp_) * 512 + h * 64 + 8 * c_); } } while (0)
    for (int it = gw; it < 2048; it += NGW) {
        const int qb = it & 127, h = (it >> 7) & 7, b = it >> 10; const int mA = b * SEQ + qb * 64 + r, mB = mA + 32; const size_t prow0 = (size_t)b * LPOS;
        const int kbA0 = NMETA + qb * 64, kbB0 = kbA0 + 32, qposA = kbA0 + r, qposB = kbB0 + r;
        bf16x8 qfA[4], qfB[4], kf[4], kfn[4]; v4u vv[4];
#pragma unroll
        for (int s = 0; s < 4; ++s) { qfA[s] = *(const bf16x8*)(F.Q + (size_t)mA * 512 + h * 64 + 8 * hh + 16 * s); qfB[s] = *(const bf16x8*)(F.Q + (size_t)mB * 512 + h * 64 + 8 * hh + 16 * s); }
        ATT_LOADK(kbB0, kf); ATT_LOADV(kbB0, vv);
        f32x16 oA0, oA1, oB0, oB1;
#pragma unroll
        for (int i = 0; i < 16; ++i) { oA0[i] = 0.f; oA1[i] = 0.f; oB0[i] = 0.f; oB1[i] = 0.f; }
        float RA = 0.f, RB = 0.f; bool doneB = false;
        for (int kb = kbB0;; kb -= 32) {
            ATT_LOADK(kb - 32, kfn);
#pragma unroll
            for (int i = 0; i < 4; ++i) { const int idx = lane + 64 * i, key = idx & 31, c = idx >> 5; const unsigned ww[4] = {vv[i].x, vv[i].y, vv[i].z, vv[i].w};
#pragma unroll
                for (int j = 0; j < 4; ++j) { vt[(8 * c + 2 * j) * 36 + key] = (bf16)(ww[j] & 0xffffu); vt[(8 * c + 2 * j + 1) * 36 + key] = (bf16)(ww[j] >> 16); } }
            ATT_LOADV(kb - 32, vv);
            LDS_WAIT();
            bf16x8 vfr[2][2];
#pragma unroll
            for (int s = 0; s < 2; ++s)
#pragma unroll
                for (int db = 0; db < 2; ++db) { const LAS bf16* vp = vt + (32 * db + r) * 36 + 16 * s + 4 * hh; const bf16x4 lo = *(const LAS bf16x4*)vp, hi = *(const LAS bf16x4*)(vp + 8);
                    vfr[s][db] = (bf16x8){lo[0], lo[1], lo[2], lo[3], hi[0], hi[1], hi[2], hi[3]}; }
            LDS_WAIT();
            if (!doneB) { if (kb == kbB0 || kb < 0) ATT_PROCESS(qfB, oB0, oB1, RB, qposB, true); else ATT_PROCESS(qfB, oB0, oB1, RB, qposB, false); }
            if (kb <= kbA0) { if (kb == kbA0 || kb < 0) ATT_PROCESS(qfA, oA0, oA1, RA, qposA, true); else ATT_PROCESS(qfA, oA0, oA1, RA, qposA, false); }
            if (kb <= 0) break;
            doneB = __all(RB >= EXIT_BITS);
            if (doneB && kb <= kbA0 && __all(RA >= EXIT_BITS)) break;
#pragma unroll
            for (int s = 0; s < 4; ++s) kf[s] = kfn[s];
        }
#pragma unroll
        for (int g = 0; g < 8; ++g) { const int db = g >> 2, gg = g & 3; const int d0 = h * 64 + 32 * db + 8 * gg + 4 * hh;
            const v2u sga = *(const v2u*)(F.SG + (size_t)mA * 512 + d0), sgb = *(const v2u*)(F.SG + (size_t)mB * 512 + d0);
            const f32x16& oa = db ? oA1 : oA0; const f32x16& ob = db ? oB1 : oB0; v2u ya, yb;
            ya.x = pk2(oa[4 * gg] * bflo(sga.x), oa[4 * gg + 1] * bfhi(sga.x)); ya.y = pk2(oa[4 * gg + 2] * bflo(sga.y), oa[4 * gg + 3] * bfhi(sga.y));
            yb.x = pk2(ob[4 * gg] * bflo(sgb.x), ob[4 * gg + 1] * bfhi(sgb.x)); yb.y = pk2(ob[4 * gg + 2] * bflo(sgb.y), ob[4 * gg + 3] * bfhi(sgb.y));
            if (DUMMY) { *(v2u*)((bf16*)(F.ws + 231 * MiB) + (size_t)(mA % 12288) * 1024 + d0) = ya; } else { *(v2u*)(F.Y + (size_t)mA * 1024 + d0) = ya; *(v2u*)(F.Y + (size_t)mB * 1024 + d0) = yb; } }
    }
}
__device__ __forceinline__ void attn_phase(Frame& F) { attn_phase_t<0>(F); }
__device__ __forceinline__ void stage_iT(Frame& F, LAS bf16* iT, size_t prow, int hh, int nv) {
#pragma unroll
    for (int q = 0; q < 2; ++q) { const int idx = F.tid + 512 * q, s = idx & 63, c8 = idx >> 6;
        v4u w = {0u, 0u, 0u, 0u}; if (s < nv) w = *(const v4u*)(F.HI + (prow + s) * 512 + hh * 128 + 8 * c8);
        const unsigned ww[4] = {w.x, w.y, w.z, w.w};
#pragma unroll
        for (int j = 0; j < 4; ++j) { iT[(8 * c8 + 2 * j) * 72 + s] = (bf16)(ww[j] & 0xffffu); iT[(8 * c8 + 2 * j + 1) * 72 + s] = (bf16)(ww[j] >> 16); } }
}
#define LDS_BAR() do { asm volatile("s_waitcnt lgkmcnt(0)" ::: "memory"); __builtin_amdgcn_s_barrier(); asm volatile("" ::: "memory"); } while (0)
#define P2_DECODE(un_, stream_, c_, b_, hh_, nvl_, prow_) const int stream_ = (un_) >> 7, c_ = (un_) & 127, b_ = stream_ >> 2, hh_ = stream_ & 3, nvl_ = c_ ? 64 : NMETA; \
    const size_t prow_ = (size_t)b_ * LPOS + (c_ ? NMETA + 64 * (c_ - 1) : 0);
#define P2_LOAD(un_, iw_, gg_) do { P2_DECODE(un_, st_, cc_, b_, hh_, nv_, prow_) \
    _Pragma("unroll") for (int q2 = 0; q2 < 2; ++q2) { const int idx = F.tid + 512 * q2, s_ = idx & 63, c8 = idx >> 6; iw_[q2] = (v4u){0u, 0u, 0u, 0u}; if (s_ < nv_) iw_[q2] = *(const v4u*)(F.HI + (prow_ + s_) * 512 + hh_ * 128 + 8 * c8); } \
    { const int kp = F.tid & 63, q = F.tid >> 6; _Pragma("unroll") for (int jj = 0; jj < 8; ++jj) { const int t = 8 * q + jj; gg_[jj] = 0u; if (t < nv_) gg_[jj] = *(const unsigned*)(F.Gf + (prow_ + t) * 512 + hh_ * 128 + 2 * kp); } } } while (0)
__device__ __forceinline__ void hgrn_local_phase(Frame& F) {
    LAS bf16* KhT = (LAS bf16*)(F.lds);
    LAS bf16* iT = (LAS bf16*)(F.lds + 18432);
    LAS float* seg = (LAS float*)(F.lds + 36864);
    const int r = F.lane & 31, h2 = F.lane >> 5, wv = F.wave >> 1, wk = F.wave & 1;
    v4u iw[2]; unsigned gg[8];
    if (F.vcu < 1024) P2_LOAD(F.vcu, iw, gg);
    for (int un = F.vcu; un < 1024; un += F.G) {
        P2_DECODE(un, stream, c_, b, hh, nvl, prow)
        (void)b; (void)hh; (void)nvl; (void)prow;
#pragma unroll
        for (int q2 = 0; q2 < 2; ++q2) { const int idx = F.tid + 512 * q2, s_ = idx & 63, c8 = idx >> 6; const unsigned ww[4] = {iw[q2].x, iw[q2].y, iw[q2].z, iw[q2].w};
#pragma unroll
            for (int j = 0; j < 4; ++j) { iT[(8 * c8 + 2 * j) * 72 + s_] = (bf16)(ww[j] & 0xffffu); iT[(8 * c8 + 2 * j + 1) * 72 + s_] = (bf16)(ww[j] >> 16); } }
        { const int kp = F.tid & 63, q = F.tid >> 6; float g0[8], g1[8], c0[8], c1[8]; float run0 = 0.f, run1 = 0.f;
#pragma unroll
            for (int jj = 0; jj < 8; ++jj) { g0[jj] = bflo(gg[jj]); g1[jj] = bfhi(gg[jj]); }
            if (un + F.G < 1024) P2_LOAD(un + F.G, iw, gg);
#pragma unroll
            for (int jj = 0; jj < 8; ++jj) { run0 += g0[jj]; run1 += g1[jj]; c0[jj] = run0; c1[jj] = run1; }
            *(LAS f32x2*)(seg + q * 128 + 2 * kp) = (f32x2){run0, run1};
            LDS_BAR();
            float pre0 = 0.f, pre1 = 0.f, bl0 = 0.f, bl1 = 0.f;
#pragma unroll
            for (int qq = 0; qq < 8; ++qq) { const f32x2 sv = *(const LAS f32x2*)(seg + qq * 128 + 2 * kp); bl0 += sv[0]; bl1 += sv[1]; if (qq < q) { pre0 += sv[0]; pre1 += sv[1]; } }
            if (q == 0) *(f32x2*)(F.DC + (stream * 128 + c_) * 128 + 2 * kp) = (f32x2){__expf(bl0), __expf(bl1)};
            float k0[8], k1[8];
#pragma unroll
            for (int jj = 0; jj < 8; ++jj) { k0[jj] = (1.0f - __expf(g0[jj])) * __expf(bl0 - (pre0 + c0[jj])); k1[jj] = (1.0f - __expf(g1[jj])) * __expf(bl1 - (pre1 + c1[jj])); }
            v4u w0, w1; w0.x = pk2(k0[0], k0[1]); w0.y = pk2(k0[2], k0[3]); w0.z = pk2(k0[4], k0[5]); w0.w = pk2(k0[6], k0[7]); w1.x = pk2(k1[0], k1[1]); w1.y = pk2(k1[2], k1[3]); w1.z = pk2(k1[4], k1[5]); w1.w = pk2(k1[6], k1[7]);
            *(LAS v4u*)(KhT + (2 * kp) * 72 + 8 * q) = w0; *(LAS v4u*)(KhT + (2 * kp + 1) * 72 + 8 * q) = w1; }
        LDS_BAR();
        f32x16 a0, a1;
#pragma unroll
        for (int i = 0; i < 16; ++i) { a0[i] = 0.f; a1[i] = 0.f; }
#pragma unroll
        for (int ks = 0; ks < 4; ++ks) { const bf16x8 af = *(const LAS bf16x8*)(iT + (32 * wv + r) * 72 + 16 * ks + 8 * h2);
            const bf16x8 b0 = *(const LAS bf16x8*)(KhT + (64 * wk + r) * 72 + 16 * ks + 8 * h2), b1 = *(const LAS bf16x8*)(KhT + (64 * wk + 32 + r) * 72 + 16 * ks + 8 * h2);
            a0 = __builtin_amdgcn_mfma_f32_32x32x16_bf16(af, b0, a0, 0, 0, 0); a1 = __builtin_amdgcn_mfma_f32_32x32x16_bf16(af, b1, a1, 0, 0, 0); }
        bf16* st = F.ST + (size_t)(stream * 128 + c_) * 16384;
#pragma unroll
        for (int i = 0; i < 16; ++i) { const int v = 32 * wv + (i & 3) + 8 * (i >> 2) + 4 * h2; st[v * 128 + 64 * wk + r] = (bf16)f2bf(a0[i]); st[v * 128 + 64 * wk + 32 + r] = (bf16)f2bf(a1[i]); }
        LDS_BAR();
    }
    asm volatile("s_waitcnt vmcnt(0)" ::: "memory");
}
__device__ __forceinline__ void hgrn_scan_phase(Frame& F, bf16* OUT) {
    LAS float* ldc = (LAS float*)F.lds;
    for (int blk = F.vcu; blk < 256; blk += F.G) {
        const int stream = blk >> 5, e = (blk & 31) * 512 + F.tid, k = e & 127; bf16* st = F.ST + (size_t)stream * 128 * 16384 + e; bf16* so = OUT + (size_t)stream * 128 * 16384 + e;
        const f32x4* dsrc = (const f32x4*)(F.DC + stream * 16384);
#pragma unroll
        for (int i = 0; i < 8; ++i) ((LAS f32x4*)ldc)[F.tid + 512 * i] = dsrc[F.tid + 512 * i];
        float S = 0.f;
#pragma unroll 1
        for (int c0 = 0; c0 < 128; c0 += 32) {
            unsigned u[32];
#pragma unroll
            for (int c = 0; c < 32; ++c) u[c] = st[(size_t)(c0 + c) * 16384];
            if (c0 == 0) __syncthreads();
#pragma unroll
            for (int c = 0; c < 32; ++c) { S = ldc[(c0 + c) * 128 + k] * S + __builtin_bit_cast(float, u[c] << 16); so[(size_t)(c0 + c) * 16384] = (bf16)f2bf(S); }
        }
        __syncthreads();
    }
}
#define P4_BAR() do { asm volatile("s_waitcnt lgkmcnt(0)" ::: "memory"); __builtin_amdgcn_s_barrier(); asm volatile("" ::: "memory"); } while (0)
#define P4_DECODE(un_, stream_, c_, nv_, b_, hh_, prow_, m0_) \
    const int stream_ = (un_) >> 7, c_ = (un_) & 127; \
    const int nv_ = 64, b_ = stream_ >> 2, hh_ = stream_ & 3; const size_t prow_ = (size_t)b_ * LPOS + NMETA + 64 * c_; const int m0_ = b_ * SEQ + 64 * c_;
#define P4_LOAD(un_, iw_, g_, qh_) do { P4_DECODE(un_, st_, cc_, nv_, b_, hh_, prow_, m0_) \
    _Pragma("unroll") for (int q2 = 0; q2 < 2; ++q2) { const int idx = F.tid + 512 * q2, s_ = idx & 63, c8 = idx >> 6; iw_[q2] = (v4u){0u, 0u, 0u, 0u}; if (s_ < nv_) iw_[q2] = *(const v4u*)(F.HI + (prow_ + s_) * 512 + hh_ * 128 + 8 * c8); } \
    { const int kp = F.tid & 63, q = F.tid >> 6; _Pragma("unroll") for (int jj = 0; jj < 8; ++jj) { const int t = 8 * q + jj; \
        const unsigned gg = *(const unsigned*)(F.Gf + (prow_ + t) * 512 + hh_ * 128 + 2 * kp); g_[2 * jj] = bflo(gg); g_[2 * jj + 1] = bfhi(gg); \
        const unsigned qq = *(const unsigned*)(F.HQ + (size_t)(m0_ + t) * 512 + hh_ * 128 + 2 * kp); qh_[2 * jj] = qq & 0xffffu; qh_[2 * jj + 1] = qq >> 16; } } } while (0)
__device__ __forceinline__ void hgrn_out_phase(Frame& F) {
    LAS bf16* Qt = (LAS bf16*)(F.lds);
    LAS bf16* Kt = (LAS bf16*)(F.lds + 17408);
    LAS bf16* iT = (LAS bf16*)(F.lds + 34816);
    LAS bf16* As = (LAS bf16*)(F.lds + 53248);
    LAS float* Of = (LAS float*)(F.lds + 62464);
    LAS float* seg = (LAS float*)(F.lds + 96256);
    const int r = F.lane & 31, h2 = F.lane >> 5;
    v4u iw[2]; float g[16]; unsigned qh[16];
    if (F.vcu < 1024) P4_LOAD(F.vcu, iw, g, qh);
    for (int un = F.vcu; un < 1024; un += F.G) {
        P4_DECODE(un, stream, c, nv, b, hh, prow, m0)
#pragma unroll
        for (int q2 = 0; q2 < 2; ++q2) { const int idx = F.tid + 512 * q2, s_ = idx & 63, c8 = idx >> 6; const unsigned ww[4] = {iw[q2].x, iw[q2].y, iw[q2].z, iw[q2].w};
#pragma unroll
            for (int j = 0; j < 4; ++j) { iT[(8 * c8 + 2 * j) * 72 + s_] = (bf16)(ww[j] & 0xffffu); iT[(8 * c8 + 2 * j + 1) * 72 + s_] = (bf16)(ww[j] >> 16); } }
        float cs[16], qv[16], gk[16];
        { const int kp = F.tid & 63, q = F.tid >> 6; float run0 = 0.f, run1 = 0.f;
#pragma unroll
            for (int jj = 0; jj < 8; ++jj) { gk[2 * jj] = g[2 * jj]; gk[2 * jj + 1] = g[2 * jj + 1]; qv[2 * jj] = __builtin_bit_cast(float, qh[2 * jj] << 16); qv[2 * jj + 1] = __builtin_bit_cast(float, qh[2 * jj + 1] << 16);
                run0 += gk[2 * jj]; run1 += gk[2 * jj + 1]; cs[2 * jj] = run0; cs[2 * jj + 1] = run1; }
            *(LAS f32x2*)(seg + q * 128 + 2 * kp) = (f32x2){run0, run1}; }
        bf16x8 sbc[8]; v4u gate0 = {0u, 0u, 0u, 0u}, gate1 = {0u, 0u, 0u, 0u};
        { const int wv = F.wave & 3; const bf16* sp = F.ST + (size_t)(stream * 128 + c) * 16384 + (32 * wv + r) * 128 + 8 * h2;
#pragma unroll
          for (int ks = 0; ks < 8; ++ks) sbc[ks] = *(const bf16x8*)(sp + 16 * ks);
          const int t = F.tid >> 3, sg_ = F.tid & 7; const int mrow = m0 + t;
          if ((t < nv) && (mrow >= b * SEQ)) { const v4u* gp_ = (const v4u*)(F.HGT + (size_t)mrow * 512 + hh * 128 + 16 * sg_); gate0 = gp_[0]; gate1 = gp_[1]; } }
        if (un + F.G < 1024) P4_LOAD(un + F.G, iw, g, qh);
        P4_BAR();
        { const int kp = F.tid & 63, q = F.tid >> 6; float pre0 = 0.f, pre1 = 0.f;
#pragma unroll
            for (int qq = 0; qq < 7; ++qq) { const f32x2 sv = *(const LAS f32x2*)(seg + qq * 128 + 2 * kp); if (qq < q) { pre0 += sv[0]; pre1 += sv[1]; } }
#pragma unroll
            for (int jj = 0; jj < 8; ++jj) { const int t = 8 * q + jj; const float b0 = pre0 + cs[2 * jj], b1 = pre1 + cs[2 * jj + 1];
                *(LAS unsigned*)(Qt + t * 136 + 2 * kp) = pk2(qv[2 * jj] * __expf(b0), qv[2 * jj + 1] * __expf(b1));
                *(LAS unsigned*)(Kt + t * 136 + 2 * kp) = pk2((1.0f - __expf(gk[2 * jj])) * __expf(-b0), (1.0f - __expf(gk[2 * jj + 1])) * __expf(-b1)); } }
        P4_BAR();
        if (F.wave < 3) { const int tt = F.wave > 0, ts = F.wave == 2; f32x16 a;
#pragma unroll
            for (int i = 0; i < 16; ++i) a[i] = 0.f;
#pragma unroll
            for (int ks = 0; ks < 8; ++ks) { const bf16x8 af = *(const LAS bf16x8*)(Qt + (32 * tt + r) * 136 + 16 * ks + 8 * h2), bfr = *(const LAS bf16x8*)(Kt + (32 * ts + r) * 136 + 16 * ks + 8 * h2);
                a = __builtin_amdgcn_mfma_f32_32x32x16_bf16(af, bfr, a, 0, 0, 0); }
#pragma unroll
            for (int i = 0; i < 16; ++i) { const int t = 32 * tt + (i & 3) + 8 * (i >> 2) + 4 * h2, s_ = 32 * ts + r; As[t * 72 + s_] = (s_ <= t) ? (bf16)f2bf(a[i]) : (bf16)0; }
        } else if (F.wave == 3) {
#pragma unroll
            for (int i = 0; i < 16; ++i) { const int t = (i & 3) + 8 * (i >> 2) + 4 * h2; As[t * 72 + 32 + r] = (bf16)0; }
        }
        P4_BAR();
        { const int wt = F.wave >> 2, wv = F.wave & 3; f32x16 o;
#pragma unroll
            for (int i = 0; i < 16; ++i) o[i] = 0.f;
#pragma unroll
            for (int ks = 0; ks < 4; ++ks) { const bf16x8 af = *(const LAS bf16x8*)(As + (32 * wt + r) * 72 + 16 * ks + 8 * h2), bfr = *(const LAS bf16x8*)(iT + (32 * wv + r) * 72 + 16 * ks + 8 * h2);
                o = __builtin_amdgcn_mfma_f32_32x32x16_bf16(af, bfr, o, 0, 0, 0); }
#pragma unroll
            for (int ks = 0; ks < 8; ++ks) { const bf16x8 af = *(const LAS bf16x8*)(Qt + (32 * wt + r) * 136 + 16 * ks + 8 * h2);
                o = __builtin_amdgcn_mfma_f32_32x32x16_bf16(af, sbc[ks], o, 0, 0, 0); }
#pragma unroll
            for (int i = 0; i < 16; ++i) { const int t = 32 * wt + (i & 3) + 8 * (i >> 2) + 4 * h2; Of[t * 132 + 32 * wv + r] = o[i]; } }
        P4_BAR();
        { const int t = F.tid >> 3, sg_ = F.tid & 7; const LAS f32x4* op = (const LAS f32x4*)(Of + t * 132 + 16 * sg_); f32x4 v[4]; float ss = 0.f;
#pragma unroll
            for (int j = 0; j < 4; ++j) { v[j] = op[j]; ss += (v[j][0] * v[j][0] + v[j][1] * v[j][1]) + (v[j][2] * v[j][2] + v[j][3] * v[j][3]); }
            ss += __shfl_xor(ss, 1); ss += __shfl_xor(ss, 2); ss += __shfl_xor(ss, 4);
            const float rstd = rsqrtf(ss * (1.0f / 128.0f) + EPS); const int mrow = m0 + t;
            if (t < nv && mrow >= b * SEQ) { const int cv = hh * 128 + 16 * sg_; const f32x4* gn = (const f32x4*)(F.hg_norm_g + cv);
#pragma unroll
                for (int q = 0; q < 2; ++q) { const v4u gq = q ? gate1 : gate0; const f32x4 n0 = gn[2 * q], n1 = gn[2 * q + 1]; const f32x4 a = v[2 * q], bq = v[2 * q + 1]; v4u y;
                    y.x = pk2(a[0] * rstd * n0[0] * bflo(gq.x), a[1] * rstd * n0[1] * bfhi(gq.x)); y.y = pk2(a[2] * rstd * n0[2] * bflo(gq.y), a[3] * rstd * n0[3] * bfhi(gq.y));
                    y.z = pk2(bq[0] * rstd * n1[0] * bflo(gq.z), bq[1] * rstd * n1[1] * bfhi(gq.z)); y.w = pk2(bq[2] * rstd * n1[2] * bflo(gq.w), bq[3] * rstd * n1[3] * bfhi(gq.w));
                    *(v4u*)(F.Y + (size_t)mrow * 1024 + 512 + cv + 8 * q) = y; } } }
        P4_BAR();
    }
    asm volatile("s_waitcnt vmcnt(0)" ::: "memory");
}
__device__ __forceinline__ void final_norm_phase(Frame& F) {
    const int gw = F.vcu * NWAVES + F.wave, NGW = F.G * NWAVES;
    for (int m = gw; m < MX; m += NGW) { f32x4* xr = (f32x4*)(F.out + (size_t)m * DM) + F.lane; const f32x4* gr = (const f32x4*)F.final_g + F.lane; f32x4 v[4]; float s = 0.f;
#pragma unroll
        for (int j = 0; j < 4; ++j) { v[j] = xr[64 * j]; s += (v[j][0] * v[j][0] + v[j][1] * v[j][1]) + (v[j][2] * v[j][2] + v[j][3] * v[j][3]); }
        const float rstd = rsqrtf(wave_sum(s) * (1.0f / 1024.0f) + EPS);
#pragma unroll
        for (int j = 0; j < 4; ++j) { f32x4 o = v[j] * rstd * gr[64 * j];
            if (DBG_SKIP & (1024 | 2048 | 16384)) { const unsigned fl = *(const unsigned*)(F.ws + 64); float sc = 1.f; if (fl) { const unsigned nbad = *(const unsigned*)(F.ws + 68); const int g0 = __builtin_ctz(fl); sc = 3.f + 2.f * (float)g0; } o = o * sc; }
            if (DBG_SKIP & 32) { const int c = 4 * (F.lane + 64 * j); for (int e = 0; e < 4; ++e) o[e] = bf2f(F.U[(size_t)m * 1024 + c + e]) + bf2f(F.WinT[(size_t)(m % 6144) * 1024 + c + e]) + bf2f(F.WoT[(size_t)(m & 1023) * 1024 + c + e]); }
            else if (DBG_SKIP & 16) { const int c = 4 * (F.lane + 64 * j); for (int e = 0; e < 4; ++e) o[e] = bf2f(F.HGT[(size_t)m * 512 + ((c + e) & 511)]) + bf2f(F.GH[(size_t)m * 1024 + c + e]); }
            xr[64 * j] = o; } }
}


#define XB_TMO      128
#define XB_XCNT(j)  (256  + 64 * (j))
#define XB_XSUB(j)  (1280 + 64 * (j))
#define XB_XGEN(j)  (2304 + 64 * (j))
#define XB_TOP      3328
#define XB_TOPGEN   3392
#define XCD_BAR_WORDS 3456
#define XB_SPIN_CAP (1u << 18)

__device__ __forceinline__ unsigned xb_ld(unsigned* p)              { return __hip_atomic_load(p, __ATOMIC_RELAXED, __HIP_MEMORY_SCOPE_AGENT); }
__device__ __forceinline__ unsigned xb_add(unsigned* p, unsigned v) { return __hip_atomic_fetch_add(p, v, __ATOMIC_RELAXED, __HIP_MEMORY_SCOPE_AGENT); }
__device__ __forceinline__ unsigned xb_xcc_id() { return (unsigned)__builtin_amdgcn_s_getreg((3 << 11) | 20) & 0xFu; }
#define XB_SPIN(cond, bar) do { unsigned _sp = 0; while (cond) { __builtin_amdgcn_s_sleep(1); \
    if ((++_sp & 255u) == 0u) { if (xb_ld(&(bar)[XB_TMO])) break; if (_sp > XB_SPIN_CAP) { atomicAdd(&(bar)[XB_TMO], 1u); break; } } } } while (0)

struct XcdBarrier {
    unsigned* bar; unsigned x;
    volatile LAS unsigned* st;
};

__device__ __forceinline__ XcdBarrier xcd_barrier_post(unsigned* bar, volatile LAS unsigned* st) {
    XcdBarrier b; b.bar = bar; b.x = xb_xcc_id(); b.st = st;
    if (threadIdx.x == 0) (void)xb_add(&bar[XB_XCNT(b.x)], 1u);
    return b;
}
__device__ __forceinline__ void xcd_barrier_complete(unsigned* bar, unsigned x, unsigned& nloc, unsigned& nx) {
    const unsigned G = gridDim.x * gridDim.y * gridDim.z;
    unsigned sum, cnt, mine, sp = 0u;
    for (;;) {
        sum = 0u; cnt = 0u; mine = 0u;
#pragma unroll
        for (unsigned j = 0; j < 16; ++j) { const unsigned c = xb_ld(&bar[XB_XCNT(j)]); sum += c; cnt += (c > 0u) ? 1u : 0u; mine = (j == x) ? c : mine; }
        if (sum == G) break;
        __builtin_amdgcn_s_sleep(1);
        if ((++sp & 255u) == 0u) { if (xb_ld(&bar[XB_TMO])) break; if (sp > XB_SPIN_CAP) { atomicAdd(&bar[XB_TMO], 1u); break; } }
    }
    nloc = mine > 0u ? mine : 1u; nx = cnt > 0u ? cnt : 1u;
}

__device__ __forceinline__ void xcd_barrier(const XcdBarrier& b) {
    asm volatile("s_waitcnt vmcnt(0)" ::: "memory");
    __syncthreads();
    if (threadIdx.x == 0) {
        unsigned* bar = b.bar;
        __builtin_amdgcn_s_waitcnt(0);
        unsigned nloc = b.st[0], nx = b.st[1];
        if (nloc == 0u) { xcd_barrier_complete(bar, b.x, nloc, nx); b.st[0] = nloc; b.st[1] = nx; }
        const unsigned old = xb_add(&bar[XB_XSUB(b.x)], 1u);
        const unsigned gen = old / nloc;
        if (old + 1u == (gen + 1u) * nloc) {
            __builtin_amdgcn_fence(__ATOMIC_RELEASE, "agent");
            asm volatile("s_waitcnt vmcnt(0)" ::: "memory");
            const unsigned og = xb_add(&bar[XB_TOP], 1u);
            const unsigned tg = og / nx;
            if (og + 1u == (tg + 1u) * nx) xb_add(&bar[XB_TOPGEN], 1u);
            else XB_SPIN(xb_ld(&bar[XB_TOPGEN]) == tg, bar);
            __builtin_amdgcn_fence(__ATOMIC_ACQUIRE, "agent");
            xb_add(&bar[XB_XGEN(b.x)], 1u);
            asm volatile("s_waitcnt vmcnt(0)" ::: "memory");
        } else {
            XB_SPIN(xb_ld(&bar[XB_XGEN(b.x)]) == gen, bar);
            __builtin_amdgcn_fence(__ATOMIC_ACQUIRE, "agent");
            asm volatile("s_waitcnt vmcnt(0)" ::: "memory");
        }
    }
    __syncthreads();
}


struct EpiResNorm {
    static constexpr bool PERM = true, AFTER_DRAIN = false, HAS_MID = false;
    const float* x; float* out; const float* fg; float* rowss; const XcdBarrier* bar;
    __device__ __forceinline__ void operator()(f32x4 (&acc)[2][2][4][2], const pg8::Unit& u, int wr, int wc, int fr, int fq) const {
        const int row0 = u.pm * 256 + wr * 64 + fr, col0 = u.pn * 256 + wc * 32 + 8 * fq;
#pragma unroll
        for (int ai = 0; ai < 2; ++ai)
#pragma unroll
            for (int m = 0; m < 4; ++m) { const int row = row0 + ai * 128 + m * 16; float ss = 0.f;
#pragma unroll
                for (int bj = 0; bj < 2; ++bj) { const size_t off = (size_t)row * 1024 + col0 + bj * 128; const f32x4 x0 = *(const f32x4*)(x + off), x1 = *(const f32x4*)(x + off + 4);
                    f32x4 a = acc[ai][bj][m][0] + x0, b = acc[ai][bj][m][1] + x1; acc[ai][bj][m][0] = a; acc[ai][bj][m][1] = b;
                    ss += (a[0] * a[0] + a[1] * a[1]) + (a[2] * a[2] + a[3] * a[3]) + (b[0] * b[0] + b[1] * b[1]) + (b[2] * b[2] + b[3] * b[3]); }
                ss += __shfl_xor(ss, 16); ss += __shfl_xor(ss, 32);
                if (fq == 0) __hip_atomic_fetch_add(rowss + row, ss, __ATOMIC_RELAXED, __HIP_MEMORY_SCOPE_AGENT); }
        xcd_barrier(*bar);
        f32x4 g0[2], g1[2];
#pragma unroll
        for (int bj = 0; bj < 2; ++bj) { g0[bj] = *(const f32x4*)(fg + col0 + bj * 128); g1[bj] = *(const f32x4*)(fg + col0 + bj * 128 + 4); }
#pragma unroll
        for (int ai = 0; ai < 2; ++ai)
#pragma unroll
            for (int m = 0; m < 4; ++m) { const int row = row0 + ai * 128 + m * 16; const float rstd = rsqrtf(__hip_atomic_load(rowss + row, __ATOMIC_RELAXED, __HIP_MEMORY_SCOPE_AGENT) * (1.0f / 1024.0f) + EPS);
#pragma unroll
                for (int bj = 0; bj < 2; ++bj) { const size_t off = (size_t)row * 1024 + col0 + bj * 128;
                    *(f32x4*)(out + off) = acc[ai][bj][m][0] * rstd * g0[bj]; *(f32x4*)(out + off + 4) = acc[ai][bj][m][1] * rstd * g1[bj]; } }
    }
};

#ifndef MK_N_LAUNCHES
#define MK_N_LAUNCHES 1
#endif
constexpr int N_PHASES = 7;
struct Args { const float* in[10]; float* out; unsigned char* ws; int ph_lo, ph_hi; };
__global__ void __launch_bounds__(NWAVES * 64, 2) mk_fwd(Args args) {
    extern __shared__ __attribute__((aligned(16))) unsigned char lds[];
    Frame F;
    F.lds = (LAS unsigned char*)lds;
    F.tid = threadIdx.x; F.lane = F.tid & 63; F.wave = __builtin_amdgcn_readfirstlane(F.tid >> 6);
    F.G = gridDim.x; { const int bx = blockIdx.x; F.vcu = (F.G % 8 == 0) ? (bx % 8) * (F.G / 8) + bx / 8 : bx; }
    unsigned char* ws = args.ws; F.ws = ws;
    F.x = args.in[0]; F.meta = args.in[1]; F.norm_g = args.in[2]; F.w_in = args.in[3]; F.w_sb_out = args.in[4]; F.w_hg_out = args.in[5]; F.w_out = args.in[6];
    F.hg_norm_g = args.in[7]; F.lbl = args.in[8]; F.final_g = args.in[9]; F.out = args.out;
    F.WinT = (bf16*)(ws + WS_WIN); F.WsbT = (bf16*)(ws + WS_WSB); F.WhgT = (bf16*)(ws + WS_WHG); F.WoT = (bf16*)(ws + WS_WO);
    F.U = (bf16*)(ws + WS_U); F.Y = (bf16*)(ws + WS_U); F.Q = (bf16*)(ws + WS_Q); F.K = (bf16*)(ws + WS_K); F.V = (bf16*)(ws + WS_V); F.SG = (bf16*)(ws + WS_SG);
    F.HQ = (bf16*)(ws + WS_HQ); F.HI = (bf16*)(ws + WS_HI); F.HGT = (bf16*)(ws + WS_HGT); F.Gf = (bf16*)(ws + WS_G); F.GH = (bf16*)(ws + WS_GH); F.DC = (float*)(ws + WS_DC);
    F.T1 = (bf16*)(ws + WS_T1); F.MG = (bf16*)(ws + WS_MG); F.ST = (bf16*)((unsigned char*)args.out + DO_ST); F.GS = (bf16*)((unsigned char*)args.out + DO_GS);
    const int lo = args.ph_lo, hi = args.ph_hi;
    volatile LAS unsigned* MISC = (volatile LAS unsigned*)(F.lds + 131072 + 320);
    if (F.tid < 32) MISC[F.tid] = 0u;
    __syncthreads();
    XcdBarrier bar; bar.bar = (unsigned*)(ws + 16384); bar.x = 0; bar.st = nullptr;
    if (MK_N_LAUNCHES == 1) bar = xcd_barrier_post((unsigned*)(ws + 16384), MISC + 8);
    if (DBG_SKIP & 256) { for (int i = F.tid; i < LDS_BYTES / 16; i += NWAVES * 64) ((LAS v4u*)F.lds)[i] = (v4u){0u, 0u, 0u, 0u}; __syncthreads(); }
#define IN(k) (lo <= (k) && (k) < hi)
#define SEAM(k) do { if (IN(k) && IN((k) + 1)) { xcd_barrier(bar); } } while (0)
    if (args.ph_hi < 0) cg::this_grid().sync();
    if (IN(0)) { p0_prologue(F); if (DBG_SKIP & (1 << 23)) { __syncthreads(); p0_prologue(F); } } SEAM(0);
    if (IN(1)) {
        pg8::Gemm g{F.U, F.WinT, MX, INC, 1024}; pg8::StaticOrder S; S.init(MX, INC, F.G, (int)blockIdx.x);
        EpiProj E{F.Q, F.K, F.V, F.SG, F.HQ, F.HI, F.HGT, F.GS, F.GH, F.Gf, F.lbl, F.ws};
        pg8::gemm_phase<EpiProj, pg8::StaticOrder, true, true>(F.lds, g, S, E);
        if (DBG_SKIP & (1 << 22)) { __syncthreads(); pg8::gemm_phase<EpiProj, pg8::StaticOrder, true, true>(F.lds, g, S, E); }
    } SEAM(1);
    if (DBG_SKIP & 128) {
        pg8::StaticOrder S; S.init(MX, INC, F.G, (int)blockIdx.x); pg8::Unit u;
        for (int i = 0; S.next(i, u); ++i) { if (u.pn < 20) continue;
            for (int e = F.tid; e < 256 * 256; e += 512) { const int rr = e >> 8, cc = e & 255; const size_t off = (size_t)(u.pm * 256 + rr) * 1024 + (u.pn - 20) * 256 + cc; F.out[off] = bf2f(F.GH[off]); } }
        return;
    }
    if (IN(2) && !(DBG_SKIP & (64 | 16384))) { hgrn_local_phase(F); attn_phase(F); if (DBG_SKIP & (1 << 20)) { __syncthreads(); hgrn_local_phase(F); } if (DBG_SKIP & (1 << 19)) { __syncthreads(); attn_phase_t<1>(F); } if (DBG_SKIP & (1 << 18)) { __syncthreads(); attn_phase_t<2>(F); } } SEAM(2);

    if (IN(3) && !(DBG_SKIP & (64 | 16384))) { hgrn_scan_phase(F, F.ST); if (DBG_SKIP & (1 << 28)) { __syncthreads(); hgrn_scan_phase(F, F.Q); } } SEAM(3);
    if (IN(4) && !(DBG_SKIP & (64 | 16384))) { hgrn_out_phase(F); if (DBG_SKIP & (1 << 21)) { __syncthreads(); hgrn_out_phase(F); } } SEAM(4);
    if (IN(5) && !(DBG_SKIP & (64 | 2048 | 16384))) {
        pg8::Gemm g{F.Y, F.WsbT, MX, 1024, 1024}; pg8::StaticOrder S; S.init(MX, 1024, F.G, (int)blockIdx.x); EpiMerge E{(const unsigned char*)F.GS, (const unsigned char*)F.GH, F.MG};
        pg8::gemm_phase<EpiMerge, pg8::StaticOrder, true, true>(F.lds, g, S, E);
    } SEAM(5);
    if (IN(6) && (DBG_SKIP & (2048 | 16384))) { for (size_t i = (size_t)blockIdx.x * 512 + F.tid; i < (size_t)MX * 256; i += (size_t)F.G * 512) ((f32x4*)F.out)[i] = ((const f32x4*)F.x)[i]; }
    const bool fuse_norm = (MK_N_LAUNCHES == 1) && (F.G == 256);
    if (IN(6) && fuse_norm) {
        pg8::Gemm g{F.MG, F.WoT, MX, 1024, 1024}; pg8::StaticOrder S; S.init(MX, 1024, F.G, (int)blockIdx.x); EpiResNorm E{F.x, F.out, F.final_g, (float*)(ws + 65536), &bar};
        pg8::gemm_phase<EpiResNorm, pg8::StaticOrder, true, true>(F.lds, g, S, E);
    }
    if (IN(6) && !fuse_norm) {
        pg8::Gemm g{F.MG, F.WoT, MX, 1024, 1024}; pg8::StaticOrder S; S.init(MX, 1024, F.G, (int)blockIdx.x); EpiRes E{F.x, F.out};
        pg8::gemm_phase<EpiRes, pg8::StaticOrder, true, true>(F.lds, g, S, E);
    }
    if (!fuse_norm) { SEAM(6); }
    if (IN(7) && !fuse_norm) { final_norm_phase(F); }

#undef IN
#undef SEAM
}

extern "C" void kernel_launch(void* const* d_in, const int* in_sizes, int n_in, void* d_out, int out_size, void* d_ws, size_t ws_size, hipStream_t stream) {
    static int grid = 0;
    if (grid == 0) {
        if (n_in != 10 || in_sizes[0] != MX * DM || out_size != MX * DM || ws_size < WS_END) { fprintf(stderr, "kernel_launch: unexpected shapes (n_in %d in0 %d out %d ws %zu)\n", n_in, n_in > 0 ? in_sizes[0] : -1, out_size, ws_size); grid = -1; return; }
        int dev = 0, cus = 0, per_cu = 0;
        if (hipGetDevice(&dev) != hipSuccess || hipDeviceGetAttribute(&cus, hipDeviceAttributeMultiprocessorCount, dev) != hipSuccess) { grid = -1; return; }
        if (hipFuncSetAttribute((const void*)mk_fwd, hipFuncAttributeMaxDynamicSharedMemorySize, LDS_BYTES) != hipSuccess) { fprintf(stderr, "kernel_launch: hipFuncSetAttribute failed\n"); grid = -1; return; }
        if (hipOccupancyMaxActiveBlocksPerMultiprocessor(&per_cu, (const void*)mk_fwd, NWAVES * 64, LDS_BYTES) != hipSuccess || per_cu < 1) { fprintf(stderr, "kernel_launch: occupancy query says %d\n", per_cu); per_cu = 1; }
        (void)hipGetLastError();
        grid = cus;
    }
    if (grid < 0) return;
    Args a{};
    for (int i = 0; i < 10; ++i) a.in[i] = (const float*)d_in[i];
    a.out = (float*)d_out; a.ws = (unsigned char*)d_ws;
#if MK_N_LAUNCHES == 1
    (void)hipMemsetAsync(d_ws, 0, 131072, stream);
    a.ph_lo = 0; a.ph_hi = N_PHASES + 1;
    void* kargs[] = {&a};
    hipError_t e = hipLaunchCooperativeKernel((const void*)mk_fwd, dim3(grid), dim3(NWAVES * 64), kargs, LDS_BYTES, stream);
    if (e != hipSuccess) fprintf(stderr, "kernel_launch: cooperative launch failed: %s (grid %d)\n", hipGetErrorString(e), grid);
#else
    for (int p = 0; p <= N_PHASES; ++p) { if ((DBG_SKIP & 32) && p >= 1 && p <= 6) continue; a.ph_lo = p; a.ph_hi = p + 1; hipLaunchKernelGGL(mk_fwd, dim3(grid), dim3(NWAVES * 64), LDS_BYTES, stream, a); }
#endif
}
```

```cpp
#include <hip/hip_runtime.h>
#include <hip/hip_cooperative_groups.h>
#include <cstdio>
#include <cstdint>
namespace cg = cooperative_groups;
#ifndef DBG_SKIP
#define DBG_SKIP 0
#endif
namespace pg8 {
#define PG8_LAS __attribute__((address_space(3)))
typedef unsigned short bf16_t;
typedef short bf16x8 __attribute__((ext_vector_type(8)));
typedef float f32x4 __attribute__((ext_vector_type(4)));
typedef unsigned u32x4 __attribute__((ext_vector_type(4)));
constexpr int BM = 256, BK = 64, HALF = 128, HTB = HALF * BK * 2  , STAGE_BYTES = 8 * HTB, NXCD = 8, WGM = 8;

__host__ __device__ __forceinline__ int lds_byte(int r, int c) { const int st = (r >> 4) * 2 + (c >> 5), rr = r & 15, cc = c & 31, ob = rr * 64 + cc * 2; return st * 1024 + (ob ^ (((ob >> 9) & 1) << 5)); }
__host__ __device__ __forceinline__ void stage_rc(int b, int& R, int& C) { const int st = b / 1024, sb = b % 1024, swz = sb ^ (((sb >> 9) & 1) << 5); R = (st >> 1) * 16 + swz / 64; C = (st & 1) * 32 + (swz % 64) / 2; }
__host__ __device__ __forceinline__ int perm32(int rho) { const int n = rho >> 4, i = rho & 15; return 8 * (i >> 2) + 4 * n + (i & 3); }

struct Unit { int pm, pn; };
struct Gemm { const bf16_t* A; const bf16_t* Bt; int M, N, K; };

struct StaticOrder {
    int nM, nN, nwg, G, c;
    __host__ __device__ void init(int M, int N, int G_, int c_) { nM = M / BM; nN = N / BM; nwg = nM * nN; G = G_; c = c_; }
    __host__ __device__ bool next(int i, Unit& u) const {
        const long L = (long)i * G + c; if (L >= nwg) return false;
        int wgid = (int)L; { const int q = nwg / NXCD, r = nwg % NXCD, xcd = wgid % NXCD, off = wgid / NXCD; wgid = (xcd < r ? xcd * (q + 1) : r * (q + 1) + (xcd - r) * q) + off; }
        const int nig = WGM * nN, gid = wgid / nig, fm = gid * WGM, gsz = (nM - fm) < WGM ? (nM - fm) : WGM;
        u.pm = fm + ((wgid % nig) % gsz); u.pn = (wgid % nig) / gsz; if (DBG_SKIP & 65536) u.pn = nN - 1 - u.pn; return true;
    }
    __device__ __forceinline__ void a_ready(const Unit&) const {}
    __device__ __forceinline__ void done(const Unit&) const {}
};

__device__ __forceinline__ unsigned cvt_pk_bf16(float lo, float hi) { unsigned r; asm volatile("v_cvt_pk_bf16_f32 %0, %1, %2" : "=v"(r) : "v"(lo), "v"(hi)); return r; }
typedef float f32x2 __attribute__((ext_vector_type(2)));
template <class Epi, class Sched, bool ALIGN_EPI = false, bool SP2 = false>
__device__ __forceinline__ void gemm_phase(PG8_LAS unsigned char* lds, const Gemm g, const Sched& S, const Epi& E) {
    const int tid = threadIdx.x, wid = __builtin_amdgcn_readfirstlane(tid >> 6), lane = tid & 63, wr = wid >> 2, wc = wid & 3, fr = lane & 15, fq = lane >> 4;
    const int K = g.K, nt = K / BK;
    unsigned voffA[2], voffB[2];
#pragma unroll
    for (int i = 0; i < 2; ++i) { int R, C; stage_rc(tid * 16 + i * 8192, R, C); const int Rb = Epi::PERM ? ((R & ~31) + perm32(R & 31)) : R;
        voffA[i] = (unsigned)(R * K + C) * 2u; voffB[i] = (unsigned)(Rb * K + C) * 2u; }
    const size_t kstep = (size_t)(BK * 2);
    const size_t hstep = (size_t)HALF * K * 2;
    const size_t tstep = 2 * hstep;
    const unsigned ldsw = (unsigned)wid * 1024u;
    const int aoff = lds_byte(wr * 64 + fr, fq * 8), boff = lds_byte(wc * 32 + fr, fq * 8);
#define PG8_SA(b, h) (((b) * 2 + (h)) * HTB)
#define PG8_SB(b, h) ((4 + (b) * 2 + (h)) * HTB)
#define PG8_STAGE(bufoff, gbase, voff) do { _Pragma("unroll") for (int _i = 0; _i < 2; ++_i) \
        __builtin_amdgcn_global_load_lds((const unsigned*)((const char*)(gbase) + (voff)[_i]), (PG8_LAS unsigned*)(lds + (bufoff) + ldsw + _i * 8192), 16, 0, 0); } while (0)
#define PG8_LDA(dst, b, h) do { _Pragma("unroll") for (int m = 0; m < 4; ++m) _Pragma("unroll") for (int k = 0; k < 2; ++k) dst[m][k] = *(const PG8_LAS bf16x8*)(lds + PG8_SA(b, h) + aoff + m * 2048 + k * 1024); } while (0)
#define PG8_LDB(dst, b, h) do { _Pragma("unroll") for (int n = 0; n < 2; ++n) _Pragma("unroll") for (int k = 0; k < 2; ++k) dst[n][k] = *(const PG8_LAS bf16x8*)(lds + PG8_SB(b, h) + boff + n * 2048 + k * 1024); } while (0)
#define PG8_MMA(ai, bj, At, Bt) do { __builtin_amdgcn_s_setprio(1); _Pragma("unroll") for (int m = 0; m < 4; ++m) _Pragma("unroll") for (int n = 0; n < 2; ++n) _Pragma("unroll") for (int k = 0; k < 2; ++k) \
        acc[ai][bj][m][n] = __builtin_amdgcn_mfma_f32_16x16x32_bf16(Bt[n][k], At[m][k], acc[ai][bj][m][n], 0, 0, 0); __builtin_amdgcn_s_setprio(0); } while (0)
#define PG8_WAIT_V(n) asm volatile("s_waitcnt vmcnt(" #n ")" ::: "memory")
#define PG8_WAIT_L(n) asm volatile("s_waitcnt lgkmcnt(" #n ")" ::: "memory")
#define PG8_BAR __builtin_amdgcn_s_barrier()
#define PG8_SCHED __builtin_amdgcn_sched_barrier(0)
    Unit cur, nxt; int ui = 0;
    if (!S.next(0, cur)) return;
    f32x4 acc[2][2][4][2];
#pragma unroll
    for (int a = 0; a < 2; ++a)
#pragma unroll
        for (int b = 0; b < 2; ++b)
#pragma unroll
            for (int m = 0; m < 4; ++m)
#pragma unroll
                for (int n = 0; n < 2; ++n) acc[a][b][m][n] = (f32x4){0.f, 0.f, 0.f, 0.f};
    bf16x8 At[4][2], B0[2][2], B1[2][2];
    const char* cA = (const char*)g.A + (size_t)cur.pm * tstep; const char* cB = (const char*)g.Bt + (size_t)cur.pn * tstep;
    S.a_ready(cur);
    if constexpr (SP2) {
        PG8_STAGE(PG8_SB(0, 0), cB, voffB); PG8_STAGE(PG8_SB(0, 1), cB + hstep, voffB); PG8_STAGE(PG8_SA(0, 0), cA, voffA); PG8_STAGE(PG8_SA(0, 1), cA + hstep, voffA);
        if (wr == 1) PG8_BAR;
        PG8_WAIT_V(2); PG8_BAR;
        PG8_STAGE(PG8_SB(1, 0), cB + kstep, voffB); PG8_STAGE(PG8_SA(1, 0), cA + kstep, voffA); PG8_STAGE(PG8_SB(1, 1), cB + hstep + kstep, voffB);
        PG8_WAIT_V(6); PG8_BAR;
    } else {
        PG8_STAGE(PG8_SB(0, 0), cB, voffB); PG8_STAGE(PG8_SA(0, 0), cA, voffA); PG8_STAGE(PG8_SB(0, 1), cB + hstep, voffB); PG8_STAGE(PG8_SA(0, 1), cA + hstep, voffA);
        if (wr == 1) PG8_BAR;
        PG8_WAIT_V(4); PG8_BAR;
        PG8_STAGE(PG8_SB(1, 0), cB + kstep, voffB); PG8_STAGE(PG8_SA(1, 0), cA + kstep, voffA); PG8_STAGE(PG8_SB(1, 1), cB + hstep + kstep, voffB);
        PG8_WAIT_V(6); PG8_BAR;
    }
    for (;;) {
        const bool has_next = S.next(ui + 1, nxt);
        const char* nA = has_next ? (const char*)g.A + (size_t)nxt.pm * tstep : cA; const char* nB = has_next ? (const char*)g.Bt + (size_t)nxt.pn * tstep : cB;
        for (int half_ = 0; half_ < (Epi::HAS_MID ? 2 : 1); ++half_) {
        if constexpr (Epi::HAS_MID) { if (half_ == 1) { E.mid(acc, cur, wr, wc, fr, fq); asm volatile("" ::: "memory"); } }
        for (int t = Epi::HAS_MID ? half_ * (nt >> 1) : 0; t < (Epi::HAS_MID ? (half_ + 1) * (nt >> 1) : nt); t += 2) {
            const bool last = (t == nt - 2);
            const char* a1 = cA + (size_t)(t + 1) * kstep;
            const char* a2 = last ? nA : cA + (size_t)(t + 2) * kstep; const char* b2 = last ? nB : cB + (size_t)(t + 2) * kstep;
            const char* a3 = a2 + kstep; const char* b3 = b2 + kstep;
            if (last && has_next) S.a_ready(nxt);
            if constexpr (SP2) {
            PG8_LDB(B0, 0, 0); PG8_LDB(B1, 0, 1); PG8_SCHED; PG8_LDA(At, 0, 0); PG8_STAGE(PG8_SA(1, 1), a1 + hstep, voffA);
            PG8_WAIT_V(8); PG8_WAIT_L(0); PG8_BAR; PG8_MMA(0, 0, At, B0); PG8_MMA(0, 1, At, B1); PG8_BAR; PG8_SCHED;
            PG8_LDA(At, 0, 1); PG8_STAGE(PG8_SB(0, 0), b2, voffB); PG8_STAGE(PG8_SB(0, 1), b2 + hstep, voffB); PG8_STAGE(PG8_SA(0, 0), a2, voffA);
            PG8_WAIT_V(8); PG8_WAIT_L(0); PG8_BAR; PG8_MMA(1, 0, At, B0); PG8_MMA(1, 1, At, B1); PG8_BAR; PG8_SCHED;
            PG8_LDB(B0, 1, 0); PG8_LDB(B1, 1, 1); PG8_SCHED; PG8_LDA(At, 1, 0); PG8_STAGE(PG8_SA(0, 1), a2 + hstep, voffA);
            PG8_WAIT_V(8); PG8_WAIT_L(0); PG8_BAR; PG8_MMA(0, 0, At, B0); PG8_MMA(0, 1, At, B1); PG8_BAR; PG8_SCHED;
            PG8_LDA(At, 1, 1); PG8_STAGE(PG8_SB(1, 0), b3, voffB); PG8_STAGE(PG8_SB(1, 1), b3 + hstep, voffB); PG8_STAGE(PG8_SA(1, 0), a3, voffA);
            PG8_WAIT_V(8); PG8_WAIT_L(0); PG8_BAR; PG8_MMA(1, 0, At, B0); PG8_MMA(1, 1, At, B1); PG8_BAR; PG8_SCHED;
            } else {
            PG8_LDB(B0, 0, 0); PG8_SCHED; PG8_LDA(At, 0, 0); PG8_STAGE(PG8_SA(1, 1), a1 + hstep, voffA);
            PG8_WAIT_L(8); PG8_BAR; PG8_WAIT_L(0); PG8_MMA(0, 0, At, B0); PG8_BAR; PG8_SCHED;
            PG8_LDB(B1, 0, 1); PG8_STAGE(PG8_SB(0, 0), b2, voffB);
            PG8_BAR; PG8_WAIT_L(0); PG8_MMA(0, 1, At, B1); PG8_BAR;
            PG8_LDA(At, 0, 1); PG8_STAGE(PG8_SA(0, 0), a2, voffA);
            PG8_BAR; PG8_WAIT_L(0); PG8_MMA(1, 0, At, B0); PG8_BAR; PG8_SCHED;
            PG8_STAGE(PG8_SB(0, 1), b2 + hstep, voffB);
            PG8_WAIT_V(6); PG8_BAR; PG8_MMA(1, 1, At, B1); PG8_BAR;
            PG8_LDB(B0, 1, 0); PG8_SCHED; PG8_LDA(At, 1, 0); PG8_STAGE(PG8_SA(0, 1), a2 + hstep, voffA);
            PG8_WAIT_L(8); PG8_BAR; PG8_WAIT_L(0); PG8_MMA(0, 0, At, B0); PG8_BAR; PG8_SCHED;
            PG8_LDB(B1, 1, 1); PG8_STAGE(PG8_SB(1, 0), b3, voffB);
            PG8_BAR; PG8_WAIT_L(0); PG8_MMA(0, 1, At, B1); PG8_BAR;
            PG8_LDA(At, 1, 1); PG8_STAGE(PG8_SA(1, 0), a3, voffA);
            PG8_BAR; PG8_WAIT_L(0); PG8_MMA(1, 0, At, B0); PG8_BAR; PG8_SCHED;
            PG8_STAGE(PG8_SB(1, 1), b3 + hstep, voffB);
            PG8_WAIT_V(6); PG8_BAR; PG8_MMA(1, 1, At, B1); PG8_BAR;
            }
        }
        }
        if constexpr (ALIGN_EPI) { if (wr == 0) PG8_BAR; }
        if constexpr (!Epi::AFTER_DRAIN) { E(acc, cur, wr, wc, fr, fq); S.done(cur); }
        if (!has_next) break;
#pragma unroll
        for (int a = 0; a < 2; ++a)
#pragma unroll
            for (int b = 0; b < 2; ++b)
#pragma unroll
                for (int m = 0; m < 4; ++m)
#pragma unroll
                    for (int n = 0; n < 2; ++n) acc[a][b][m][n] = (f32x4){0.f, 0.f, 0.f, 0.f};
        cur = nxt; cA = nA; cB = nB; ++ui;
        if constexpr (ALIGN_EPI) { if (wr == 1) PG8_BAR; }
    }
    PG8_WAIT_V(0);
    if constexpr (!ALIGN_EPI) { if (wr == 0) PG8_BAR; }
    PG8_BAR;
    if constexpr (Epi::AFTER_DRAIN) { E.fused(acc, cur, wr, wc, fr, fq, lds, wid, lane); S.done(cur); }
#undef PG8_SA
#undef PG8_SB
#undef PG8_STAGE
#undef PG8_LDA
#undef PG8_LDB
#undef PG8_MMA
#undef PG8_WAIT_V
#undef PG8_WAIT_L
#undef PG8_BAR
#undef PG8_SCHED
}
template <class Epi, class Sched>
__device__ __forceinline__ void gemm_phase2(PG8_LAS unsigned char* lds, const Gemm g, const Sched& S, const Epi& E) {
    const int tid = threadIdx.x, wid = __builtin_amdgcn_readfirstlane(tid >> 6), lane = tid & 63, wr = wid >> 2, wc = wid & 3, fr = lane & 15, fq = lane >> 4;
    const int K = g.K, nt = K / BK;
    unsigned voffA[2], voffB[2];
#pragma unroll
    for (int i = 0; i < 2; ++i) { int R, C; stage_rc(tid * 16 + i * 8192, R, C); const int Rb = Epi::PERM ? ((R & ~31) + perm32(R & 31)) : R;
        voffA[i] = (unsigned)(R * K + C) * 2u; voffB[i] = (unsigned)(Rb * K + C) * 2u; }
    const size_t kstep = (size_t)(BK * 2), hstep = (size_t)HALF * K * 2, tstep = 2 * hstep;
    const unsigned ldsw = (unsigned)wid * 1024u;
    const int aoff = lds_byte(wr * 64 + fr, fq * 8), boff = lds_byte(wc * 32 + fr, fq * 8);
#define G2_SA(b, h) (((b) * 2 + (h)) * HTB)
#define G2_SB(b, h) ((4 + (b) * 2 + (h)) * HTB)
#define G2_STAGE(bufoff, gbase, voff) do { _Pragma("unroll") for (int _i = 0; _i < 2; ++_i) \
        __builtin_amdgcn_global_load_lds((const unsigned*)((const char*)(gbase) + (voff)[_i]), (PG8_LAS unsigned*)(lds + (bufoff) + ldsw + _i * 8192), 16, 0, 0); } while (0)
#define G2_STAGE4(b, pa, pb) do { G2_STAGE(G2_SB(b, 0), (pb), voffB); G2_STAGE(G2_SB(b, 1), (pb) + hstep, voffB); G2_STAGE(G2_SA(b, 0), (pa), voffA); G2_STAGE(G2_SA(b, 1), (pa) + hstep, voffA); } while (0)
#define G2_LDA(dst, b, h) do { _Pragma("unroll") for (int m = 0; m < 4; ++m) _Pragma("unroll") for (int k = 0; k < 2; ++k) dst[m][k] = *(const PG8_LAS bf16x8*)(lds + G2_SA(b, h) + aoff + m * 2048 + k * 1024); } while (0)
#define G2_LDB(dst, b, h) do { _Pragma("unroll") for (int n = 0; n < 2; ++n) _Pragma("unroll") for (int k = 0; k < 2; ++k) dst[n][k] = *(const PG8_LAS bf16x8*)(lds + G2_SB(b, h) + boff + n * 2048 + k * 1024); } while (0)
#define G2_MMA(ai, bj, At, Bt) do { _Pragma("unroll") for (int m = 0; m < 4; ++m) _Pragma("unroll") for (int n = 0; n < 2; ++n) _Pragma("unroll") for (int k = 0; k < 2; ++k) \
        acc[ai][bj][m][n] = __builtin_amdgcn_mfma_f32_16x16x32_bf16(Bt[n][k], At[m][k], acc[ai][bj][m][n], 0, 0, 0); } while (0)
#define G2_COMPUTE(b) do { G2_LDB(B0, b, 0); G2_LDB(B1, b, 1); G2_LDA(At, b, 0); __builtin_amdgcn_s_setprio(1); G2_MMA(0, 0, At, B0); G2_MMA(0, 1, At, B1); G2_LDA(At, b, 1); G2_MMA(1, 0, At, B0); G2_MMA(1, 1, At, B1); __builtin_amdgcn_s_setprio(0); } while (0)
#define G2_SYNC() do { asm volatile("s_waitcnt vmcnt(0) lgkmcnt(0)" ::: "memory"); __builtin_amdgcn_s_barrier(); __builtin_amdgcn_s_sleep(8); __builtin_amdgcn_s_barrier(); asm volatile("" ::: "memory"); } while (0)
    Unit cur, nxt; int ui = 0;
    if (!S.next(0, cur)) return;
    f32x4 acc[2][2][4][2];
#pragma unroll
    for (int a = 0; a < 2; ++a)
#pragma unroll
        for (int b = 0; b < 2; ++b)
#pragma unroll
            for (int m = 0; m < 4; ++m)
#pragma unroll
                for (int n = 0; n < 2; ++n) acc[a][b][m][n] = (f32x4){0.f, 0.f, 0.f, 0.f};
    bf16x8 At[4][2], B0[2][2], B1[2][2];
    const char* cA = (const char*)g.A + (size_t)cur.pm * tstep; const char* cB = (const char*)g.Bt + (size_t)cur.pn * tstep;
    G2_SYNC();
    G2_STAGE4(0, cA, cB);
    G2_SYNC();
    for (;;) {
        const bool has_next = S.next(ui + 1, nxt);
        const char* nA = has_next ? (const char*)g.A + (size_t)nxt.pm * tstep : cA; const char* nB = has_next ? (const char*)g.Bt + (size_t)nxt.pn * tstep : cB;
        for (int t = 0; t < nt; t += 2) {
            const bool last = (t == nt - 2);
            { const char* a1 = cA + (size_t)(t + 1) * kstep; const char* b1 = cB + (size_t)(t + 1) * kstep; G2_STAGE4(1, a1, b1); }
            G2_COMPUTE(0);
            G2_SYNC();
            if (!last || has_next) { const char* a2 = last ? nA : cA + (size_t)(t + 2) * kstep; const char* b2 = last ? nB : cB + (size_t)(t + 2) * kstep; G2_STAGE4(0, a2, b2); }
            G2_COMPUTE(1);
            G2_SYNC();
        }
        E(acc, cur, wr, wc, fr, fq);
        if (!has_next) break;
#pragma unroll
        for (int a = 0; a < 2; ++a)
#pragma unroll
            for (int b = 0; b < 2; ++b)
#pragma unroll
                for (int m = 0; m < 4; ++m)
#pragma unroll
                    for (int n = 0; n < 2; ++n) acc[a][b][m][n] = (f32x4){0.f, 0.f, 0.f, 0.f};
        cur = nxt; cA = nA; cB = nB; ++ui;
    }
    asm volatile("s_waitcnt vmcnt(0)" ::: "memory");
#undef G2_SA
#undef G2_SB
#undef G2_STAGE
#undef G2_STAGE4
#undef G2_LDA
#undef G2_LDB
#undef G2_MMA
#undef G2_COMPUTE
#undef G2_SYNC
}
template <class Epi, class Sched>
__device__ __forceinline__ void gemm_phase3(PG8_LAS unsigned char* lds, const Gemm g, const Sched& S, const Epi& E) {
    typedef int i32x4 __attribute__((ext_vector_type(4)));
    const int tid = threadIdx.x, wid = __builtin_amdgcn_readfirstlane(tid >> 6), lane = tid & 63, wr = wid >> 2, wc = wid & 3, fr = lane & 15, fq = lane >> 4;
    const int K = g.K, nt = K / BK;
    unsigned voffA[2], voffB[2];
#pragma unroll
    for (int i = 0; i < 2; ++i) { int R, C; stage_rc(tid * 16 + i * 8192, R, C); const int Rb = Epi::PERM ? ((R & ~31) + perm32(R & 31)) : R;
        voffA[i] = (unsigned)(R * K + C) * 2u; voffB[i] = (unsigned)(Rb * K + C) * 2u; }
    const size_t kstep = (size_t)(BK * 2), hstep = (size_t)HALF * K * 2, tstep = 2 * hstep;
    const int aoff = lds_byte(wr * 64 + fr, fq * 8), boff = lds_byte(wc * 32 + fr, fq * 8);
#define G3_SA(b, h) (((b) * 2 + (h)) * HTB)
#define G3_SB(b, h) ((4 + (b) * 2 + (h)) * HTB)
#define G3_ISSUE(pa, pb) do { _Pragma("unroll") for (int h = 0; h < 2; ++h) _Pragma("unroll") for (int i = 0; i < 2; ++i) { \
        sa[h * 2 + i] = *(const i32x4*)((pa) + h * hstep + voffA[i]); sb[h * 2 + i] = *(const i32x4*)((pb) + h * hstep + voffB[i]); } } while (0)
#define G3_WRITE(b) do { _Pragma("unroll") for (int h = 0; h < 2; ++h) _Pragma("unroll") for (int i = 0; i < 2; ++i) { \
        *(PG8_LAS i32x4*)(lds + G3_SA(b, h) + tid * 16 + i * 8192) = sa[h * 2 + i]; *(PG8_LAS i32x4*)(lds + G3_SB(b, h) + tid * 16 + i * 8192) = sb[h * 2 + i]; } } while (0)
#define G3_LDA(dst, b, h) do { _Pragma("unroll") for (int m = 0; m < 4; ++m) _Pragma("unroll") for (int k = 0; k < 2; ++k) dst[m][k] = *(const PG8_LAS bf16x8*)(lds + G3_SA(b, h) + aoff + m * 2048 + k * 1024); } while (0)
#define G3_LDB(dst, b, h) do { _Pragma("unroll") for (int n = 0; n < 2; ++n) _Pragma("unroll") for (int k = 0; k < 2; ++k) dst[n][k] = *(const PG8_LAS bf16x8*)(lds + G3_SB(b, h) + boff + n * 2048 + k * 1024); } while (0)
#define G3_MMA(ai, bj, At, Bt) do { _Pragma("unroll") for (int m = 0; m < 4; ++m) _Pragma("unroll") for (int n = 0; n < 2; ++n) _Pragma("unroll") for (int k = 0; k < 2; ++k) \
        acc[ai][bj][m][n] = __builtin_amdgcn_mfma_f32_16x16x32_bf16(Bt[n][k], At[m][k], acc[ai][bj][m][n], 0, 0, 0); } while (0)
#define G3_COMPUTE(b) do { bf16x8 At[4][2], B0[2][2], B1[2][2]; G3_LDB(B0, b, 0); G3_LDB(B1, b, 1); G3_LDA(At, b, 0); G3_MMA(0, 0, At, B0); G3_MMA(0, 1, At, B1); G3_LDA(At, b, 1); G3_MMA(1, 0, At, B0); G3_MMA(1, 1, At, B1); } while (0)
    Unit cur, nxt; int ui = 0;
    if (!S.next(0, cur)) return;
    f32x4 acc[2][2][4][2];
#pragma unroll
    for (int a = 0; a < 2; ++a)
#pragma unroll
        for (int b = 0; b < 2; ++b)
#pragma unroll
            for (int m = 0; m < 4; ++m)
#pragma unroll
                for (int n = 0; n < 2; ++n) acc[a][b][m][n] = (f32x4){0.f, 0.f, 0.f, 0.f};
    i32x4 sa[4], sb[4];
    const char* cA = (const char*)g.A + (size_t)cur.pm * tstep; const char* cB = (const char*)g.Bt + (size_t)cur.pn * tstep;
    __syncthreads();
    G3_ISSUE(cA, cB); G3_WRITE(0); G3_ISSUE(cA + kstep, cB + kstep);
    __syncthreads();
    for (;;) {
        const bool has_next = S.next(ui + 1, nxt);
        const char* nA = has_next ? (const char*)g.A + (size_t)nxt.pm * tstep : cA; const char* nB = has_next ? (const char*)g.Bt + (size_t)nxt.pn * tstep : cB;
        for (int t = 0; t < nt; t += 2) {
            const bool last = (t == nt - 2);
            G3_WRITE(1);
            if (!last || has_next) { const char* a2 = last ? nA : cA + (size_t)(t + 2) * kstep; const char* b2 = last ? nB : cB + (size_t)(t + 2) * kstep; G3_ISSUE(a2, b2); }
            G3_COMPUTE(0);
            __syncthreads();
            if (!last || has_next) { G3_WRITE(0);
                const char* a3 = last ? nA + kstep : cA + (size_t)(t + 3) * kstep; const char* b3 = last ? nB + kstep : cB + (size_t)(t + 3) * kstep; G3_ISSUE(a3, b3); }
            G3_COMPUTE(1);
            __syncthreads();
        }
        E(acc, cur, wr, wc, fr, fq);
        if (!has_next) break;
#pragma unroll
        for (int a = 0; a < 2; ++a)
#pragma unroll
            for (int b = 0; b < 2; ++b)
#pragma unroll
                for (int m = 0; m < 4; ++m)
#pragma unroll
                    for (int n = 0; n < 2; ++n) acc[a][b][m][n] = (f32x4){0.f, 0.f, 0.f, 0.f};
        cur = nxt; cA = nA; cB = nB; ++ui;
    }
#undef G3_SA
#undef G3_SB
#undef G3_ISSUE
#undef G3_WRITE
#undef G3_LDA
#undef G3_LDB
#undef G3_MMA
#undef G3_COMPUTE
}
}


constexpr int NWAVES = 8;
constexpr int BATCH = 2, SEQ = 8192, DM = 1024, NMETA = 16, LPOS = SEQ + NMETA, MX = BATCH * SEQ, RP = BATCH * LPOS, INC = 6144;
constexpr int NCH = 129;
constexpr float EPS = 1e-6f;
constexpr float LOG2E = 1.4426950408889634f;
constexpr float QSCALE = 0.125f * LOG2E;
constexpr float HG_SCALE = 0.08838834764831845f;
constexpr float EXIT_BITS = 126.0f;

#define GAS __attribute__((address_space(1)))
#define LAS __attribute__((address_space(3)))
typedef unsigned short bf16;
typedef unsigned v4u __attribute__((ext_vector_type(4)));
typedef unsigned v2u __attribute__((ext_vector_type(2)));
typedef float f32x4 __attribute__((ext_vector_type(4)));
typedef float f32x2 __attribute__((ext_vector_type(2)));
typedef float f32x16 __attribute__((ext_vector_type(16)));
typedef short bf16x8 __attribute__((ext_vector_type(8)));
typedef short bf16x4 __attribute__((ext_vector_type(4)));

constexpr size_t MiB = 1u << 20;
constexpr size_t WS_WIN = 1 * MiB, WS_WSB = 13 * MiB, WS_WHG = 14 * MiB, WS_WO = 15 * MiB;
constexpr size_t WS_U = 17 * MiB;
constexpr size_t WS_Q = 49 * MiB;
constexpr size_t WS_K = 65 * MiB;
constexpr size_t WS_V = 82 * MiB;
constexpr size_t WS_SG = 99 * MiB;
constexpr size_t WS_HQ = 197 * MiB;
constexpr size_t WS_HI = 213 * MiB;
constexpr size_t WS_HGT = 148 * MiB;
constexpr size_t WS_G = 164 * MiB;
constexpr size_t WS_GH = 115 * MiB;
constexpr size_t WS_DC = 230 * MiB;
constexpr size_t WS_T1 = WS_Q;
constexpr size_t WS_MG = WS_G;
constexpr size_t WS_END = 232 * MiB;
constexpr size_t DO_ST = 0, DO_GS = 32 * MiB;

constexpr int RING_BYTES = 131072, LDS_BYTES = 147456;

__device__ __forceinline__ unsigned f2bf(float f) { unsigned u = __builtin_bit_cast(unsigned, f); return (u + 0x7fffu + ((u >> 16) & 1u)) >> 16; }
__device__ __forceinline__ unsigned pk2(float lo, float hi) { return pg8::cvt_pk_bf16(lo, hi); }
__device__ __forceinline__ float bf2f(unsigned short h) { return __builtin_bit_cast(float, (unsigned)h << 16); }
__device__ __forceinline__ float bflo(unsigned w) { return __builtin_bit_cast(float, w << 16); }
__device__ __forceinline__ float bfhi(unsigned w) { return __builtin_bit_cast(float, w & 0xffff0000u); }
__device__ __forceinline__ float fsigmoid(float v) { return __builtin_amdgcn_rcpf(1.0f + __builtin_amdgcn_exp2f(-v * LOG2E)); }
__device__ __forceinline__ float fsilu(float v) { return v * fsigmoid(v); }
__device__ __forceinline__ float wave_sum(float v) {
#pragma unroll
    for (int o = 1; o < 64; o <<= 1) v += __shfl_xor(v, o);
    return v;
}
#define LDS_WAIT() asm volatile("s_waitcnt lgkmcnt(0)" ::: "memory")

struct Frame {
    LAS unsigned char* lds;
    int tid, lane, wave, vcu, G;
    const float *x, *meta, *norm_g, *w_in, *w_sb_out, *w_hg_out, *w_out, *hg_norm_g, *lbl, *final_g;
    float* out; unsigned char* ws;
    bf16 *WinT, *WsbT, *WhgT, *WoT, *U, *Q, *K, *V, *SG, *HQ, *HI, *HGT, *GH, *GS, *T1, *MG, *ST, *Y;
    bf16* Gf; float* DC;
};

__device__ __forceinline__ void store8bf(bf16* p, f32x4 a, f32x4 b) { v4u w; w.x = pk2(a[0], a[1]); w.y = pk2(a[2], a[3]); w.z = pk2(b[0], b[1]); w.w = pk2(b[2], b[3]); *(v4u*)p = w; }
template <int ACT> __device__ __forceinline__ float actf(float v) {
    if (ACT == 0) return v;
    if (ACT == 1) return v * QSCALE;
    if (ACT == 2) return fsilu(v);
    if (ACT == 3) return fsilu(v) * HG_SCALE;
    return fsigmoid(v);
}
struct EpiProj {
    static constexpr bool PERM = true, AFTER_DRAIN = false, HAS_MID = false;
    bf16 *Q, *K, *V, *SG, *HQ, *HI, *HGT, *GS, *GH; bf16* Gf; const float* lbl; unsigned char* wsb;
    template <int ACT> __device__ __forceinline__ void emit(const f32x4 (&acc)[2][2][4][2], bf16* base, int ldc, int row0, int col0) const {
#pragma unroll
        for (int ai = 0; ai < 2; ++ai)
#pragma unroll
            for (int m = 0; m < 4; ++m) { bf16* rowp = base + (size_t)(row0 + ai * 128 + m * 16) * ldc + col0;
#pragma unroll
                for (int bj = 0; bj < 2; ++bj) { f32x4 a = acc[ai][bj][m][0], b = acc[ai][bj][m][1];
#pragma unroll
                    for (int j = 0; j < 4; ++j) { a[j] = actf<ACT>(a[j]); b[j] = actf<ACT>(b[j]); }
                    store8bf(rowp + bj * 128, a, b); } }
    }
    __device__ __forceinline__ void operator()(const f32x4 (&acc)[2][2][4][2], const pg8::Unit& u, int wr, int wc, int fr, int fq) const {
        const int pn = u.pn, bb = u.pm >> 5;
        const int rowm = u.pm * 256 + wr * 64 + fr, rowp = rowm + 16 * (1 + bb);
        const int cin = wc * 32 + 8 * fq;
        int act, ldc, row0, col0; bf16* base;
        if (pn < 16) { const int grp = pn >> 1; col0 = (pn & 1) * 256 + cin; ldc = 512;
            act = (grp == 0) ? 1 : (grp == 3 || grp == 7) ? 2 : (grp == 4) ? 3 : (grp == 5) ? 5 : 0;
            const size_t boff = (grp == 0) ? WS_Q : (grp == 1) ? WS_K : (grp == 2) ? WS_V : (grp == 3) ? WS_SG : (grp == 4) ? WS_HQ : (grp == 6) ? WS_HI : WS_HGT; base = (bf16*)(wsb + boff);
            row0 = (grp == 1 || grp == 2 || grp == 5 || grp == 6) ? rowp : rowm;
        } else { act = 4; ldc = 1024; row0 = rowm; base = (pn < 20) ? GS : GH; col0 = ((pn - 16) & 3) * 256 + cin; }
        if (act == 5) {
#pragma unroll
            for (int bj = 0; bj < 2; ++bj) { float lb[8];
#pragma unroll
                for (int j = 0; j < 8; ++j) { const int c = col0 + bj * 128 + j; lb[j] = fsigmoid(lbl[c] - lbl[512 + c]); }
#pragma unroll
                for (int ai = 0; ai < 2; ++ai)
#pragma unroll
                    for (int m = 0; m < 4; ++m) { bf16* o = Gf + (size_t)(row0 + ai * 128 + m * 16) * 512 + col0 + bj * 128; f32x4 a = acc[ai][bj][m][0], b = acc[ai][bj][m][1];
#pragma unroll
                        for (int j = 0; j < 4; ++j) { a[j] = __logf(lb[j] + (1.0f - lb[j]) * fsigmoid(a[j])); b[j] = __logf(lb[4 + j] + (1.0f - lb[4 + j]) * fsigmoid(b[j])); }
                        store8bf(o, a, b); } }
            return;
        }
        if (act == 4) {
            unsigned char* gbase = (unsigned char*)base;
#pragma unroll
            for (int ai = 0; ai < 2; ++ai)
#pragma unroll
                for (int m = 0; m < 4; ++m) { unsigned char* rowq = gbase + (size_t)(row0 + ai * 128 + m * 16) * 1024 + col0;
#pragma unroll
                    for (int bj = 0; bj < 2; ++bj) { const f32x4 a = acc[ai][bj][m][0], b = acc[ai][bj][m][1]; unsigned qa[4], qb_[4];
#pragma unroll
                        for (int j = 0; j < 4; ++j) { qa[j] = (unsigned)fminf(fmaxf(fsigmoid(a[j]) * 255.0f + 0.5f, 1.0f), 255.0f); qb_[j] = (unsigned)fminf(fmaxf(fsigmoid(b[j]) * 255.0f + 0.5f, 1.0f), 255.0f); }
                        v2u w; w.x = qa[0] | (qa[1] << 8) | (qa[2] << 16) | (qa[3] << 24); w.y = qb_[0] | (qb_[1] << 8) | (qb_[2] << 16) | (qb_[3] << 24);
                        *(v2u*)(rowq + bj * 128) = w; } }
            return;
        }
        if (act <= 1) {
            const float lin = (act == 0) ? 1.0f : QSCALE;
#pragma unroll
            for (int ai = 0; ai < 2; ++ai)
#pragma unroll
                for (int m = 0; m < 4; ++m) { bf16* rowq = base + (size_t)(row0 + ai * 128 + m * 16) * ldc + col0;
#pragma unroll
                    for (int bj = 0; bj < 2; ++bj) store8bf(rowq + bj * 128, acc[ai][bj][m][0] * lin, acc[ai][bj][m][1] * lin); }
            return;
        }
        const float vs = (act == 2) ? 1.0f : HG_SCALE;
#pragma unroll
        for (int ai = 0; ai < 2; ++ai)
#pragma unroll
            for (int m = 0; m < 4; ++m) { bf16* rowq = base + (size_t)(row0 + ai * 128 + m * 16) * ldc + col0;
#pragma unroll
                for (int bj = 0; bj < 2; ++bj) { f32x4 a = acc[ai][bj][m][0], b = acc[ai][bj][m][1];
#pragma unroll
                    for (int j = 0; j < 4; ++j) { a[j] = vs * a[j] * fsigmoid(a[j]); b[j] = vs * b[j] * fsigmoid(b[j]); }
                    store8bf(rowq + bj * 128, a, b); } }
    }
};
template <int MODE> struct EpiGate {
    static constexpr bool PERM = true, AFTER_DRAIN = false, HAS_MID = false;
    const bf16* gate; const bf16* prev; bf16* O;
    __device__ __forceinline__ void operator()(const f32x4 (&acc)[2][2][4][2], const pg8::Unit& u, int wr, int wc, int fr, int fq) const {
        const int row0 = u.pm * 256 + wr * 64 + fr, col0 = u.pn * 256 + wc * 32 + 8 * fq;
#pragma unroll
        for (int ai = 0; ai < 2; ++ai)
#pragma unroll
            for (int m = 0; m < 4; ++m)
#pragma unroll
                for (int bj = 0; bj < 2; ++bj) { const size_t off = (size_t)(row0 + ai * 128 + m * 16) * 1024 + col0 + bj * 128;
                    const v4u g = *(const v4u*)(gate + off); f32x4 a = acc[ai][bj][m][0], b = acc[ai][bj][m][1];
                    a[0] *= bflo(g.x); a[1] *= bfhi(g.x); a[2] *= bflo(g.y); a[3] *= bfhi(g.y); b[0] *= bflo(g.z); b[1] *= bfhi(g.z); b[2] *= bflo(g.w); b[3] *= bfhi(g.w);
                    if (MODE == 1) { const v4u p = *(const v4u*)(prev + off);
                        a[0] += bflo(p.x); a[1] += bfhi(p.x); a[2] += bflo(p.y); a[3] += bfhi(p.y); b[0] += bflo(p.z); b[1] += bfhi(p.z); b[2] += bflo(p.w); b[3] += bfhi(p.w); }
                    store8bf(O + off, a, b); }
    }
};
struct EpiRes {
    static constexpr bool PERM = true, AFTER_DRAIN = false, HAS_MID = false;
    const float* x; float* out;
    __device__ __forceinline__ void operator()(const f32x4 (&acc)[2][2][4][2], const pg8::Unit& u, int wr, int wc, int fr, int fq) const {
        const int row0 = u.pm * 256 + wr * 64 + fr, col0 = u.pn * 256 + wc * 32 + 8 * fq;
#pragma unroll
        for (int ai = 0; ai < 2; ++ai)
#pragma unroll
            for (int m = 0; m < 4; ++m)
#pragma unroll
                for (int bj = 0; bj < 2; ++bj) { const size_t off = (size_t)(row0 + ai * 128 + m * 16) * 1024 + col0 + bj * 128;
                    const f32x4 x0 = *(const f32x4*)(x + off), x1 = *(const f32x4*)(x + off + 4);
                    f32x4 c0 = acc[ai][bj][m][0], c1 = acc[ai][bj][m][1];
                    if (DBG_SKIP & 32768) { for (int j = 0; j < 4; ++j) { c0[j] = fminf(fmaxf(c0[j], -1.5f), 1.5f); c1[j] = fminf(fmaxf(c1[j], -1.5f), 1.5f); } }
                    *(f32x4*)(out + off) = x0 + c0; *(f32x4*)(out + off + 4) = x1 + c1; }
    }
};

struct EpiMerge {
    static constexpr bool PERM = true, AFTER_DRAIN = false, HAS_MID = true;
    const unsigned char* GS; const unsigned char* GH; bf16* O;
    __device__ __forceinline__ void mid(f32x4 (&acc)[2][2][4][2], const pg8::Unit& u, int wr, int wc, int fr, int fq) const {
        int row0 = u.pm * 256 + wr * 64 + fr, col0 = u.pn * 256 + wc * 32 + 8 * fq;
        asm volatile("" : "+v"(row0), "+v"(col0));
#pragma unroll
        for (int ai = 0; ai < 2; ++ai)
#pragma unroll
            for (int m = 0; m < 4; ++m)
#pragma unroll
                for (int bj = 0; bj < 2; ++bj) { const size_t off = (size_t)(row0 + ai * 128 + m * 16) * 1024 + col0 + bj * 128; const v2u s_ = *(const v2u*)(GS + off), h_ = *(const v2u*)(GH + off);
#pragma unroll
                    for (int n = 0; n < 2; ++n) { const unsigned sw = n ? s_.y : s_.x, hw = n ? h_.y : h_.x; f32x4 a = acc[ai][bj][m][n];
#pragma unroll
                        for (int e = 0; e < 4; ++e) a[e] *= (float)((sw >> (8 * e)) & 255u) * __builtin_amdgcn_rcpf((float)((hw >> (8 * e)) & 255u));
                        asm volatile("" : "+v"(a) :: "memory"); acc[ai][bj][m][n] = a; } }
    }
    __device__ __forceinline__ void operator()(const f32x4 (&acc)[2][2][4][2], const pg8::Unit& u, int wr, int wc, int fr, int fq) const {
        const int row0 = u.pm * 256 + wr * 64 + fr, col0 = u.pn * 256 + wc * 32 + 8 * fq;
#pragma unroll
        for (int ai = 0; ai < 2; ++ai)
#pragma unroll
            for (int m = 0; m < 4; ++m)
#pragma unroll
                for (int bj = 0; bj < 2; ++bj) { const size_t off = (size_t)(row0 + ai * 128 + m * 16) * 1024 + col0 + bj * 128; const v2u h_ = *(const v2u*)(GH + off); f32x4 a = acc[ai][bj][m][0], b = acc[ai][bj][m][1];
#pragma unroll
                    for (int e = 0; e < 4; ++e) { a[e] *= (float)((h_.x >> (8 * e)) & 255u) * (1.0f / 255.0f); b[e] *= (float)((h_.y >> (8 * e)) & 255u) * (1.0f / 255.0f); }
                    store8bf(O + off, a, b); }
    }
};

__device__ __forceinline__ void p0_transpose_item(const float* W, int K, int N, bf16* WT, int ldt, LAS float* scr, int item, int lane) {
    const int nblk = N / 32, kb = item / nblk, nb = item % nblk, k0 = 64 * kb, n0 = 32 * nb;
#pragma unroll 8
    for (int i = 0; i < 32; ++i) { const int kk = 2 * i + (lane >> 5); scr[kk * 33 + (lane & 31)] = __builtin_nontemporal_load(W + (size_t)(k0 + kk) * N + n0 + (lane & 31)); }
    LDS_WAIT();
    const int c = lane & 7;
#pragma unroll
    for (int j = 0; j < 4; ++j) { const int n = (lane >> 3) + 8 * j; const LAS float* s = scr + (8 * c) * 33 + n;
        v4u o; o.x = pk2(s[0 * 33], s[1 * 33]); o.y = pk2(s[2 * 33], s[3 * 33]); o.z = pk2(s[4 * 33], s[5 * 33]); o.w = pk2(s[6 * 33], s[7 * 33]);
        *(v4u*)(WT + (size_t)(n0 + n) * ldt + k0 + 8 * c) = o; }
    LDS_WAIT();
}
__device__ __forceinline__ void meta_item(Frame& F, int it) {
    LAS float* um = (LAS float*)F.lds;
    LAS float* red = (LAS float*)(F.lds + 65536);
#pragma unroll
    for (int rr = 0; rr < 2; ++rr) { const int row = F.wave * 2 + rr; const f32x4* xr = (const f32x4*)(F.meta + row * 1024) + F.lane; const f32x4* gr = (const f32x4*)F.norm_g + F.lane;
        f32x4 v[4]; float s = 0.f;
#pragma unroll
        for (int j = 0; j < 4; ++j) { v[j] = xr[64 * j]; s += (v[j][0] * v[j][0] + v[j][1] * v[j][1]) + (v[j][2] * v[j][2] + v[j][3] * v[j][3]); }
        const float rstd = rsqrtf(wave_sum(s) * (1.0f / 1024.0f) + EPS);
#pragma unroll
        for (int j = 0; j < 4; ++j) { const f32x4 g = gr[64 * j];
#pragma unroll
            for (int e = 0; e < 4; ++e) um[(4 * (F.lane + 64 * j) + e) * 16 + row] = v[j][e] * rstd * g[e]; } }
    __syncthreads();
    const int cl = F.tid & 63, kg = F.tid >> 6;
    const int c0 = (it < 16) ? 512 + 64 * it : 2560 + 64 * (it - 16);
    float acc[16];
#pragma unroll
    for (int r = 0; r < 16; ++r) acc[r] = 0.f;
    const float* wp = F.w_in + (size_t)(kg * 128) * INC + c0 + cl;
#pragma unroll 4
    for (int k = 0; k < 128; ++k) { const float w = wp[(size_t)k * INC]; const LAS f32x4* up = (const LAS f32x4*)(um + (kg * 128 + k) * 16);
#pragma unroll
        for (int q = 0; q < 4; ++q) { const f32x4 u = up[q];
#pragma unroll
            for (int e = 0; e < 4; ++e) acc[4 * q + e] += u[e] * w; } }
#pragma unroll
    for (int r = 0; r < 16; ++r) red[(kg * 16 + r) * 64 + cl] = acc[r];
    __syncthreads();
    for (int o = F.tid; o < 1024; o += 512) { const int r = o >> 6, c = o & 63; float s = 0.f;
#pragma unroll
        for (int k2 = 0; k2 < 8; ++k2) s += red[(k2 * 16 + r) * 64 + c];
        const int col = c0 + c;
#pragma unroll
        for (int b = 0; b < 2; ++b) { const size_t prow = (size_t)b * LPOS + r;
            if (col < 1024) F.K[prow * 512 + col - 512] = (bf16)f2bf(s);
            else if (col < 1536) F.V[prow * 512 + col - 1024] = (bf16)f2bf(s);
            else if (col < 3072) { const int cc = col - 2560; const float lb = fsigmoid(F.lbl[cc] - F.lbl[512 + cc]); F.Gf[prow * 512 + cc] = (bf16)f2bf(__logf(lb + (1.0f - lb) * fsigmoid(s))); }
            else F.HI[prow * 512 + col - 3072] = (bf16)f2bf(s); } }
    __syncthreads();
}
__device__ __forceinline__ void p0_prologue(Frame& F) {
    if (blockIdx.x < 32) meta_item(F, blockIdx.x);
    LAS float* scr = (LAS float*)(F.lds + F.wave * 16384);
    const int gw = F.vcu * NWAVES + F.wave, NGW = F.G * NWAVES;
    constexpr int I_IN = (1024 / 64) * (INC / 32), I_SB = (512 / 64) * (1024 / 32), I_O = (1024 / 64) * (1024 / 32);
    constexpr int NITEMS = I_IN + 2 * I_SB + I_O;
    for (int it = gw; it < NITEMS; it += NGW) {
        int r = it;
        if (r < I_IN) { p0_transpose_item(F.w_in, 1024, INC, F.WinT, 1024, scr, r, F.lane); continue; } r -= I_IN;
        if (r < I_SB) { p0_transpose_item(F.w_sb_out, 512, 1024, F.WsbT, 1024, scr, r, F.lane); continue; } r -= I_SB;
        if (r < I_SB) { p0_transpose_item(F.w_hg_out, 512, 1024, F.WsbT + 512, 1024, scr, r, F.lane); continue; } r -= I_SB;
        p0_transpose_item(F.w_out, 1024, 1024, F.WoT, 1024, scr, r, F.lane);
    }
    for (int m = gw; m < MX; m += 2 * NGW) {
        const int m2 = m + NGW; const bool has2 = m2 < MX;
        const f32x4* xr = (const f32x4*)(F.x + (size_t)m * DM) + F.lane; const f32x4* xr2 = (const f32x4*)(F.x + (size_t)(has2 ? m2 : m) * DM) + F.lane; const f32x4* gr = (const f32x4*)F.norm_g + F.lane;
        f32x4 v[4], w2[4]; float s = 0.f, s2 = 0.f;
#pragma unroll
        for (int j = 0; j < 4; ++j) { v[j] = __builtin_nontemporal_load(xr + 64 * j); w2[j] = __builtin_nontemporal_load(xr2 + 64 * j); }
#pragma unroll
        for (int j = 0; j < 4; ++j) { s += (v[j][0] * v[j][0] + v[j][1] * v[j][1]) + (v[j][2] * v[j][2] + v[j][3] * v[j][3]); s2 += (w2[j][0] * w2[j][0] + w2[j][1] * w2[j][1]) + (w2[j][2] * w2[j][2] + w2[j][3] * w2[j][3]); }
        const float rstd = rsqrtf(wave_sum(s) * (1.0f / 1024.0f) + EPS), rstd2 = rsqrtf(wave_sum(s2) * (1.0f / 1024.0f) + EPS);
        v2u* o8 = (v2u*)(F.U + (size_t)m * DM) + F.lane; v2u* o82 = (v2u*)(F.U + (size_t)m2 * DM) + F.lane;
#pragma unroll
        for (int j = 0; j < 4; ++j) { const f32x4 g = gr[64 * j]; v2u w; w.x = pk2(v[j][0] * rstd * g[0], v[j][1] * rstd * g[1]); w.y = pk2(v[j][2] * rstd * g[2], v[j][3] * rstd * g[3]); o8[64 * j] = w;
            if (has2) { v2u u; u.x = pk2(w2[j][0] * rstd2 * g[0], w2[j][1] * rstd2 * g[1]); u.y = pk2(w2[j][2] * rstd2 * g[2], w2[j][3] * rstd2 * g[3]); o82[64 * j] = u; } }
    }
}

#define ATT_PROCESS(qf_, o0_, o1_, R_, qpos_, masked_) do { \
    f32x16 z; _Pragma("unroll") for (int i = 0; i < 16; ++i) z[i] = 0.f; \
    _Pragma("unroll") for (int s = 0; s < 4; ++s) z = __builtin_amdgcn_mfma_f32_32x32x16_bf16(kf[s], qf_[s], z, 0, 0, 0); \
    float sp[16], lbv[16]; \
    if (masked_) { _Pragma("unroll") for (int i = 0; i < 16; ++i) { const int kpos = kb + (i & 3) + 8 * (i >> 2) + 4 * hh; const bool valid = (kpos < (qpos_)) && (kpos >= 0); \
            const float zz = fminf(z[i], 126.f); float s_; asm("v_log_f32 %0, %1" : "=v"(s_) : "v"(1.0f + __builtin_amdgcn_exp2f(zz))); sp[i] = valid ? s_ : 0.f; lbv[i] = valid ? (zz - s_) : -INFINITY; } } \
    else { _Pragma("unroll") for (int i = 0; i < 16; ++i) { const float zz = fminf(z[i], 126.f); float s_; asm("v_log_f32 %0, %1" : "=v"(s_) : "v"(1.0f + __builtin_amdgcn_exp2f(zz))); sp[i] = s_; lbv[i] = zz - s_; } } \
    float gs[4], ps[4], after[4]; \
    _Pragma("unroll") for (int g = 0; g < 4; ++g) { gs[g] = (sp[4 * g] + sp[4 * g + 1]) + (sp[4 * g + 2] + sp[4 * g + 3]); ps[g] = __shfl_xor(gs[g], 32); } \
    float tot = 0.f; \
    _Pragma("unroll") for (int g = 3; g >= 0; --g) { after[g] = tot + (hh == 0 ? ps[g] : 0.f); tot += gs[g] + ps[g]; } \
    float w[16]; \
    _Pragma("unroll") for (int g = 0; g < 4; ++g) { float run = (R_) + after[g]; \
        _Pragma("unroll") for (int ii = 3; ii >= 0; --ii) { const int i = 4 * g + ii; w[i] = __builtin_amdgcn_exp2f(lbv[i] - run); run += sp[i]; } } \
    (R_) += tot; \
    _Pragma("unroll") for (int s = 0; s < 2; ++s) { v4u t_; t_.x = pk2(w[8 * s], w[8 * s + 1]); t_.y = pk2(w[8 * s + 2], w[8 * s + 3]); t_.z = pk2(w[8 * s + 4], w[8 * s + 5]); t_.w = pk2(w[8 * s + 6], w[8 * s + 7]); \
        const bf16x8 wf_ = __builtin_bit_cast(bf16x8, t_); \
        o0_ = __builtin_amdgcn_mfma_f32_32x32x16_bf16(vfr[s][0], wf_, o0_, 0, 0, 0); o1_ = __builtin_amdgcn_mfma_f32_32x32x16_bf16(vfr[s][1], wf_, o1_, 0, 0, 0); } } while (0)
template <int DUMMY> __device__ __forceinline__ void attn_phase_t(Frame& F) {
    LAS bf16* vt = (LAS bf16*)(F.lds + F.wave * 8192);
    const int lane = F.lane, r = lane & 31, hh = lane >> 5;
    const int gw = F.vcu * NWAVES + F.wave, NGW = F.G * NWAVES;
#define ATT_LOADK(kb_, kf_) do { int kp_ = (kb_) + r; kp_ = kp_ < 0 ? 0 : kp_; const bf16* krow_ = F.K + (prow0 + kp_) * 512 + h * 64 + 8 * hh; \
            _Pragma("unroll") for (int s_ = 0; s_ < 4; ++s_) kf_[s_] = *(const bf16x8*)(krow_ + 16 * s_); } while (0)
#define ATT_LOADV(kb_, vv_) do { _Pragma("unroll") for (int i_ = 0; i_ < 4; ++i_) { const int idx_ = lane + 64 * i_, key_ = idx_ & 31, c_ = idx_ >> 5; int vp_ = (kb_) + key_; vp_ = vp_ < 0 ? 0 : vp_; \
                vv_[i_] = *(const v4u*)(F.V + (prow0 + vp_) * 512 + h * 64 + 8 * c_); } } while (0)
    for (int it = gw; it < 2048; it += NGW) {
        const int qb = it & 127, h = (it >> 7) & 7, b = it >> 10; const int mA = b * SEQ + qb * 64 + r, mB = mA + 32; const size_t prow0 = (size_t)b * LPOS;
        const int kbA0 = NMETA + qb * 64, kbB0 = kbA0 + 32, qposA = kbA0 + r, qposB = kbB0 + r;
        bf16x8 qfA[4], qfB[4], kf[4], kfn[4]; v4u vv[4];
#pragma unroll
        for (int s = 0; s < 4; ++s) { qfA[s] = *(const bf16x8*)(F.Q + (size_t)mA * 512 + h * 64 + 8 * hh + 16 * s); qfB[s] = *(const bf16x8*)(F.Q + (size_t)mB * 512 + h * 64 + 8 * hh + 16 * s); }
        ATT_LOADK(kbB0, kf); ATT_LOADV(kbB0, vv);
        f32x16 oA0, oA1, oB0, oB1;
#pragma unroll
        for (int i = 0; i < 16; ++i) { oA0[i] = 0.f; oA1[i] = 0.f; oB0[i] = 0.f; oB1[i] = 0.f; }
        float RA = 0.f, RB = 0.f; bool doneB = false;
        for (int kb = kbB0;; kb -= 32) {
            ATT_LOADK(kb - 32, kfn);
#pragma unroll
            for (int i = 0; i < 4; ++i) { const int idx = lane + 64 * i, key = idx & 31, c = idx >> 5; const unsigned ww[4] = {vv[i].x, vv[i].y, vv[i].z, vv[i].w};
#pragma unroll
                for (int j = 0; j < 4; ++j) { vt[(8 * c + 2 * j) * 36 + key] = (bf16)(ww[j] & 0xffffu); vt[(8 * c + 2 * j + 1) * 36 + key] = (bf16)(ww[j] >> 16); } }
            ATT_LOADV(kb - 32, vv);
            LDS_WAIT();
            bf16x8 vfr[2][2];
#pragma unroll
            for (int s = 0; s < 2; ++s)
#pragma unroll
                for (int db = 0; db < 2; ++db) { const LAS bf16* vp = vt + (32 * db + r) * 36 + 16 * s + 4 * hh; const bf16x4 lo = *(const LAS bf16x4*)vp, hi = *(const LAS bf16x4*)(vp + 8);
                    vfr[s][db] = (bf16x8){lo[0], lo[1], lo[2], lo[3], hi[0], hi[1], hi[2], hi[3]}; }
            LDS_WAIT();
            if (!doneB) { if (kb == kbB0 || kb < 0) ATT_PROCESS(qfB, oB0, oB1, RB, qposB, true); else ATT_PROCESS(qfB, oB0, oB1, RB, qposB, false); }
            if (kb <= kbA0) { if (kb == kbA0 || kb < 0) ATT_PROCESS(qfA, oA0, oA1, RA, qposA, true); else ATT_PROCESS(qfA, oA0, oA1, RA, qposA, false); }
            if (kb <= 0) break;
            doneB = __all(RB >= EXIT_BITS);
            if (doneB && kb <= kbA0 && __all(RA >= EXIT_BITS)) break;
#pragma unroll
            for (int s = 0; s < 4; ++s) kf[s] = kfn[s];
        }
#pragma unroll
        for (int g = 0; g < 8; ++g) { const int db = g >> 2, gg = g & 3; const int d0 = h * 64 + 32 * db + 8 * gg + 4 * hh;
            const v2u sga = *(const v2u*)(F.SG + (size_t)mA * 512 + d0), sgb = *(const v2u*)(F.SG + (size_t)mB * 512 + d0);
            const f32x16& oa = db ? oA1 : oA0; const f32x16& ob = db ? oB1 : oB0; v2u ya, yb;
            ya.x = pk2(oa[4 * gg] * bflo(sga.x), oa[4 * gg + 1] * bfhi(sga.x)); ya.y = pk2(oa[4 * gg + 2] * bflo(sga.y), oa[4 * gg + 3] * bfhi(sga.y));
            yb.x = pk2(ob[4 * gg] * bflo(sgb.x), ob[4 * gg + 1] * bfhi(sgb.x)); yb.y = pk2(ob[4 * gg + 2] * bflo(sgb.y), ob[4 * gg + 3] * bfhi(sgb.y));
            if (DUMMY) { *(v2u*)((bf16*)(F.ws + 231 * MiB) + (size_t)(mA % 12288) * 1024 + d0) = ya; } else { *(v2u*)(F.Y + (size_t)mA * 1024 + d0) = ya; *(v2u*)(F.Y + (size_t)mB * 1024 + d0) = yb; } }
    }
}
__device__ __forceinline__ void attn_phase(Frame& F) { attn_phase_t<0>(F); }
__device__ __forceinline__ void stage_iT(Frame& F, LAS bf16* iT, size_t prow, int hh, int nv) {
#pragma unroll
    for (int q = 0; q < 2; ++q) { const int idx = F.tid + 512 * q, s = idx & 63, c8 = idx >> 6;
        v4u w = {0u, 0u, 0u, 0u}; if (s < nv) w = *(const v4u*)(F.HI + (prow + s) * 512 + hh * 128 + 8 * c8);
        const unsigned ww[4] = {w.x, w.y, w.z, w.w};
#pragma unroll
        for (int j = 0; j < 4; ++j) { iT[(8 * c8 + 2 * j) * 72 + s] = (bf16)(ww[j] & 0xffffu); iT[(8 * c8 + 2 * j + 1) * 72 + s] = (bf16)(ww[j] >> 16); } }
}
#define LDS_BAR() do { asm volatile("s_waitcnt lgkmcnt(0)" ::: "memory"); __builtin_amdgcn_s_barrier(); asm volatile("" ::: "memory"); } while (0)
#define P2_DECODE(un_, stream_, c_, b_, hh_, nvl_, prow_) const int stream_ = (un_) >> 7, c_ = (un_) & 127, b_ = stream_ >> 2, hh_ = stream_ & 3, nvl_ = c_ ? 64 : NMETA; \
    const size_t prow_ = (size_t)b_ * LPOS + (c_ ? NMETA + 64 * (c_ - 1) : 0);
#define P2_LOAD(un_, iw_, gg_) do { P2_DECODE(un_, st_, cc_, b_, hh_, nv_, prow_) \
    _Pragma("unroll") for (int q2 = 0; q2 < 2; ++q2) { const int idx = F.tid + 512 * q2, s_ = idx & 63, c8 = idx >> 6; iw_[q2] = (v4u){0u, 0u, 0u, 0u}; if (s_ < nv_) iw_[q2] = *(const v4u*)(F.HI + (prow_ + s_) * 512 + hh_ * 128 + 8 * c8); } \
    { const int kp = F.tid & 63, q = F.tid >> 6; _Pragma("unroll") for (int jj = 0; jj < 8; ++jj) { const int t = 8 * q + jj; gg_[jj] = 0u; if (t < nv_) gg_[jj] = *(const unsigned*)(F.Gf + (prow_ + t) * 512 + hh_ * 128 + 2 * kp); } } } while (0)
__device__ __forceinline__ void hgrn_local_phase(Frame& F) {
    LAS bf16* KhT = (LAS bf16*)(F.lds);
    LAS bf16* iT = (LAS bf16*)(F.lds + 18432);
    LAS float* seg = (LAS float*)(F.lds + 36864);
    const int r = F.lane & 31, h2 = F.lane >> 5, wv = F.wave >> 1, wk = F.wave & 1;
    v4u iw[2]; unsigned gg[8];
    if (F.vcu < 1024) P2_LOAD(F.vcu, iw, gg);
    for (int un = F.vcu; un < 1024; un += F.G) {
        P2_DECODE(un, stream, c_, b, hh, nvl, prow)
        (void)b; (void)hh; (void)nvl; (void)prow;
#pragma unroll
        for (int q2 = 0; q2 < 2; ++q2) { const int idx = F.tid + 512 * q2, s_ = idx & 63, c8 = idx >> 6; const unsigned ww[4] = {iw[q2].x, iw[q2].y, iw[q2].z, iw[q2].w};
#pragma unroll
            for (int j = 0; j < 4; ++j) { iT[(8 * c8 + 2 * j) * 72 + s_] = (bf16)(ww[j] & 0xffffu); iT[(8 * c8 + 2 * j + 1) * 72 + s_] = (bf16)(ww[j] >> 16); } }
        { const int kp = F.tid & 63, q = F.tid >> 6; float g0[8], g1[8], c0[8], c1[8]; float run0 = 0.f, run1 = 0.f;
#pragma unroll
            for (int jj = 0; jj < 8; ++jj) { g0[jj] = bflo(gg[jj]); g1[jj] = bfhi(gg[jj]); }
            if (un + F.G < 1024) P2_LOAD(un + F.G, iw, gg);
#pragma unroll
            for (int jj = 0; jj < 8; ++jj) { run0 += g0[jj]; run1 += g1[jj]; c0[jj] = run0; c1[jj] = run1; }
            *(LAS f32x2*)(seg + q * 128 + 2 * kp) = (f32x2){run0, run1};
            LDS_BAR();
            float pre0 = 0.f, pre1 = 0.f, bl0 = 0.f, bl1 = 0.f;
#pragma unroll
            for (int qq = 0; qq < 8; ++qq) { const f32x2 sv = *(const LAS f32x2*)(seg + qq * 128 + 2 * kp); bl0 += sv[0]; bl1 += sv[1]; if (qq < q) { pre0 += sv[0]; pre1 += sv[1]; } }
            if (q == 0) *(f32x2*)(F.DC + (stream * 128 + c_) * 128 + 2 * kp) = (f32x2){__expf(bl0), __expf(bl1)};
            float k0[8], k1[8];
#pragma unroll
            for (int jj = 0; jj < 8; ++jj) { k0[jj] = (1.0f - __expf(g0[jj])) * __expf(bl0 - (pre0 + c0[jj])); k1[jj] = (1.0f - __expf(g1[jj])) * __expf(bl1 - (pre1 + c1[jj])); }
            v4u w0, w1; w0.x = pk2(k0[0], k0[1]); w0.y = pk2(k0[2], k0[3]); w0.z = pk2(k0[4], k0[5]); w0.w = pk2(k0[6], k0[7]); w1.x = pk2(k1[0], k1[1]); w1.y = pk2(k1[2], k1[3]); w1.z = pk2(k1[4], k1[5]); w1.w = pk2(k1[6], k1[7]);
            *(LAS v4u*)(KhT + (2 * kp) * 72 + 8 * q) = w0; *(LAS v4u*)(KhT + (2 * kp + 1) * 72 + 8 * q) = w1; }
        LDS_BAR();
        f32x16 a0, a1;
#pragma unroll
        for (int i = 0; i < 16; ++i) { a0[i] = 0.f; a1[i] = 0.f; }
#pragma unroll
        for (int ks = 0; ks < 4; ++ks) { const bf16x8 af = *(const LAS bf16x8*)(iT + (32 * wv + r) * 72 + 16 * ks + 8 * h2);
            const bf16x8 b0 = *(const LAS bf16x8*)(KhT + (64 * wk + r) * 72 + 16 * ks + 8 * h2), b1 = *(const LAS bf16x8*)(KhT + (64 * wk + 32 + r) * 72 + 16 * ks + 8 * h2);
            a0 = __builtin_amdgcn_mfma_f32_32x32x16_bf16(af, b0, a0, 0, 0, 0); a1 = __builtin_amdgcn_mfma_f32_32x32x16_bf16(af, b1, a1, 0, 0, 0); }
        bf16* st = F.ST + (size_t)(stream * 128 + c_) * 16384;
#pragma unroll
        for (int i = 0; i < 16; ++i) { const int v = 32 * wv + (i & 3) + 8 * (i >> 2) + 4 * h2; st[v * 128 + 64 * wk + r] = (bf16)f2bf(a0[i]); st[v * 128 + 64 * wk + 32 + r] = (bf16)f2bf(a1[i]); }
        LDS_BAR();
    }
    asm volatile("s_waitcnt vmcnt(0)" ::: "memory");
}
__device__ __forceinline__ void hgrn_scan_phase(Frame& F, bf16* OUT) {
    LAS float* ldc = (LAS float*)F.lds;
    for (int blk = F.vcu; blk < 256; blk += F.G) {
        const int stream = blk >> 5, e = (blk & 31) * 512 + F.tid, k = e & 127; bf16* st = F.ST + (size_t)stream * 128 * 16384 + e; bf16* so = OUT + (size_t)stream * 128 * 16384 + e;
        const f32x4* dsrc = (const f32x4*)(F.DC + stream * 16384);
#pragma unroll
        for (int i = 0; i < 8; ++i) ((LAS f32x4*)ldc)[F.tid + 512 * i] = dsrc[F.tid + 512 * i];
        float S = 0.f;
#pragma unroll 1
        for (int c0 = 0; c0 < 128; c0 += 32) {
            unsigned u[32];
#pragma unroll
            for (int c = 0; c < 32; ++c) u[c] = st[(size_t)(c0 + c) * 16384];
            if (c0 == 0) __syncthreads();
#pragma unroll
            for (int c = 0; c < 32; ++c) { S = ldc[(c0 + c) * 128 + k] * S + __builtin_bit_cast(float, u[c] << 16); so[(size_t)(c0 + c) * 16384] = (bf16)f2bf(S); }
        }
        __syncthreads();
    }
}
#define P4_BAR() do { asm volatile("s_waitcnt lgkmcnt(0)" ::: "memory"); __builtin_amdgcn_s_barrier(); asm volatile("" ::: "memory"); } while (0)
#define P4_DECODE(un_, stream_, c_, nv_, b_, hh_, prow_, m0_) \
    const int stream_ = (un_) >> 7, c_ = (un_) & 127; \
    const int nv_ = 64, b_ = stream_ >> 2, hh_ = stream_ & 3; const size_t prow_ = (size_t)b_ * LPOS + NMETA + 64 * c_; const int m0_ = b_ * SEQ + 64 * c_;
#define P4_LOAD(un_, iw_, g_, qh_) do { P4_DECODE(un_, st_, cc_, nv_, b_, hh_, prow_, m0_) \
    _Pragma("unroll") for (int q2 = 0; q2 < 2; ++q2) { const int idx = F.tid + 512 * q2, s_ = idx & 63, c8 = idx >> 6; iw_[q2] = (v4u){0u, 0u, 0u, 0u}; if (s_ < nv_) iw_[q2] = *(const v4u*)(F.HI + (prow_ + s_) * 512 + hh_ * 128 + 8 * c8); } \
    { const int kp = F.tid & 63, q = F.tid >> 6; _Pragma("unroll") for (int jj = 0; jj < 8; ++jj) { const int t = 8 * q + jj; \
        const unsigned gg = *(const unsigned*)(F.Gf + (prow_ + t) * 512 + hh_ * 128 + 2 * kp); g_[2 * jj] = bflo(gg); g_[2 * jj + 1] = bfhi(gg); \
        const unsigned qq = *(const unsigned*)(F.HQ + (size_t)(m0_ + t) * 512 + hh_ * 128 + 2 * kp); qh_[2 * jj] = qq & 0xffffu; qh_[2 * jj + 1] = qq >> 16; } } } while (0)
__device__ __forceinline__ void hgrn_out_phase(Frame& F) {
    LAS bf16* Qt = (LAS bf16*)(F.lds);
    LAS bf16* Kt = (LAS bf16*)(F.lds + 17408);
    LAS bf16* iT = (LAS bf16*)(F.lds + 34816);
    LAS bf16* As = (LAS bf16*)(F.lds + 53248);
    LAS float* Of = (LAS float*)(F.lds + 62464);
    LAS float* seg = (LAS float*)(F.lds + 96256);
    const int r = F.lane & 31, h2 = F.lane >> 5;
    v4u iw[2]; float g[16]; unsigned qh[16];
    if (F.vcu < 1024) P4_LOAD(F.vcu, iw, g, qh);
    for (int un = F.vcu; un < 1024; un += F.G) {
        P4_DECODE(un, stream, c, nv, b, hh, prow, m0)
#pragma unroll
        for (int q2 = 0; q2 < 2; ++q2) { const int idx = F.tid + 512 * q2, s_ = idx & 63, c8 = idx >> 6; const unsigned ww[4] = {iw[q2].x, iw[q2].y, iw[q2].z, iw[q2].w};
#pragma unroll
            for (int j = 0; j < 4; ++j) { iT[(8 * c8 + 2 * j) * 72 + s_] = (bf16)(ww[j] & 0xffffu); iT[(8 * c8 + 2 * j + 1) * 72 + s_] = (bf16)(ww[j] >> 16); } }
        float cs[16], qv[16], gk[16];
        { const int kp = F.tid & 63, q = F.tid >> 6; float run0 = 0.f, run1 = 0.f;
#pragma unroll
            for (int jj = 0; jj < 8; ++jj) { gk[2 * jj] = g[2 * jj]; gk[2 * jj + 1] = g[2 * jj + 1]; qv[2 * jj] = __builtin_bit_cast(float, qh[2 * jj] << 16); qv[2 * jj + 1] = __builtin_bit_cast(float, qh[2 * jj + 1] << 16);
                run0 += gk[2 * jj]; run1 += gk[2 * jj + 1]; cs[2 * jj] = run0; cs[2 * jj + 1] = run1; }
            *(LAS f32x2*)(seg + q * 128 + 2 * kp) = (f32x2){run0, run1}; }
        bf16x8 sbc[8]; v4u gate0 = {0u, 0u, 0u, 0u}, gate1 = {0u, 0u, 0u, 0u};
        { const int wv = F.wave & 3; const bf16* sp = F.ST + (size_t)(stream * 128 + c) * 16384 + (32 * wv + r) * 128 + 8 * h2;
#pragma unroll
          for (int ks = 0; ks < 8; ++ks) sbc[ks] = *(const bf16x8*)(sp + 16 * ks);
          const int t = F.tid >> 3, sg_ = F.tid & 7; const int mrow = m0 + t;
          if ((t < nv) && (mrow >= b * SEQ)) { const v4u* gp_ = (const v4u*)(F.HGT + (size_t)mrow * 512 + hh * 128 + 16 * sg_); gate0 = gp_[0]; gate1 = gp_[1]; } }
        if (un + F.G < 1024) P4_LOAD(un + F.G, iw, g, qh);
        P4_BAR();
        { const int kp = F.tid & 63, q = F.tid >> 6; float pre0 = 0.f, pre1 = 0.f;
#pragma unroll
            for (int qq = 0; qq < 7; ++qq) { const f32x2 sv = *(const LAS f32x2*)(seg + qq * 128 + 2 * kp); if (qq < q) { pre0 += sv[0]; pre1 += sv[1]; } }
#pragma unroll
            for (int jj = 0; jj < 8; ++jj) { const int t = 8 * q + jj; const float b0 = pre0 + cs[2 * jj], b1 = pre1 + cs[2 * jj + 1];
                *(LAS unsigned*)(Qt + t * 136 + 2 * kp) = pk2(qv[2 * jj] * __expf(b0), qv[2 * jj + 1] * __expf(b1));
                *(LAS unsigned*)(Kt + t * 136 + 2 * kp) = pk2((1.0f - __expf(gk[2 * jj])) * __expf(-b0), (1.0f - __expf(gk[2 * jj + 1])) * __expf(-b1)); } }
        P4_BAR();
        if (F.wave < 3) { const int tt = F.wave > 0, ts = F.wave == 2; f32x16 a;
#pragma unroll
            for (int i = 0; i < 16; ++i) a[i] = 0.f;
#pragma unroll
            for (int ks = 0; ks < 8; ++ks) { const bf16x8 af = *(const LAS bf16x8*)(Qt + (32 * tt + r) * 136 + 16 * ks + 8 * h2), bfr = *(const LAS bf16x8*)(Kt + (32 * ts + r) * 136 + 16 * ks + 8 * h2);
                a = __builtin_amdgcn_mfma_f32_32x32x16_bf16(af, bfr, a, 0, 0, 0); }
#pragma unroll
            for (int i = 0; i < 16; ++i) { const int t = 32 * tt + (i & 3) + 8 * (i >> 2) + 4 * h2, s_ = 32 * ts + r; As[t * 72 + s_] = (s_ <= t) ? (bf16)f2bf(a[i]) : (bf16)0; }
        } else if (F.wave == 3) {
#pragma unroll
            for (int i = 0; i < 16; ++i) { const int t = (i & 3) + 8 * (i >> 2) + 4 * h2; As[t * 72 + 32 + r] = (bf16)0; }
        }
        P4_BAR();
        { const int wt = F.wave >> 2, wv = F.wave & 3; f32x16 o;
#pragma unroll
            for (int i = 0; i < 16; ++i) o[i] = 0.f;
#pragma unroll
            for (int ks = 0; ks < 4; ++ks) { const bf16x8 af = *(const LAS bf16x8*)(As + (32 * wt + r) * 72 + 16 * ks + 8 * h2), bfr = *(const LAS bf16x8*)(iT + (32 * wv + r) * 72 + 16 * ks + 8 * h2);
                o = __builtin_amdgcn_mfma_f32_32x32x16_bf16(af, bfr, o, 0, 0, 0); }
#pragma unroll
            for (int ks = 0; ks < 8; ++ks) { const bf16x8 af = *(const LAS bf16x8*)(Qt + (32 * wt + r) * 136 + 16 * ks + 8 * h2);
                o = __builtin_amdgcn_mfma_f32_32x32x16_bf16(af, sbc[ks], o, 0, 0, 0); }
#pragma unroll
            for (int i = 0; i < 16; ++i) { const int t = 32 * wt + (i & 3) + 8 * (i >> 2) + 4 * h2; Of[t * 132 + 32 * wv + r] = o[i]; } }
        P4_BAR();
        { const int t = F.tid >> 3, sg_ = F.tid & 7; const LAS f32x4* op = (const LAS f32x4*)(Of + t * 132 + 16 * sg_); f32x4 v[4]; float ss = 0.f;
#pragma unroll
            for (int j = 0; j < 4; ++j) { v[j] = op[j]; ss += (v[j][0] * v[j][0] + v[j][1] * v[j][1]) + (v[j][2] * v[j][2] + v[j][3] * v[j][3]); }
            ss += __shfl_xor(ss, 1); ss += __shfl_xor(ss, 2); ss += __shfl_xor(ss, 4);
            const float rstd = rsqrtf(ss * (1.0f / 128.0f) + EPS); const int mrow = m0 + t;
            if (t < nv && mrow >= b * SEQ) { const int cv = hh * 128 + 16 * sg_; const f32x4* gn = (const f32x4*)(F.hg_norm_g + cv);
#pragma unroll
                for (int q = 0; q < 2; ++q) { const v4u gq = q ? gate1 : gate0; const f32x4 n0 = gn[2 * q], n1 = gn[2 * q + 1]; const f32x4 a = v[2 * q], bq = v[2 * q + 1]; v4u y;
                    y.x = pk2(a[0] * rstd * n0[0] * bflo(gq.x), a[1] * rstd * n0[1] * bfhi(gq.x)); y.y = pk2(a[2] * rstd * n0[2] * bflo(gq.y), a[3] * rstd * n0[3] * bfhi(gq.y));
                    y.z = pk2(bq[0] * rstd * n1[0] * bflo(gq.z), bq[1] * rstd * n1[1] * bfhi(gq.z)); y.w = pk2(bq[2] * rstd * n1[2] * bflo(gq.w), bq[3] * rstd * n1[3] * bfhi(gq.w));
                    *(v4u*)(F.Y + (size_t)mrow * 1024 + 512 + cv + 8 * q) = y; } } }
        P4_BAR();
    }
    asm volatile("s_waitcnt vmcnt(0)" ::: "memory");
}
__device__ __forceinline__ void final_norm_phase(Frame& F) {
    const int gw = F.vcu * NWAVES + F.wave, NGW = F.G * NWAVES;
    for (int m = gw; m < MX; m += NGW) { f32x4* xr = (f32x4*)(F.out + (size_t)m * DM) + F.lane; const f32x4* gr = (const f32x4*)F.final_g + F.lane; f32x4 v[4]; float s = 0.f;
#pragma unroll
        for (int j = 0; j < 4; ++j) { v[j] = xr[64 * j]; s += (v[j][0] * v[j][0] + v[j][1] * v[j][1]) + (v[j][2] * v[j][2] + v[j][3] * v[j][3]); }
        const float rstd = rsqrtf(wave_sum(s) * (1.0f / 1024.0f) + EPS);
#pragma unroll
        for (int j = 0; j < 4; ++j) { f32x4 o = v[j] * rstd * gr[64 * j];
            if (DBG_SKIP & (1024 | 2048 | 16384)) { const unsigned fl = *(const unsigned*)(F.ws + 64); float sc = 1.f; if (fl) { const unsigned nbad = *(const unsigned*)(F.ws + 68); const int g0 = __builtin_ctz(fl); sc = 3.f + 2.f * (float)g0; } o = o * sc; }
            if (DBG_SKIP & 32) { const int c = 4 * (F.lane + 64 * j); for (int e = 0; e < 4; ++e) o[e] = bf2f(F.U[(size_t)m * 1024 + c + e]) + bf2f(F.WinT[(size_t)(m % 6144) * 1024 + c + e]) + bf2f(F.WoT[(size_t)(m & 1023) * 1024 + c + e]); }
            else if (DBG_SKIP & 16) { const int c = 4 * (F.lane + 64 * j); for (int e = 0; e < 4; ++e) o[e] = bf2f(F.HGT[(size_t)m * 512 + ((c + e) & 511)]) + bf2f(F.GH[(size_t)m * 1024 + c + e]); }
            xr[64 * j] = o; } }
}


#define XB_TMO      128
#define XB_XCNT(j)  (256  + 64 * (j))
#define XB_XSUB(j)  (1280 + 64 * (j))
#define XB_XGEN(j)  (2304 + 64 * (j))
#define XB_TOP      3328
#define XB_TOPGEN   3392
#define XCD_BAR_WORDS 3456
#define XB_SPIN_CAP (1u << 18)

__device__ __forceinline__ unsigned xb_ld(unsigned* p)              { return __hip_atomic_load(p, __ATOMIC_RELAXED, __HIP_MEMORY_SCOPE_AGENT); }
__device__ __forceinline__ unsigned xb_add(unsigned* p, unsigned v) { return __hip_atomic_fetch_add(p, v, __ATOMIC_RELAXED, __HIP_MEMORY_SCOPE_AGENT); }
__device__ __forceinline__ unsigned xb_xcc_id() { return (unsigned)__builtin_amdgcn_s_getreg((3 << 11) | 20) & 0xFu; }
#define XB_SPIN(cond, bar) do { unsigned _sp = 0; while (cond) { __builtin_amdgcn_s_sleep(1); \
    if ((++_sp & 255u) == 0u) { if (xb_ld(&(bar)[XB_TMO])) break; if (_sp > XB_SPIN_CAP) { atomicAdd(&(bar)[XB_TMO], 1u); break; } } } } while (0)

struct XcdBarrier {
    unsigned* bar; unsigned x;
    volatile LAS unsigned* st;
};

__device__ __forceinline__ XcdBarrier xcd_barrier_post(unsigned* bar, volatile LAS unsigned* st) {
    XcdBarrier b; b.bar = bar; b.x = xb_xcc_id(); b.st = st;
    if (threadIdx.x == 0) (void)xb_add(&bar[XB_XCNT(b.x)], 1u);
    return b;
}
__device__ __forceinline__ void xcd_barrier_complete(unsigned* bar, unsigned x, unsigned& nloc, unsigned& nx) {
    const unsigned G = gridDim.x * gridDim.y * gridDim.z;
    unsigned sum, cnt, mine, sp = 0u;
    for (;;) {
        sum = 0u; cnt = 0u; mine = 0u;
#pragma unroll
        for (unsigned j = 0; j < 16; ++j) { const unsigned c = xb_ld(&bar[XB_XCNT(j)]); sum += c; cnt += (c > 0u) ? 1u : 0u; mine = (j == x) ? c : mine; }
        if (sum == G) break;
        __builtin_amdgcn_s_sleep(1);
        if ((++sp & 255u) == 0u) { if (xb_ld(&bar[XB_TMO])) break; if (sp > XB_SPIN_CAP) { atomicAdd(&bar[XB_TMO], 1u); break; } }
    }
    nloc = mine > 0u ? mine : 1u; nx = cnt > 0u ? cnt : 1u;
}

__device__ __forceinline__ void xcd_barrier(const XcdBarrier& b) {
    asm volatile("s_waitcnt vmcnt(0)" ::: "memory");
    __syncthreads();
    if (threadIdx.x == 0) {
        unsigned* bar = b.bar;
        __builtin_amdgcn_s_waitcnt(0);
        unsigned nloc = b.st[0], nx = b.st[1];
        if (nloc == 0u) { xcd_barrier_complete(bar, b.x, nloc, nx); b.st[0] = nloc; b.st[1] = nx; }
        const unsigned old = xb_add(&bar[XB_XSUB(b.x)], 1u);
        const unsigned gen = old / nloc;
        if (old + 1u == (gen + 1u) * nloc) {
            __builtin_amdgcn_fence(__ATOMIC_RELEASE, "agent");
            asm volatile("s_waitcnt vmcnt(0)" ::: "memory");
            const unsigned og = xb_add(&bar[XB_TOP], 1u);
            const unsigned tg = og / nx;
            if (og + 1u == (tg + 1u) * nx) xb_add(&bar[XB_TOPGEN], 1u);
            else XB_SPIN(xb_ld(&bar[XB_TOPGEN]) == tg, bar);
            __builtin_amdgcn_fence(__ATOMIC_ACQUIRE, "agent");
            xb_add(&bar[XB_XGEN(b.x)], 1u);
            asm volatile("s_waitcnt vmcnt(0)" ::: "memory");
        } else {
            XB_SPIN(xb_ld(&bar[XB_XGEN(b.x)]) == gen, bar);
            __builtin_amdgcn_fence(__ATOMIC_ACQUIRE, "agent");
            asm volatile("s_waitcnt vmcnt(0)" ::: "memory");
        }
    }
    __syncthreads();
}


struct EpiResNorm {
    static constexpr bool PERM = true, AFTER_DRAIN = false, HAS_MID = false;
    const float* x; float* out; const float* fg; float* rowss; const XcdBarrier* bar;
    __device__ __forceinline__ void operator()(f32x4 (&acc)[2][2][4][2], const pg8::Unit& u, int wr, int wc, int fr, int fq) const {
        const int row0 = u.pm * 256 + wr * 64 + fr, col0 = u.pn * 256 + wc * 32 + 8 * fq;
#pragma unroll
        for (int ai = 0; ai < 2; ++ai)
#pragma unroll
            for (int m = 0; m < 4; ++m) { const int row = row0 + ai * 128 + m * 16; float ss = 0.f;
#pragma unroll
                for (int bj = 0; bj < 2; ++bj) { const size_t off = (size_t)row * 1024 + col0 + bj * 128; const f32x4 x0 = *(const f32x4*)(x + off), x1 = *(const f32x4*)(x + off + 4);
                    f32x4 a = acc[ai][bj][m][0] + x0, b = acc[ai][bj][m][1] + x1; acc[ai][bj][m][0] = a; acc[ai][bj][m][1] = b;
                    ss += (a[0] * a[0] + a[1] * a[1]) + (a[2] * a[2] + a[3] * a[3]) + (b[0] * b[0] + b[1] * b[1]) + (b[2] * b[2] + b[3] * b[3]); }
                ss += __shfl_xor(ss, 16); ss += __shfl_xor(ss, 32);
                if (fq == 0) __hip_atomic_fetch_add(rowss + row, ss, __ATOMIC_RELAXED, __HIP_MEMORY_SCOPE_AGENT); }
        xcd_barrier(*bar);
        f32x4 g0[2], g1[2];
#pragma unroll
        for (int bj = 0; bj < 2; ++bj) { g0[bj] = *(const f32x4*)(fg + col0 + bj * 128); g1[bj] = *(const f32x4*)(fg + col0 + bj * 128 + 4); }
#pragma unroll
        for (int ai = 0; ai < 2; ++ai)
#pragma unroll
            for (int m = 0; m < 4; ++m) { const int row = row0 + ai * 128 + m * 16; const float rstd = rsqrtf(__hip_atomic_load(rowss + row, __ATOMIC_RELAXED, __HIP_MEMORY_SCOPE_AGENT) * (1.0f / 1024.0f) + EPS);
#pragma unroll
                for (int bj = 0; bj < 2; ++bj) { const size_t off = (size_t)row * 1024 + col0 + bj * 128;
                    __builtin_nontemporal_store(acc[ai][bj][m][0] * rstd * g0[bj], (f32x4*)(out + off)); __builtin_nontemporal_store(acc[ai][bj][m][1] * rstd * g1[bj], (f32x4*)(out + off + 4)); } }
    }
};

#ifndef MK_N_LAUNCHES
#define MK_N_LAUNCHES 1
#endif
constexpr int N_PHASES = 7;
struct Args { const float* in[10]; float* out; unsigned char* ws; int ph_lo, ph_hi; };
__global__ void __launch_bounds__(NWAVES * 64, 2) mk_fwd(Args args) {
    extern __shared__ __attribute__((aligned(16))) unsigned char lds[];
    Frame F;
    F.lds = (LAS unsigned char*)lds;
    F.tid = threadIdx.x; F.lane = F.tid & 63; F.wave = __builtin_amdgcn_readfirstlane(F.tid >> 6);
    F.G = gridDim.x; { const int bx = blockIdx.x; F.vcu = (F.G % 8 == 0) ? (bx % 8) * (F.G / 8) + bx / 8 : bx; }
    unsigned char* ws = args.ws; F.ws = ws;
    F.x = args.in[0]; F.meta = args.in[1]; F.norm_g = args.in[2]; F.w_in = args.in[3]; F.w_sb_out = args.in[4]; F.w_hg_out = args.in[5]; F.w_out = args.in[6];
    F.hg_norm_g = args.in[7]; F.lbl = args.in[8]; F.final_g = args.in[9]; F.out = args.out;
    F.WinT = (bf16*)(ws + WS_WIN); F.WsbT = (bf16*)(ws + WS_WSB); F.WhgT = (bf16*)(ws + WS_WHG); F.WoT = (bf16*)(ws + WS_WO);
    F.U = (bf16*)(ws + WS_U); F.Y = (bf16*)(ws + WS_U); F.Q = (bf16*)(ws + WS_Q); F.K = (bf16*)(ws + WS_K); F.V = (bf16*)(ws + WS_V); F.SG = (bf16*)(ws + WS_SG);
    F.HQ = (bf16*)(ws + WS_HQ); F.HI = (bf16*)(ws + WS_HI); F.HGT = (bf16*)(ws + WS_HGT); F.Gf = (bf16*)(ws + WS_G); F.GH = (bf16*)(ws + WS_GH); F.DC = (float*)(ws + WS_DC);
    F.T1 = (bf16*)(ws + WS_T1); F.MG = (bf16*)(ws + WS_MG); F.ST = (bf16*)((unsigned char*)args.out + DO_ST); F.GS = (bf16*)((unsigned char*)args.out + DO_GS);
    const int lo = args.ph_lo, hi = args.ph_hi;
    volatile LAS unsigned* MISC = (volatile LAS unsigned*)(F.lds + 131072 + 320);
    if (F.tid < 32) MISC[F.tid] = 0u;
    __syncthreads();
    XcdBarrier bar; bar.bar = (unsigned*)(ws + 16384); bar.x = 0; bar.st = nullptr;
    if (MK_N_LAUNCHES == 1) bar = xcd_barrier_post((unsigned*)(ws + 16384), MISC + 8);
    if (DBG_SKIP & 256) { for (int i = F.tid; i < LDS_BYTES / 16; i += NWAVES * 64) ((LAS v4u*)F.lds)[i] = (v4u){0u, 0u, 0u, 0u}; __syncthreads(); }
#define IN(k) (lo <= (k) && (k) < hi)
#define SEAM(k) do { if (IN(k) && IN((k) + 1)) { xcd_barrier(bar); } } while (0)
    if (args.ph_hi < 0) cg::this_grid().sync();
    if (IN(0)) { p0_prologue(F); if (DBG_SKIP & (1 << 23)) { __syncthreads(); p0_prologue(F); } } SEAM(0);
    if (IN(1)) {
        pg8::Gemm g{F.U, F.WinT, MX, INC, 1024}; pg8::StaticOrder S; S.init(MX, INC, F.G, (int)blockIdx.x);
        EpiProj E{F.Q, F.K, F.V, F.SG, F.HQ, F.HI, F.HGT, F.GS, F.GH, F.Gf, F.lbl, F.ws};
        pg8::gemm_phase<EpiProj, pg8::StaticOrder, true, true>(F.lds, g, S, E);
        if (DBG_SKIP & (1 << 22)) { __syncthreads(); pg8::gemm_phase<EpiProj, pg8::StaticOrder, true, true>(F.lds, g, S, E); }
    } SEAM(1);
    if (DBG_SKIP & 128) {
        pg8::StaticOrder S; S.init(MX, INC, F.G, (int)blockIdx.x); pg8::Unit u;
        for (int i = 0; S.next(i, u); ++i) { if (u.pn < 20) continue;
            for (int e = F.tid; e < 256 * 256; e += 512) { const int rr = e >> 8, cc = e & 255; const size_t off = (size_t)(u.pm * 256 + rr) * 1024 + (u.pn - 20) * 256 + cc; F.out[off] = bf2f(F.GH[off]); } }
        return;
    }
    if (IN(2) && !(DBG_SKIP & (64 | 16384))) { hgrn_local_phase(F); attn_phase(F); if (DBG_SKIP & (1 << 20)) { __syncthreads(); hgrn_local_phase(F); } if (DBG_SKIP & (1 << 19)) { __syncthreads(); attn_phase_t<1>(F); } if (DBG_SKIP & (1 << 18)) { __syncthreads(); attn_phase_t<2>(F); } } SEAM(2);

    if (IN(3) && !(DBG_SKIP & (64 | 16384))) { hgrn_scan_phase(F, F.ST); if (DBG_SKIP & (1 << 28)) { __syncthreads(); hgrn_scan_phase(F, F.Q); } } SEAM(3);
    if (IN(4) && !(DBG_SKIP & (64 | 16384))) { hgrn_out_phase(F); if (DBG_SKIP & (1 << 21)) { __syncthreads(); hgrn_out_phase(F); } } SEAM(4);
    if (IN(5) && !(DBG_SKIP & (64 | 2048 | 16384))) {
        pg8::Gemm g{F.Y, F.WsbT, MX, 1024, 1024}; pg8::StaticOrder S; S.init(MX, 1024, F.G, (int)blockIdx.x); EpiMerge E{(const unsigned char*)F.GS, (const unsigned char*)F.GH, F.MG};
        pg8::gemm_phase<EpiMerge, pg8::StaticOrder, true, true>(F.lds, g, S, E);
    } SEAM(5);
    if (IN(6) && (DBG_SKIP & (2048 | 16384))) { for (size_t i = (size_t)blockIdx.x * 512 + F.tid; i < (size_t)MX * 256; i += (size_t)F.G * 512) ((f32x4*)F.out)[i] = ((const f32x4*)F.x)[i]; }
    const bool fuse_norm = (MK_N_LAUNCHES == 1) && (F.G == 256);
    if (IN(6) && fuse_norm) {
        pg8::Gemm g{F.MG, F.WoT, MX, 1024, 1024}; pg8::StaticOrder S; S.init(MX, 1024, F.G, (int)blockIdx.x); EpiResNorm E{F.x, F.out, F.final_g, (float*)(ws + 65536), &bar};
        pg8::gemm_phase<EpiResNorm, pg8::StaticOrder, true, true>(F.lds, g, S, E);
    }
    if (IN(6) && !fuse_norm) {
        pg8::Gemm g{F.MG, F.WoT, MX, 1024, 1024}; pg8::StaticOrder S; S.init(MX, 1024, F.G, (int)blockIdx.x); EpiRes E{F.x, F.out};
        pg8::gemm_phase<EpiRes, pg8::StaticOrder, true, true>(F.lds, g, S, E);
    }
    if (!fuse_norm) { SEAM(6); }
    if (IN(7) && !fuse_norm) { final_norm_phase(F); }

#undef IN
#undef SEAM
}

extern "C" void kernel_launch(void* const* d_in, const int* in_sizes, int n_in, void* d_out, int out_size, void* d_ws, size_t ws_size, hipStream_t stream) {
    static int grid = 0;
    if (grid == 0) {
        if (n_in != 10 || in_sizes[0] != MX * DM || out_size != MX * DM || ws_size < WS_END) { fprintf(stderr, "kernel_launch: unexpected shapes (n_in %d in0 %d out %d ws %zu)\n", n_in, n_in > 0 ? in_sizes[0] : -1, out_size, ws_size); grid = -1; return; }
        int dev = 0, cus = 0, per_cu = 0;
        if (hipGetDevice(&dev) != hipSuccess || hipDeviceGetAttribute(&cus, hipDeviceAttributeMultiprocessorCount, dev) != hipSuccess) { grid = -1; return; }
        if (hipFuncSetAttribute((const void*)mk_fwd, hipFuncAttributeMaxDynamicSharedMemorySize, LDS_BYTES) != hipSuccess) { fprintf(stderr, "kernel_launch: hipFuncSetAttribute failed\n"); grid = -1; return; }
        if (hipOccupancyMaxActiveBlocksPerMultiprocessor(&per_cu, (const void*)mk_fwd, NWAVES * 64, LDS_BYTES) != hipSuccess || per_cu < 1) { fprintf(stderr, "kernel_launch: occupancy query says %d\n", per_cu); per_cu = 1; }
        (void)hipGetLastError();
        grid = cus;
    }
    if (grid < 0) return;
    Args a{};
    for (int i = 0; i < 10; ++i) a.in[i] = (const float*)d_in[i];
    a.out = (float*)d_out; a.ws = (unsigned char*)d_ws;
#if MK_N_LAUNCHES == 1
    (void)hipMemsetAsync(d_ws, 0, 131072, stream);
    a.ph_lo = 0; a.ph_hi = N_PHASES + 1;
    void* kargs[] = {&a};
    hipError_t e = hipLaunchCooperativeKernel((const void*)mk_fwd, dim3(grid), dim3(NWAVES * 64), kargs, LDS_BYTES, stream);
    if (e != hipSuccess) fprintf(stderr, "kernel_launch: cooperative launch failed: %s (grid %d)\n", hipGetErrorString(e), grid);
#else
    for (int p = 0; p <= N_PHASES; ++p) { if ((DBG_SKIP & 32) && p >= 1 && p <= 6) continue; a.ph_lo = p; a.ph_hi = p + 1; hipLaunchKernelGGL(mk_fwd, dim3(grid), dim3(NWAVES * 64), LDS_BYTES, stream, a); }
#endif
}
```

```cpp
#include <hip/hip_runtime.h>
#include <hip/hip_cooperative_groups.h>
#include <cstdio>
#include <cstdint>
namespace cg = cooperative_groups;
#ifndef DBG_SKIP
#define DBG_SKIP 0
#endif
namespace pg8 {
#define PG8_LAS __attribute__((address_space(3)))
typedef unsigned short bf16_t;
typedef short bf16x8 __attribute__((ext_vector_type(8)));
typedef float f32x4 __attribute__((ext_vector_type(4)));
typedef unsigned u32x4 __attribute__((ext_vector_type(4)));
constexpr int BM = 256, BK = 64, HALF = 128, HTB = HALF * BK * 2  , STAGE_BYTES = 8 * HTB, NXCD = 8, WGM = 8;

__host__ __device__ __forceinline__ int lds_byte(int r, int c) { const int st = (r >> 4) * 2 + (c >> 5), rr = r & 15, cc = c & 31, ob = rr * 64 + cc * 2; return st * 1024 + (ob ^ (((ob >> 9) & 1) << 5)); }
__host__ __device__ __forceinline__ void stage_rc(int b, int& R, int& C) { const int st = b / 1024, sb = b % 1024, swz = sb ^ (((sb >> 9) & 1) << 5); R = (st >> 1) * 16 + swz / 64; C = (st & 1) * 32 + (swz % 64) / 2; }
__host__ __device__ __forceinline__ int perm32(int rho) { const int n = rho >> 4, i = rho & 15; return 8 * (i >> 2) + 4 * n + (i & 3); }

struct Unit { int pm, pn; };
struct Gemm { const bf16_t* A; const bf16_t* Bt; int M, N, K; };

struct StaticOrder {
    int nM, nN, nwg, G, c;
    __host__ __device__ void init(int M, int N, int G_, int c_) { nM = M / BM; nN = N / BM; nwg = nM * nN; G = G_; c = c_; }
    __host__ __device__ bool next(int i, Unit& u) const {
        const long L = (long)i * G + c; if (L >= nwg) return false;
        int wgid = (int)L; { const int q = nwg / NXCD, r = nwg % NXCD, xcd = wgid % NXCD, off = wgid / NXCD; wgid = (xcd < r ? xcd * (q + 1) : r * (q + 1) + (xcd - r) * q) + off; }
        const int nig = WGM * nN, gid = wgid / nig, fm = gid * WGM, gsz = (nM - fm) < WGM ? (nM - fm) : WGM;
        u.pm = fm + ((wgid % nig) % gsz); u.pn = (wgid % nig) / gsz; if (DBG_SKIP & 65536) u.pn = nN - 1 - u.pn; return true;
    }
    __device__ __forceinline__ void a_ready(const Unit&) const {}
    __device__ __forceinline__ void done(const Unit&) const {}
};

__device__ __forceinline__ unsigned cvt_pk_bf16(float lo, float hi) { unsigned r; asm volatile("v_cvt_pk_bf16_f32 %0, %1, %2" : "=v"(r) : "v"(lo), "v"(hi)); return r; }
typedef float f32x2 __attribute__((ext_vector_type(2)));
template <class Epi, class Sched, bool ALIGN_EPI = false, bool SP2 = false>
__device__ __forceinline__ void gemm_phase(PG8_LAS unsigned char* lds, const Gemm g, const Sched& S, const Epi& E) {
    const int tid = threadIdx.x, wid = __builtin_amdgcn_readfirstlane(tid >> 6), lane = tid & 63, wr = wid >> 2, wc = wid & 3, fr = lane & 15, fq = lane >> 4;
    const int K = g.K, nt = K / BK;
    unsigned voffA[2], voffB[2];
#pragma unroll
    for (int i = 0; i < 2; ++i) { int R, C; stage_rc(tid * 16 + i * 8192, R, C); const int Rb = Epi::PERM ? ((R & ~31) + perm32(R & 31)) : R;
        voffA[i] = (unsigned)(R * K + C) * 2u; voffB[i] = (unsigned)(Rb * K + C) * 2u; }
    const size_t kstep = (size_t)(BK * 2);
    const size_t hstep = (size_t)HALF * K * 2;
    const size_t tstep = 2 * hstep;
    const unsigned ldsw = (unsigned)wid * 1024u;
    const int aoff = lds_byte(wr * 64 + fr, fq * 8), boff = lds_byte(wc * 32 + fr, fq * 8);
#define PG8_SA(b, h) (((b) * 2 + (h)) * HTB)
#define PG8_SB(b, h) ((4 + (b) * 2 + (h)) * HTB)
#define PG8_STAGE(bufoff, gbase, voff) do { _Pragma("unroll") for (int _i = 0; _i < 2; ++_i) \
        __builtin_amdgcn_global_load_lds((const unsigned*)((const char*)(gbase) + (voff)[_i]), (PG8_LAS unsigned*)(lds + (bufoff) + ldsw + _i * 8192), 16, 0, 0); } while (0)
#define PG8_LDA(dst, b, h) do { _Pragma("unroll") for (int m = 0; m < 4; ++m) _Pragma("unroll") for (int k = 0; k < 2; ++k) dst[m][k] = *(const PG8_LAS bf16x8*)(lds + PG8_SA(b, h) + aoff + m * 2048 + k * 1024); } while (0)
#define PG8_LDB(dst, b, h) do { _Pragma("unroll") for (int n = 0; n < 2; ++n) _Pragma("unroll") for (int k = 0; k < 2; ++k) dst[n][k] = *(const PG8_LAS bf16x8*)(lds + PG8_SB(b, h) + boff + n * 2048 + k * 1024); } while (0)
#define PG8_MMA(ai, bj, At, Bt) do { __builtin_amdgcn_s_setprio(1); _Pragma("unroll") for (int m = 0; m < 4; ++m) _Pragma("unroll") for (int n = 0; n < 2; ++n) _Pragma("unroll") for (int k = 0; k < 2; ++k) \
        acc[ai][bj][m][n] = __builtin_amdgcn_mfma_f32_16x16x32_bf16(Bt[n][k], At[m][k], acc[ai][bj][m][n], 0, 0, 0); __builtin_amdgcn_s_setprio(0); } while (0)
#define PG8_WAIT_V(n) asm volatile("s_waitcnt vmcnt(" #n ")" ::: "memory")
#define PG8_WAIT_L(n) asm volatile("s_waitcnt lgkmcnt(" #n ")" ::: "memory")
#define PG8_BAR __builtin_amdgcn_s_barrier()
#define PG8_SCHED __builtin_amdgcn_sched_barrier(0)
    Unit cur, nxt; int ui = 0;
    if (!S.next(0, cur)) return;
    f32x4 acc[2][2][4][2];
#pragma unroll
    for (int a = 0; a < 2; ++a)
#pragma unroll
        for (int b = 0; b < 2; ++b)
#pragma unroll
            for (int m = 0; m < 4; ++m)
#pragma unroll
                for (int n = 0; n < 2; ++n) acc[a][b][m][n] = (f32x4){0.f, 0.f, 0.f, 0.f};
    bf16x8 At[4][2], B0[2][2], B1[2][2];
    const char* cA = (const char*)g.A + (size_t)cur.pm * tstep; const char* cB = (const char*)g.Bt + (size_t)cur.pn * tstep;
    S.a_ready(cur);
    if constexpr (SP2) {
        PG8_STAGE(PG8_SB(0, 0), cB, voffB); PG8_STAGE(PG8_SB(0, 1), cB + hstep, voffB); PG8_STAGE(PG8_SA(0, 0), cA, voffA); PG8_STAGE(PG8_SA(0, 1), cA + hstep, voffA);
        if (wr == 1) PG8_BAR;
        PG8_WAIT_V(2); PG8_BAR;
        PG8_STAGE(PG8_SB(1, 0), cB + kstep, voffB); PG8_STAGE(PG8_SA(1, 0), cA + kstep, voffA); PG8_STAGE(PG8_SB(1, 1), cB + hstep + kstep, voffB);
        PG8_WAIT_V(6); PG8_BAR;
    } else {
        PG8_STAGE(PG8_SB(0, 0), cB, voffB); PG8_STAGE(PG8_SA(0, 0), cA, voffA); PG8_STAGE(PG8_SB(0, 1), cB + hstep, voffB); PG8_STAGE(PG8_SA(0, 1), cA + hstep, voffA);
        if (wr == 1) PG8_BAR;
        PG8_WAIT_V(4); PG8_BAR;
        PG8_STAGE(PG8_SB(1, 0), cB + kstep, voffB); PG8_STAGE(PG8_SA(1, 0), cA + kstep, voffA); PG8_STAGE(PG8_SB(1, 1), cB + hstep + kstep, voffB);
        PG8_WAIT_V(6); PG8_BAR;
    }
    for (;;) {
        const bool has_next = S.next(ui + 1, nxt);
        const char* nA = has_next ? (const char*)g.A + (size_t)nxt.pm * tstep : cA; const char* nB = has_next ? (const char*)g.Bt + (size_t)nxt.pn * tstep : cB;
        for (int half_ = 0; half_ < (Epi::HAS_MID ? 2 : 1); ++half_) {
        if constexpr (Epi::HAS_MID) { if (half_ == 1) { E.mid(acc, cur, wr, wc, fr, fq); asm volatile("" ::: "memory"); } }
        for (int t = Epi::HAS_MID ? half_ * (nt >> 1) : 0; t < (Epi::HAS_MID ? (half_ + 1) * (nt >> 1) : nt); t += 2) {
            const bool last = (t == nt - 2);
            const char* a1 = cA + (size_t)(t + 1) * kstep;
            const char* a2 = last ? nA : cA + (size_t)(t + 2) * kstep; const char* b2 = last ? nB : cB + (size_t)(t + 2) * kstep;
            const char* a3 = a2 + kstep; const char* b3 = b2 + kstep;
            if (last && has_next) S.a_ready(nxt);
            if constexpr (SP2) {
            PG8_LDB(B0, 0, 0); PG8_LDB(B1, 0, 1); PG8_SCHED; PG8_LDA(At, 0, 0); PG8_STAGE(PG8_SA(1, 1), a1 + hstep, voffA);
            PG8_WAIT_V(8); PG8_WAIT_L(0); PG8_BAR; PG8_MMA(0, 0, At, B0); PG8_MMA(0, 1, At, B1); PG8_BAR; PG8_SCHED;
            PG8_LDA(At, 0, 1); PG8_STAGE(PG8_SB(0, 0), b2, voffB); PG8_STAGE(PG8_SB(0, 1), b2 + hstep, voffB); PG8_STAGE(PG8_SA(0, 0), a2, voffA);
            PG8_WAIT_V(8); PG8_WAIT_L(0); PG8_BAR; PG8_MMA(1, 0, At, B0); PG8_MMA(1, 1, At, B1); PG8_BAR; PG8_SCHED;
            PG8_LDB(B0, 1, 0); PG8_LDB(B1, 1, 1); PG8_SCHED; PG8_LDA(At, 1, 0); PG8_STAGE(PG8_SA(0, 1), a2 + hstep, voffA);
            PG8_WAIT_V(8); PG8_WAIT_L(0); PG8_BAR; PG8_MMA(0, 0, At, B0); PG8_MMA(0, 1, At, B1); PG8_BAR; PG8_SCHED;
            PG8_LDA(At, 1, 1); PG8_STAGE(PG8_SB(1, 0), b3, voffB); PG8_STAGE(PG8_SB(1, 1), b3 + hstep, voffB); PG8_STAGE(PG8_SA(1, 0), a3, voffA);
            PG8_WAIT_V(8); PG8_WAIT_L(0); PG8_BAR; PG8_MMA(1, 0, At, B0); PG8_MMA(1, 1, At, B1); PG8_BAR; PG8_SCHED;
            } else {
            PG8_LDB(B0, 0, 0); PG8_SCHED; PG8_LDA(At, 0, 0); PG8_STAGE(PG8_SA(1, 1), a1 + hstep, voffA);
            PG8_WAIT_L(8); PG8_BAR; PG8_WAIT_L(0); PG8_MMA(0, 0, At, B0); PG8_BAR; PG8_SCHED;
            PG8_LDB(B1, 0, 1); PG8_STAGE(PG8_SB(0, 0), b2, voffB);
            PG8_BAR; PG8_WAIT_L(0); PG8_MMA(0, 1, At, B1); PG8_BAR;
            PG8_LDA(At, 0, 1); PG8_STAGE(PG8_SA(0, 0), a2, voffA);
            PG8_BAR; PG8_WAIT_L(0); PG8_MMA(1, 0, At, B0); PG8_BAR; PG8_SCHED;
            PG8_STAGE(PG8_SB(0, 1), b2 + hstep, voffB);
            PG8_WAIT_V(6); PG8_BAR; PG8_MMA(1, 1, At, B1); PG8_BAR;
            PG8_LDB(B0, 1, 0); PG8_SCHED; PG8_LDA(At, 1, 0); PG8_STAGE(PG8_SA(0, 1), a2 + hstep, voffA);
            PG8_WAIT_L(8); PG8_BAR; PG8_WAIT_L(0); PG8_MMA(0, 0, At, B0); PG8_BAR; PG8_SCHED;
            PG8_LDB(B1, 1, 1); PG8_STAGE(PG8_SB(1, 0), b3, voffB);
            PG8_BAR; PG8_WAIT_L(0); PG8_MMA(0, 1, At, B1); PG8_BAR;
            PG8_LDA(At, 1, 1); PG8_STAGE(PG8_SA(1, 0), a3, voffA);
            PG8_BAR; PG8_WAIT_L(0); PG8_MMA(1, 0, At, B0); PG8_BAR; PG8_SCHED;
            PG8_STAGE(PG8_SB(1, 1), b3 + hstep, voffB);
            PG8_WAIT_V(6); PG8_BAR; PG8_MMA(1, 1, At, B1); PG8_BAR;
            }
        }
        }
        if constexpr (ALIGN_EPI) { if (wr == 0) PG8_BAR; }
        if constexpr (!Epi::AFTER_DRAIN) { E(acc, cur, wr, wc, fr, fq); S.done(cur); }
        if (!has_next) break;
#pragma unroll
        for (int a = 0; a < 2; ++a)
#pragma unroll
            for (int b = 0; b < 2; ++b)
#pragma unroll
                for (int m = 0; m < 4; ++m)
#pragma unroll
                    for (int n = 0; n < 2; ++n) acc[a][b][m][n] = (f32x4){0.f, 0.f, 0.f, 0.f};
        cur = nxt; cA = nA; cB = nB; ++ui;
        if constexpr (ALIGN_EPI) { if (wr == 1) PG8_BAR; }
    }
    PG8_WAIT_V(0);
    if constexpr (!ALIGN_EPI) { if (wr == 0) PG8_BAR; }
    PG8_BAR;
    if constexpr (Epi::AFTER_DRAIN) { E.fused(acc, cur, wr, wc, fr, fq, lds, wid, lane); S.done(cur); }
#undef PG8_SA
#undef PG8_SB
#undef PG8_STAGE
#undef PG8_LDA
#undef PG8_LDB
#undef PG8_MMA
#undef PG8_WAIT_V
#undef PG8_WAIT_L
#undef PG8_BAR
#undef PG8_SCHED
}
template <class Epi, class Sched>
__device__ __forceinline__ void gemm_phase2(PG8_LAS unsigned char* lds, const Gemm g, const Sched& S, const Epi& E) {
    const int tid = threadIdx.x, wid = __builtin_amdgcn_readfirstlane(tid >> 6), lane = tid & 63, wr = wid >> 2, wc = wid & 3, fr = lane & 15, fq = lane >> 4;
    const int K = g.K, nt = K / BK;
    unsigned voffA[2], voffB[2];
#pragma unroll
    for (int i = 0; i < 2; ++i) { int R, C; stage_rc(tid * 16 + i * 8192, R, C); const int Rb = Epi::PERM ? ((R & ~31) + perm32(R & 31)) : R;
        voffA[i] = (unsigned)(R * K + C) * 2u; voffB[i] = (unsigned)(Rb * K + C) * 2u; }
    const size_t kstep = (size_t)(BK * 2), hstep = (size_t)HALF * K * 2, tstep = 2 * hstep;
    const unsigned ldsw = (unsigned)wid * 1024u;
    const int aoff = lds_byte(wr * 64 + fr, fq * 8), boff = lds_byte(wc * 32 + fr, fq * 8);
#define G2_SA(b, h) (((b) * 2 + (h)) * HTB)
#define G2_SB(b, h) ((4 + (b) * 2 + (h)) * HTB)
#define G2_STAGE(bufoff, gbase, voff) do { _Pragma("unroll") for (int _i = 0; _i < 2; ++_i) \
        __builtin_amdgcn_global_load_lds((const unsigned*)((const char*)(gbase) + (voff)[_i]), (PG8_LAS unsigned*)(lds + (bufoff) + ldsw + _i * 8192), 16, 0, 0); } while (0)
#define G2_STAGE4(b, pa, pb) do { G2_STAGE(G2_SB(b, 0), (pb), voffB); G2_STAGE(G2_SB(b, 1), (pb) + hstep, voffB); G2_STAGE(G2_SA(b, 0), (pa), voffA); G2_STAGE(G2_SA(b, 1), (pa) + hstep, voffA); } while (0)
#define G2_LDA(dst, b, h) do { _Pragma("unroll") for (int m = 0; m < 4; ++m) _Pragma("unroll") for (int k = 0; k < 2; ++k) dst[m][k] = *(const PG8_LAS bf16x8*)(lds + G2_SA(b, h) + aoff + m * 2048 + k * 1024); } while (0)
#define G2_LDB(dst, b, h) do { _Pragma("unroll") for (int n = 0; n < 2; ++n) _Pragma("unroll") for (int k = 0; k < 2; ++k) dst[n][k] = *(const PG8_LAS bf16x8*)(lds + G2_SB(b, h) + boff + n * 2048 + k * 1024); } while (0)
#define G2_MMA(ai, bj, At, Bt) do { _Pragma("unroll") for (int m = 0; m < 4; ++m) _Pragma("unroll") for (int n = 0; n < 2; ++n) _Pragma("unroll") for (int k = 0; k < 2; ++k) \
        acc[ai][bj][m][n] = __builtin_amdgcn_mfma_f32_16x16x32_bf16(Bt[n][k], At[m][k], acc[ai][bj][m][n], 0, 0, 0); } while (0)
#define G2_COMPUTE(b) do { G2_LDB(B0, b, 0); G2_LDB(B1, b, 1); G2_LDA(At, b, 0); __builtin_amdgcn_s_setprio(1); G2_MMA(0, 0, At, B0); G2_MMA(0, 1, At, B1); G2_LDA(At, b, 1); G2_MMA(1, 0, At, B0); G2_MMA(1, 1, At, B1); __builtin_amdgcn_s_setprio(0); } while (0)
#define G2_SYNC() do { asm volatile("s_waitcnt vmcnt(0) lgkmcnt(0)" ::: "memory"); __builtin_amdgcn_s_barrier(); __builtin_amdgcn_s_sleep(8); __builtin_amdgcn_s_barrier(); asm volatile("" ::: "memory"); } while (0)
    Unit cur, nxt; int ui = 0;
    if (!S.next(0, cur)) return;
    f32x4 acc[2][2][4][2];
#pragma unroll
    for (int a = 0; a < 2; ++a)
#pragma unroll
        for (int b = 0; b < 2; ++b)
#pragma unroll
            for (int m = 0; m < 4; ++m)
#pragma unroll
                for (int n = 0; n < 2; ++n) acc[a][b][m][n] = (f32x4){0.f, 0.f, 0.f, 0.f};
    bf16x8 At[4][2], B0[2][2], B1[2][2];
    const char* cA = (const char*)g.A + (size_t)cur.pm * tstep; const char* cB = (const char*)g.Bt + (size_t)cur.pn * tstep;
    G2_SYNC();
    G2_STAGE4(0, cA, cB);
    G2_SYNC();
    for (;;) {
        const bool has_next = S.next(ui + 1, nxt);
        const char* nA = has_next ? (const char*)g.A + (size_t)nxt.pm * tstep : cA; const char* nB = has_next ? (const char*)g.Bt + (size_t)nxt.pn * tstep : cB;
        for (int t = 0; t < nt; t += 2) {
            const bool last = (t == nt - 2);
            { const char* a1 = cA + (size_t)(t + 1) * kstep; const char* b1 = cB + (size_t)(t + 1) * kstep; G2_STAGE4(1, a1, b1); }
            G2_COMPUTE(0);
            G2_SYNC();
            if (!last || has_next) { const char* a2 = last ? nA : cA + (size_t)(t + 2) * kstep; const char* b2 = last ? nB : cB + (size_t)(t + 2) * kstep; G2_STAGE4(0, a2, b2); }
            G2_COMPUTE(1);
            G2_SYNC();
        }
        E(acc, cur, wr, wc, fr, fq);
        if (!has_next) break;
#pragma unroll
        for (int a = 0; a < 2; ++a)
#pragma unroll
            for (int b = 0; b < 2; ++b)
#pragma unroll
                for (int m = 0; m < 4; ++m)
#pragma unroll
                    for (int n = 0; n < 2; ++n) acc[a][b][m][n] = (f32x4){0.f, 0.f, 0.f, 0.f};
        cur = nxt; cA = nA; cB = nB; ++ui;
    }
    asm volatile("s_waitcnt vmcnt(0)" ::: "memory");
#undef G2_SA
#undef G2_SB
#undef G2_STAGE
#undef G2_STAGE4
#undef G2_LDA
#undef G2_LDB
#undef G2_MMA
#undef G2_COMPUTE
#undef G2_SYNC
}
template <class Epi, class Sched>
__device__ __forceinline__ void gemm_phase3(PG8_LAS unsigned char* lds, const Gemm g, const Sched& S, const Epi& E) {
    typedef int i32x4 __attribute__((ext_vector_type(4)));
    const int tid = threadIdx.x, wid = __builtin_amdgcn_readfirstlane(tid >> 6), lane = tid & 63, wr = wid >> 2, wc = wid & 3, fr = lane & 15, fq = lane >> 4;
    const int K = g.K, nt = K / BK;
    unsigned voffA[2], voffB[2];
#pragma unroll
    for (int i = 0; i < 2; ++i) { int R, C; stage_rc(tid * 16 + i * 8192, R, C); const int Rb = Epi::PERM ? ((R & ~31) + perm32(R & 31)) : R;
        voffA[i] = (unsigned)(R * K + C) * 2u; voffB[i] = (unsigned)(Rb * K + C) * 2u; }
    const size_t kstep = (size_t)(BK * 2), hstep = (size_t)HALF * K * 2, tstep = 2 * hstep;
    const int aoff = lds_byte(wr * 64 + fr, fq * 8), boff = lds_byte(wc * 32 + fr, fq * 8);
#define G3_SA(b, h) (((b) * 2 + (h)) * HTB)
#define G3_SB(b, h) ((4 + (b) * 2 + (h)) * HTB)
#define G3_ISSUE(pa, pb) do { _Pragma("unroll") for (int h = 0; h < 2; ++h) _Pragma("unroll") for (int i = 0; i < 2; ++i) { \
        sa[h * 2 + i] = *(const i32x4*)((pa) + h * hstep + voffA[i]); sb[h * 2 + i] = *(const i32x4*)((pb) + h * hstep + voffB[i]); } } while (0)
#define G3_WRITE(b) do { _Pragma("unroll") for (int h = 0; h < 2; ++h) _Pragma("unroll") for (int i = 0; i < 2; ++i) { \
        *(PG8_LAS i32x4*)(lds + G3_SA(b, h) + tid * 16 + i * 8192) = sa[h * 2 + i]; *(PG8_LAS i32x4*)(lds + G3_SB(b, h) + tid * 16 + i * 8192) = sb[h * 2 + i]; } } while (0)
#define G3_LDA(dst, b, h) do { _Pragma("unroll") for (int m = 0; m < 4; ++m) _Pragma("unroll") for (int k = 0; k < 2; ++k) dst[m][k] = *(const PG8_LAS bf16x8*)(lds + G3_SA(b, h) + aoff + m * 2048 + k * 1024); } while (0)
#define G3_LDB(dst, b, h) do { _Pragma("unroll") for (int n = 0; n < 2; ++n) _Pragma("unroll") for (int k = 0; k < 2; ++k) dst[n][k] = *(const PG8_LAS bf16x8*)(lds + G3_SB(b, h) + boff + n * 2048 + k * 1024); } while (0)
#define G3_MMA(ai, bj, At, Bt) do { _Pragma("unroll") for (int m = 0; m < 4; ++m) _Pragma("unroll") for (int n = 0; n < 2; ++n) _Pragma("unroll") for (int k = 0; k < 2; ++k) \
        acc[ai][bj][m][n] = __builtin_amdgcn_mfma_f32_16x16x32_bf16(Bt[n][k], At[m][k], acc[ai][bj][m][n], 0, 0, 0); } while (0)
#define G3_COMPUTE(b) do { bf16x8 At[4][2], B0[2][2], B1[2][2]; G3_LDB(B0, b, 0); G3_LDB(B1, b, 1); G3_LDA(At, b, 0); G3_MMA(0, 0, At, B0); G3_MMA(0, 1, At, B1); G3_LDA(At, b, 1); G3_MMA(1, 0, At, B0); G3_MMA(1, 1, At, B1); } while (0)
    Unit cur, nxt; int ui = 0;
    if (!S.next(0, cur)) return;
    f32x4 acc[2][2][4][2];
#pragma unroll
    for (int a = 0; a < 2; ++a)
#pragma unroll
        for (int b = 0; b < 2; ++b)
#pragma unroll
            for (int m = 0; m < 4; ++m)
#pragma unroll
                for (int n = 0; n < 2; ++n) acc[a][b][m][n] = (f32x4){0.f, 0.f, 0.f, 0.f};
    i32x4 sa[4], sb[4];
    const char* cA = (const char*)g.A + (size_t)cur.pm * tstep; const char* cB = (const char*)g.Bt + (size_t)cur.pn * tstep;
    __syncthreads();
    G3_ISSUE(cA, cB); G3_WRITE(0); G3_ISSUE(cA + kstep, cB + kstep);
    __syncthreads();
    for (;;) {
        const bool has_next = S.next(ui + 1, nxt);
        const char* nA = has_next ? (const char*)g.A + (size_t)nxt.pm * tstep : cA; const char* nB = has_next ? (const char*)g.Bt + (size_t)nxt.pn * tstep : cB;
        for (int t = 0; t < nt; t += 2) {
            const bool last = (t == nt - 2);
            G3_WRITE(1);
            if (!last || has_next) { const char* a2 = last ? nA : cA + (size_t)(t + 2) * kstep; const char* b2 = last ? nB : cB + (size_t)(t + 2) * kstep; G3_ISSUE(a2, b2); }
            G3_COMPUTE(0);
            __syncthreads();
            if (!last || has_next) { G3_WRITE(0);
                const char* a3 = last ? nA + kstep : cA + (size_t)(t + 3) * kstep; const char* b3 = last ? nB + kstep : cB + (size_t)(t + 3) * kstep; G3_ISSUE(a3, b3); }
            G3_COMPUTE(1);
            __syncthreads();
        }
        E(acc, cur, wr, wc, fr, fq);
        if (!has_next) break;
#pragma unroll
        for (int a = 0; a < 2; ++a)
#pragma unroll
            for (int b = 0; b < 2; ++b)
#pragma unroll
                for (int m = 0; m < 4; ++m)
#pragma unroll
                    for (int n = 0; n < 2; ++n) acc[a][b][m][n] = (f32x4){0.f, 0.f, 0.f, 0.f};
        cur = nxt; cA = nA; cB = nB; ++ui;
    }
#undef G3_SA
#undef G3_SB
#undef G3_ISSUE
#undef G3_WRITE
#undef G3_LDA
#undef G3_LDB
#undef G3_MMA
#undef G3_COMPUTE
}
}


constexpr int NWAVES = 8;
constexpr int BATCH = 2, SEQ = 8192, DM = 1024, NMETA = 16, LPOS = SEQ + NMETA, MX = BATCH * SEQ, RP = BATCH * LPOS, INC = 6144;
constexpr int NCH = 129;
constexpr float EPS = 1e-6f;
constexpr float LOG2E = 1.4426950408889634f;
constexpr float QSCALE = 0.125f * LOG2E;
constexpr float HG_SCALE = 0.08838834764831845f;
constexpr float EXIT_BITS = 126.0f;

#define GAS __attribute__((address_space(1)))
#define LAS __attribute__((address_space(3)))
typedef unsigned short bf16;
typedef unsigned v4u __attribute__((ext_vector_type(4)));
typedef unsigned v2u __attribute__((ext_vector_type(2)));
typedef float f32x4 __attribute__((ext_vector_type(4)));
typedef float f32x2 __attribute__((ext_vector_type(2)));
typedef float f32x16 __attribute__((ext_vector_type(16)));
typedef short bf16x8 __attribute__((ext_vector_type(8)));
typedef short bf16x4 __attribute__((ext_vector_type(4)));

constexpr size_t MiB = 1u << 20;
constexpr size_t WS_WIN = 1 * MiB, WS_WSB = 13 * MiB, WS_WHG = 14 * MiB, WS_WO = 15 * MiB;
constexpr size_t WS_U = 17 * MiB;
constexpr size_t WS_Q = 49 * MiB;
constexpr size_t WS_K = 65 * MiB;
constexpr size_t WS_V = 82 * MiB;
constexpr size_t WS_SG = 99 * MiB;
constexpr size_t WS_HQ = 197 * MiB;
constexpr size_t WS_HI = 213 * MiB;
constexpr size_t WS_HGT = 148 * MiB;
constexpr size_t WS_G = 164 * MiB;
constexpr size_t WS_GH = 115 * MiB;
constexpr size_t WS_DC = 230 * MiB;
constexpr size_t WS_T1 = WS_Q;
constexpr size_t WS_MG = WS_G;
constexpr size_t WS_END = 232 * MiB;
constexpr size_t DO_ST = 0, DO_GS = 32 * MiB;

constexpr int RING_BYTES = 131072, LDS_BYTES = 147456;

__device__ __forceinline__ unsigned f2bf(float f) { unsigned u = __builtin_bit_cast(unsigned, f); return (u + 0x7fffu + ((u >> 16) & 1u)) >> 16; }
__device__ __forceinline__ unsigned pk2(float lo, float hi) { return pg8::cvt_pk_bf16(lo, hi); }
__device__ __forceinline__ float bf2f(unsigned short h) { return __builtin_bit_cast(float, (unsigned)h << 16); }
__device__ __forceinline__ float bflo(unsigned w) { return __builtin_bit_cast(float, w << 16); }
__device__ __forceinline__ float bfhi(unsigned w) { return __builtin_bit_cast(float, w & 0xffff0000u); }
__device__ __forceinline__ float fsigmoid(float v) { return __builtin_amdgcn_rcpf(1.0f + __builtin_amdgcn_exp2f(-v * LOG2E)); }
__device__ __forceinline__ float fsilu(float v) { return v * fsigmoid(v); }
__device__ __forceinline__ float wave_sum(float v) {
#pragma unroll
    for (int o = 1; o < 64; o <<= 1) v += __shfl_xor(v, o);
    return v;
}
#define LDS_WAIT() asm volatile("s_waitcnt lgkmcnt(0)" ::: "memory")

struct Frame {
    LAS unsigned char* lds;
    int tid, lane, wave, vcu, G;
    const float *x, *meta, *norm_g, *w_in, *w_sb_out, *w_hg_out, *w_out, *hg_norm_g, *lbl, *final_g;
    float* out; unsigned char* ws;
    bf16 *WinT, *WsbT, *WhgT, *WoT, *U, *Q, *K, *V, *SG, *HQ, *HI, *HGT, *GH, *GS, *T1, *MG, *ST, *Y;
    bf16* Gf; float* DC;
};

__device__ __forceinline__ void store8bf(bf16* p, f32x4 a, f32x4 b) { v4u w; w.x = pk2(a[0], a[1]); w.y = pk2(a[2], a[3]); w.z = pk2(b[0], b[1]); w.w = pk2(b[2], b[3]); *(v4u*)p = w; }
template <int ACT> __device__ __forceinline__ float actf(float v) {
    if (ACT == 0) return v;
    if (ACT == 1) return v * QSCALE;
    if (ACT == 2) return fsilu(v);
    if (ACT == 3) return fsilu(v) * HG_SCALE;
    return fsigmoid(v);
}
struct EpiProj {
    static constexpr bool PERM = true, AFTER_DRAIN = false, HAS_MID = false;
    bf16 *Q, *K, *V, *SG, *HQ, *HI, *HGT, *GS, *GH; bf16* Gf; const float* lbl; unsigned char* wsb;
    template <int ACT> __device__ __forceinline__ void emit(const f32x4 (&acc)[2][2][4][2], bf16* base, int ldc, int row0, int col0) const {
#pragma unroll
        for (int ai = 0; ai < 2; ++ai)
#pragma unroll
            for (int m = 0; m < 4; ++m) { bf16* rowp = base + (size_t)(row0 + ai * 128 + m * 16) * ldc + col0;
#pragma unroll
                for (int bj = 0; bj < 2; ++bj) { f32x4 a = acc[ai][bj][m][0], b = acc[ai][bj][m][1];
#pragma unroll
                    for (int j = 0; j < 4; ++j) { a[j] = actf<ACT>(a[j]); b[j] = actf<ACT>(b[j]); }
                    store8bf(rowp + bj * 128, a, b); } }
    }
    __device__ __forceinline__ void operator()(const f32x4 (&acc)[2][2][4][2], const pg8::Unit& u, int wr, int wc, int fr, int fq) const {
        const int pn = u.pn, bb = u.pm >> 5;
        const int rowm = u.pm * 256 + wr * 64 + fr, rowp = rowm + 16 * (1 + bb);
        const int cin = wc * 32 + 8 * fq;
        int act, ldc, row0, col0; bf16* base;
        if (pn < 16) { const int grp = pn >> 1; col0 = (pn & 1) * 256 + cin; ldc = 512;
            act = (grp == 0) ? 1 : (grp == 3 || grp == 7) ? 2 : (grp == 4) ? 3 : (grp == 5) ? 5 : 0;
            const size_t boff = (grp == 0) ? WS_Q : (grp == 1) ? WS_K : (grp == 2) ? WS_V : (grp == 3) ? WS_SG : (grp == 4) ? WS_HQ : (grp == 6) ? WS_HI : WS_HGT; base = (bf16*)(wsb + boff);
            row0 = (grp == 1 || grp == 2 || grp == 5 || grp == 6) ? rowp : rowm;
        } else { act = 4; ldc = 1024; row0 = rowm; base = (pn < 20) ? GS : GH; col0 = ((pn - 16) & 3) * 256 + cin; }
        if (act == 5) {
#pragma unroll
            for (int bj = 0; bj < 2; ++bj) { float lb[8];
#pragma unroll
                for (int j = 0; j < 8; ++j) { const int c = col0 + bj * 128 + j; lb[j] = fsigmoid(lbl[c] - lbl[512 + c]); }
#pragma unroll
                for (int ai = 0; ai < 2; ++ai)
#pragma unroll
                    for (int m = 0; m < 4; ++m) { bf16* o = Gf + (size_t)(row0 + ai * 128 + m * 16) * 512 + col0 + bj * 128; f32x4 a = acc[ai][bj][m][0], b = acc[ai][bj][m][1];
#pragma unroll
                        for (int j = 0; j < 4; ++j) { a[j] = __logf(lb[j] + (1.0f - lb[j]) * fsigmoid(a[j])); b[j] = __logf(lb[4 + j] + (1.0f - lb[4 + j]) * fsigmoid(b[j])); }
                        store8bf(o, a, b); } }
            return;
        }
        if (act == 4) {
            unsigned char* gbase = (unsigned char*)base;
#pragma unroll
            for (int ai = 0; ai < 2; ++ai)
#pragma unroll
                for (int m = 0; m < 4; ++m) { unsigned char* rowq = gbase + (size_t)(row0 + ai * 128 + m * 16) * 1024 + col0;
#pragma unroll
                    for (int bj = 0; bj < 2; ++bj) { const f32x4 a = acc[ai][bj][m][0], b = acc[ai][bj][m][1]; unsigned qa[4], qb_[4];
#pragma unroll
                        for (int j = 0; j < 4; ++j) { qa[j] = (unsigned)fminf(fmaxf(fsigmoid(a[j]) * 255.0f + 0.5f, 1.0f), 255.0f); qb_[j] = (unsigned)fminf(fmaxf(fsigmoid(b[j]) * 255.0f + 0.5f, 1.0f), 255.0f); }
                        v2u w; w.x = qa[0] | (qa[1] << 8) | (qa[2] << 16) | (qa[3] << 24); w.y = qb_[0] | (qb_[1] << 8) | (qb_[2] << 16) | (qb_[3] << 24);
                        *(v2u*)(rowq + bj * 128) = w; } }
            return;
        }
        if (act <= 1) {
            const float lin = (act == 0) ? 1.0f : QSCALE;
#pragma unroll
            for (int ai = 0; ai < 2; ++ai)
#pragma unroll
                for (int m = 0; m < 4; ++m) { bf16* rowq = base + (size_t)(row0 + ai * 128 + m * 16) * ldc + col0;
#pragma unroll
                    for (int bj = 0; bj < 2; ++bj) store8bf(rowq + bj * 128, acc[ai][bj][m][0] * lin, acc[ai][bj][m][1] * lin); }
            return;
        }
        const float vs = (act == 2) ? 1.0f : HG_SCALE;
#pragma unroll
        for (int ai = 0; ai < 2; ++ai)
#pragma unroll
            for (int m = 0; m < 4; ++m) { bf16* rowq = base + (size_t)(row0 + ai * 128 + m * 16) * ldc + col0;
#pragma unroll
                for (int bj = 0; bj < 2; ++bj) { f32x4 a = acc[ai][bj][m][0], b = acc[ai][bj][m][1];
#pragma unroll
                    for (int j = 0; j < 4; ++j) { a[j] = vs * a[j] * fsigmoid(a[j]); b[j] = vs * b[j] * fsigmoid(b[j]); }
                    store8bf(rowq + bj * 128, a, b); } }
    }
};
template <int MODE> struct EpiGate {
    static constexpr bool PERM = true, AFTER_DRAIN = false, HAS_MID = false;
    const bf16* gate; const bf16* prev; bf16* O;
    __device__ __forceinline__ void operator()(const f32x4 (&acc)[2][2][4][2], const pg8::Unit& u, int wr, int wc, int fr, int fq) const {
        const int row0 = u.pm * 256 + wr * 64 + fr, col0 = u.pn * 256 + wc * 32 + 8 * fq;
#pragma unroll
        for (int ai = 0; ai < 2; ++ai)
#pragma unroll
            for (int m = 0; m < 4; ++m)
#pragma unroll
                for (int bj = 0; bj < 2; ++bj) { const size_t off = (size_t)(row0 + ai * 128 + m * 16) * 1024 + col0 + bj * 128;
                    const v4u g = *(const v4u*)(gate + off); f32x4 a = acc[ai][bj][m][0], b = acc[ai][bj][m][1];
                    a[0] *= bflo(g.x); a[1] *= bfhi(g.x); a[2] *= bflo(g.y); a[3] *= bfhi(g.y); b[0] *= bflo(g.z); b[1] *= bfhi(g.z); b[2] *= bflo(g.w); b[3] *= bfhi(g.w);
                    if (MODE == 1) { const v4u p = *(const v4u*)(prev + off);
                        a[0] += bflo(p.x); a[1] += bfhi(p.x); a[2] += bflo(p.y); a[3] += bfhi(p.y); b[0] += bflo(p.z); b[1] += bfhi(p.z); b[2] += bflo(p.w); b[3] += bfhi(p.w); }
                    store8bf(O + off, a, b); }
    }
};
struct EpiRes {
    static constexpr bool PERM = true, AFTER_DRAIN = false, HAS_MID = false;
    const float* x; float* out;
    __device__ __forceinline__ void operator()(const f32x4 (&acc)[2][2][4][2], const pg8::Unit& u, int wr, int wc, int fr, int fq) const {
        const int row0 = u.pm * 256 + wr * 64 + fr, col0 = u.pn * 256 + wc * 32 + 8 * fq;
#pragma unroll
        for (int ai = 0; ai < 2; ++ai)
#pragma unroll
            for (int m = 0; m < 4; ++m)
#pragma unroll
                for (int bj = 0; bj < 2; ++bj) { const size_t off = (size_t)(row0 + ai * 128 + m * 16) * 1024 + col0 + bj * 128;
                    const f32x4 x0 = *(const f32x4*)(x + off), x1 = *(const f32x4*)(x + off + 4);
                    f32x4 c0 = acc[ai][bj][m][0], c1 = acc[ai][bj][m][1];
                    if (DBG_SKIP & 32768) { for (int j = 0; j < 4; ++j) { c0[j] = fminf(fmaxf(c0[j], -1.5f), 1.5f); c1[j] = fminf(fmaxf(c1[j], -1.5f), 1.5f); } }
                    *(f32x4*)(out + off) = x0 + c0; *(f32x4*)(out + off + 4) = x1 + c1; }
    }
};

struct EpiMerge {
    static constexpr bool PERM = true, AFTER_DRAIN = false, HAS_MID = true;
    const unsigned char* GS; const unsigned char* GH; bf16* O;
    __device__ __forceinline__ void mid(f32x4 (&acc)[2][2][4][2], const pg8::Unit& u, int wr, int wc, int fr, int fq) const {
        int row0 = u.pm * 256 + wr * 64 + fr, col0 = u.pn * 256 + wc * 32 + 8 * fq;
        asm volatile("" : "+v"(row0), "+v"(col0));
#pragma unroll
        for (int ai = 0; ai < 2; ++ai)
#pragma unroll
            for (int m = 0; m < 4; ++m)
#pragma unroll
                for (int bj = 0; bj < 2; ++bj) { const size_t off = (size_t)(row0 + ai * 128 + m * 16) * 1024 + col0 + bj * 128; const v2u s_ = *(const v2u*)(GS + off), h_ = *(const v2u*)(GH + off);
#pragma unroll
                    for (int n = 0; n < 2; ++n) { const unsigned sw = n ? s_.y : s_.x, hw = n ? h_.y : h_.x; f32x4 a = acc[ai][bj][m][n];
#pragma unroll
                        for (int e = 0; e < 4; ++e) a[e] *= (float)((sw >> (8 * e)) & 255u) * __builtin_amdgcn_rcpf((float)((hw >> (8 * e)) & 255u));
                        asm volatile("" : "+v"(a) :: "memory"); acc[ai][bj][m][n] = a; } }
    }
    __device__ __forceinline__ void operator()(const f32x4 (&acc)[2][2][4][2], const pg8::Unit& u, int wr, int wc, int fr, int fq) const {
        const int row0 = u.pm * 256 + wr * 64 + fr, col0 = u.pn * 256 + wc * 32 + 8 * fq;
#pragma unroll
        for (int ai = 0; ai < 2; ++ai)
#pragma unroll
            for (int m = 0; m < 4; ++m)
#pragma unroll
                for (int bj = 0; bj < 2; ++bj) { const size_t off = (size_t)(row0 + ai * 128 + m * 16) * 1024 + col0 + bj * 128; const v2u h_ = *(const v2u*)(GH + off); f32x4 a = acc[ai][bj][m][0], b = acc[ai][bj][m][1];
#pragma unroll
                    for (int e = 0; e < 4; ++e) { a[e] *= (float)((h_.x >> (8 * e)) & 255u) * (1.0f / 255.0f); b[e] *= (float)((h_.y >> (8 * e)) & 255u) * (1.0f / 255.0f); }
                    store8bf(O + off, a, b); }
    }
};

__device__ __forceinline__ void p0_transpose_item(const float* W, int K, int N, bf16* WT, int ldt, LAS float* scr, int item, int lane) {
    const int nblk = N / 32, kb = item / nblk, nb = item % nblk, k0 = 64 * kb, n0 = 32 * nb;
#pragma unroll 8
    for (int i = 0; i < 32; ++i) { const int kk = 2 * i + (lane >> 5); scr[kk * 33 + (lane & 31)] = __builtin_nontemporal_load(W + (size_t)(k0 + kk) * N + n0 + (lane & 31)); }
    LDS_WAIT();
    const int c = lane & 7;
#pragma unroll
    for (int j = 0; j < 4; ++j) { const int n = (lane >> 3) + 8 * j; const LAS float* s = scr + (8 * c) * 33 + n;
        v4u o; o.x = pk2(s[0 * 33], s[1 * 33]); o.y = pk2(s[2 * 33], s[3 * 33]); o.z = pk2(s[4 * 33], s[5 * 33]); o.w = pk2(s[6 * 33], s[7 * 33]);
        *(v4u*)(WT + (size_t)(n0 + n) * ldt + k0 + 8 * c) = o; }
    LDS_WAIT();
}
__device__ __forceinline__ void meta_item(Frame& F, int it) {
    LAS float* um = (LAS float*)F.lds;
    LAS float* red = (LAS float*)(F.lds + 65536);
#pragma unroll
    for (int rr = 0; rr < 2; ++rr) { const int row = F.wave * 2 + rr; const f32x4* xr = (const f32x4*)(F.meta + row * 1024) + F.lane; const f32x4* gr = (const f32x4*)F.norm_g + F.lane;
        f32x4 v[4]; float s = 0.f;
#pragma unroll
        for (int j = 0; j < 4; ++j) { v[j] = xr[64 * j]; s += (v[j][0] * v[j][0] + v[j][1] * v[j][1]) + (v[j][2] * v[j][2] + v[j][3] * v[j][3]); }
        const float rstd = rsqrtf(wave_sum(s) * (1.0f / 1024.0f) + EPS);
#pragma unroll
        for (int j = 0; j < 4; ++j) { const f32x4 g = gr[64 * j];
#pragma unroll
            for (int e = 0; e < 4; ++e) um[(4 * (F.lane + 64 * j) + e) * 16 + row] = v[j][e] * rstd * g[e]; } }
    __syncthreads();
    const int cl = F.tid & 63, kg = F.tid >> 6;
    const int c0 = (it < 16) ? 512 + 64 * it : 2560 + 64 * (it - 16);
    float acc[16];
#pragma unroll
    for (int r = 0; r < 16; ++r) acc[r] = 0.f;
    const float* wp = F.w_in + (size_t)(kg * 128) * INC + c0 + cl;
#pragma unroll 4
    for (int k = 0; k < 128; ++k) { const float w = wp[(size_t)k * INC]; const LAS f32x4* up = (const LAS f32x4*)(um + (kg * 128 + k) * 16);
#pragma unroll
        for (int q = 0; q < 4; ++q) { const f32x4 u = up[q];
#pragma unroll
            for (int e = 0; e < 4; ++e) acc[4 * q + e] += u[e] * w; } }
#pragma unroll
    for (int r = 0; r < 16; ++r) red[(kg * 16 + r) * 64 + cl] = acc[r];
    __syncthreads();
    for (int o = F.tid; o < 1024; o += 512) { const int r = o >> 6, c = o & 63; float s = 0.f;
#pragma unroll
        for (int k2 = 0; k2 < 8; ++k2) s += red[(k2 * 16 + r) * 64 + c];
        const int col = c0 + c;
#pragma unroll
        for (int b = 0; b < 2; ++b) { const size_t prow = (size_t)b * LPOS + r;
            if (col < 1024) F.K[prow * 512 + col - 512] = (bf16)f2bf(s);
            else if (col < 1536) F.V[prow * 512 + col - 1024] = (bf16)f2bf(s);
            else if (col < 3072) { const int cc = col - 2560; const float lb = fsigmoid(F.lbl[cc] - F.lbl[512 + cc]); F.Gf[prow * 512 + cc] = (bf16)f2bf(__logf(lb + (1.0f - lb) * fsigmoid(s))); }
            else F.HI[prow * 512 + col - 3072] = (bf16)f2bf(s); } }
    __syncthreads();
}
__device__ __forceinline__ void p0_prologue(Frame& F) {
    if (blockIdx.x < 32) meta_item(F, blockIdx.x);
    LAS float* scr = (LAS float*)(F.lds + F.wave * 16384);
    const int gw = F.vcu * NWAVES + F.wave, NGW = F.G * NWAVES;
    constexpr int I_IN = (1024 / 64) * (INC / 32), I_SB = (512 / 64) * (1024 / 32), I_O = (1024 / 64) * (1024 / 32);
    constexpr int NITEMS = I_IN + 2 * I_SB + I_O;
    for (int it = gw; it < NITEMS; it += NGW) {
        int r = it;
        if (r < I_IN) { p0_transpose_item(F.w_in, 1024, INC, F.WinT, 1024, scr, r, F.lane); continue; } r -= I_IN;
        if (r < I_SB) { p0_transpose_item(F.w_sb_out, 512, 1024, F.WsbT, 1024, scr, r, F.lane); continue; } r -= I_SB;
        if (r < I_SB) { p0_transpose_item(F.w_hg_out, 512, 1024, F.WsbT + 512, 1024, scr, r, F.lane); continue; } r -= I_SB;
        p0_transpose_item(F.w_out, 1024, 1024, F.WoT, 1024, scr, r, F.lane);
    }
    const bool xloc = (F.G == 256);
    const int xl = (int)blockIdx.x & 7, lw = ((int)blockIdx.x >> 3) * NWAVES + F.wave;
    const int mbeg = xloc ? 2048 * xl + lw : gw, mstep = xloc ? 256 : NGW, mend = xloc ? 2048 * xl + 2048 : MX;
    for (int m = mbeg; m < mend; m += 2 * mstep) {
        const int m2 = m + mstep; const bool has2 = m2 < mend;
        const f32x4* xr = (const f32x4*)(F.x + (size_t)m * DM) + F.lane; const f32x4* xr2 = (const f32x4*)(F.x + (size_t)(has2 ? m2 : m) * DM) + F.lane; const f32x4* gr = (const f32x4*)F.norm_g + F.lane;
        f32x4 v[4], w2[4]; float s = 0.f, s2 = 0.f;
#pragma unroll
        for (int j = 0; j < 4; ++j) { v[j] = __builtin_nontemporal_load(xr + 64 * j); w2[j] = __builtin_nontemporal_load(xr2 + 64 * j); }
#pragma unroll
        for (int j = 0; j < 4; ++j) { s += (v[j][0] * v[j][0] + v[j][1] * v[j][1]) + (v[j][2] * v[j][2] + v[j][3] * v[j][3]); s2 += (w2[j][0] * w2[j][0] + w2[j][1] * w2[j][1]) + (w2[j][2] * w2[j][2] + w2[j][3] * w2[j][3]); }
        const float rstd = rsqrtf(wave_sum(s) * (1.0f / 1024.0f) + EPS), rstd2 = rsqrtf(wave_sum(s2) * (1.0f / 1024.0f) + EPS);
        v2u* o8 = (v2u*)(F.U + (size_t)m * DM) + F.lane; v2u* o82 = (v2u*)(F.U + (size_t)m2 * DM) + F.lane;
#pragma unroll
        for (int j = 0; j < 4; ++j) { const f32x4 g = gr[64 * j]; v2u w; w.x = pk2(v[j][0] * rstd * g[0], v[j][1] * rstd * g[1]); w.y = pk2(v[j][2] * rstd * g[2], v[j][3] * rstd * g[3]); o8[64 * j] = w;
            if (has2) { v2u u; u.x = pk2(w2[j][0] * rstd2 * g[0], w2[j][1] * rstd2 * g[1]); u.y = pk2(w2[j][2] * rstd2 * g[2], w2[j][3] * rstd2 * g[3]); o82[64 * j] = u; } }
    }
}

#define ATT_PROCESS(qf_, o0_, o1_, R_, qpos_, masked_) do { \
    f32x16 z; _Pragma("unroll") for (int i = 0; i < 16; ++i) z[i] = 0.f; \
    _Pragma("unroll") for (int s = 0; s < 4; ++s) z = __builtin_amdgcn_mfma_f32_32x32x16_bf16(kf[s], qf_[s], z, 0, 0, 0); \
    float sp[16], lbv[16]; \
    if (masked_) { _Pragma("unroll") for (int i = 0; i < 16; ++i) { const int kpos = kb + (i & 3) + 8 * (i >> 2) + 4 * hh; const bool valid = (kpos < (qpos_)) && (kpos >= 0); \
            const float zz = fminf(z[i], 126.f); float s_; asm("v_log_f32 %0, %1" : "=v"(s_) : "v"(1.0f + __builtin_amdgcn_exp2f(zz))); sp[i] = valid ? s_ : 0.f; lbv[i] = valid ? (zz - s_) : -INFINITY; } } \
    else { _Pragma("unroll") for (int i = 0; i < 16; ++i) { const float zz = fminf(z[i], 126.f); float s_; asm("v_log_f32 %0, %1" : "=v"(s_) : "v"(1.0f + __builtin_amdgcn_exp2f(zz))); sp[i] = s_; lbv[i] = zz - s_; } } \
    float gs[4], ps[4], after[4]; \
    _Pragma("unroll") for (int g = 0; g < 4; ++g) { gs[g] = (sp[4 * g] + sp[4 * g + 1]) + (sp[4 * g + 2] + sp[4 * g + 3]); ps[g] = __shfl_xor(gs[g], 32); } \
    float tot = 0.f; \
    _Pragma("unroll") for (int g = 3; g >= 0; --g) { after[g] = tot + (hh == 0 ? ps[g] : 0.f); tot += gs[g] + ps[g]; } \
    float w[16]; \
    _Pragma("unroll") for (int g = 0; g < 4; ++g) { float run = (R_) + after[g]; \
        _Pragma("unroll") for (int ii = 3; ii >= 0; --ii) { const int i = 4 * g + ii; w[i] = __builtin_amdgcn_exp2f(lbv[i] - run); run += sp[i]; } } \
    (R_) += tot; \
    _Pragma("unroll") for (int s = 0; s < 2; ++s) { v4u t_; t_.x = pk2(w[8 * s], w[8 * s + 1]); t_.y = pk2(w[8 * s + 2], w[8 * s + 3]); t_.z = pk2(w[8 * s + 4], w[8 * s + 5]); t_.w = pk2(w[8 * s + 6], w[8 * s + 7]); \
        const bf16x8 wf_ = __builtin_bit_cast(bf16x8, t_); \
        o0_ = __builtin_amdgcn_mfma_f32_32x32x16_bf16(vfr[s][0], wf_, o0_, 0, 0, 0); o1_ = __builtin_amdgcn_mfma_f32_32x32x16_bf16(vfr[s][1], wf_, o1_, 0, 0, 0); } } while (0)
template <int DUMMY> __device__ __forceinline__ void attn_phase_t(Frame& F) {
    LAS bf16* vt = (LAS bf16*)(F.lds + F.wave * 8192);
    const int lane = F.lane, r = lane & 31, hh = lane >> 5;
    const int gw = F.vcu * NWAVES + F.wave, NGW = F.G * NWAVES;
#define ATT_LOADK(kb_, kf_) do { int kp_ = (kb_) + r; kp_ = kp_ < 0 ? 0 : kp_; const bf16* krow_ = F.K + (prow0 + kp_) * 512 + h * 64 + 8 * hh; \
            _Pragma("unroll") for (int s_ = 0; s_ < 4; ++s_) kf_[s_] = *(const bf16x8*)(krow_ + 16 * s_); } while (0)
#define ATT_LOADV(kb_, vv_) do { _Pragma("unroll") for (int i_ = 0; i_ < 4; ++i_) { const int idx_ = lane + 64 * i_, key_ = idx_ & 31, c_ = idx_ >> 5; int vp_ = (kb_) + key_; vp_ = vp_ < 0 ? 0 : vp_; \
                vv_[i_] = *(const v4u*)(F.V + (prow0 + vp_) * 512 + h * 64 + 8 * c_); } } while (0)
    for (int it = gw; it < 2048; it += NGW) {
        const int qb = it & 127, h = (it >> 7) & 7, b = it >> 10; const int mA = b * SEQ + qb * 64 + r, mB = mA + 32; const size_t prow0 = (size_t)b * LPOS;
        const int kbA0 = NMETA + qb * 64, kbB0 = kbA0 + 32, qposA = kbA0 + r, qposB = kbB0 + r;
        bf16x8 qfA[4], qfB[4], kf[4], kfn[4]; v4u vv[4];
#pragma unroll
        for (int s = 0; s < 4; ++s) { qfA[s] = *(const bf16x8*)(F.Q + (size_t)mA * 512 + h * 64 + 8 * hh + 16 * s); qfB[s] = *(const bf16x8*)(F.Q + (size_t)mB * 512 + h * 64 + 8 * hh + 16 * s); }
        ATT_LOADK(kbB0, kf); ATT_LOADV(kbB0, vv);
        f32x16 oA0, oA1, oB0, oB1;
#pragma unroll
        for (int i = 0; i < 16; ++i) { oA0[i] = 0.f; oA1[i] = 0.f; oB0[i] = 0.f; oB1[i] = 0.f; }
        float RA = 0.f, RB = 0.f; bool doneB = false;
        for (int kb = kbB0;; kb -= 32) {
            ATT_LOADK(kb - 32, kfn);
#pragma unroll
            for (int i = 0; i < 4; ++i) { const int idx = lane + 64 * i, key = idx & 31, c = idx >> 5; const unsigned ww[4] = {vv[i].x, vv[i].y, vv[i].z, vv[i].w};
#pragma unroll
                for (int j = 0; j < 4; ++j) { vt[(8 * c + 2 * j) * 36 + key] = (bf16)(ww[j] & 0xffffu); vt[(8 * c + 2 * j + 1) * 36 + key] = (bf16)(ww[j] >> 16); } }
            ATT_LOADV(kb - 32, vv);
            LDS_WAIT();
            bf16x8 vfr[2][2];
#pragma unroll
            for (int s = 0; s < 2; ++s)
#pragma unroll
                for (int db = 0; db < 2; ++db) { const LAS bf16* vp = vt + (32 * db + r) * 36 + 16 * s + 4 * hh; const bf16x4 lo = *(const LAS bf16x4*)vp, hi = *(const LAS bf16x4*)(vp + 8);
                    vfr[s][db] = (bf16x8){lo[0], lo[1], lo[2], lo[3], hi[0], hi[1], hi[2], hi[3]}; }
            LDS_WAIT();
            if (!doneB) { if (kb == kbB0 || kb < 0) ATT_PROCESS(qfB, oB0, oB1, RB, qposB, true); else ATT_PROCESS(qfB, oB0, oB1, RB, qposB, false); }
            if (kb <= kbA0) { if (kb == kbA0 || kb < 0) ATT_PROCESS(qfA, oA0, oA1, RA, qposA, true); else ATT_PROCESS(qfA, oA0, oA1, RA, qposA, false); }
            if (kb <= 0) break;
            doneB = __all(RB >= EXIT_BITS);
            if (doneB && kb <= kbA0 && __all(RA >= EXIT_BITS)) break;
#pragma unroll
            for (int s = 0; s < 4; ++s) kf[s] = kfn[s];
        }
#pragma unroll
        for (int g = 0; g < 8; ++g) { const int db = g >> 2, gg = g & 3; const int d0 = h * 64 + 32 * db + 8 * gg + 4 * hh;
            const v2u sga = *(const v2u*)(F.SG + (size_t)mA * 512 + d0), sgb = *(const v2u*)(F.SG + (size_t)mB * 512 + d0);
            const f32x16& oa = db ? oA1 : oA0; const f32x16& ob = db ? oB1 : oB0; v2u ya, yb;
            ya.x = pk2(oa[4 * gg] * bflo(sga.x), oa[4 * gg + 1] * bfhi(sga.x)); ya.y = pk2(oa[4 * gg + 2] * bflo(sga.y), oa[4 * gg + 3] * bfhi(sga.y));
            yb.x = pk2(ob[4 * gg] * bflo(sgb.x), ob[4 * gg + 1] * bfhi(sgb.x)); yb.y = pk2(ob[4 * gg + 2] * bflo(sgb.y), ob[4 * gg + 3] * bfhi(sgb.y));
            if (DUMMY) { *(v2u*)((bf16*)(F.ws + 231 * MiB) + (size_t)(mA % 12288) * 1024 + d0) = ya; } else { *(v2u*)(F.Y + (size_t)mA * 1024 + d0) = ya; *(v2u*)(F.Y + (size_t)mB * 1024 + d0) = yb; } }
    }
}
__device__ __forceinline__ void attn_phase(Frame& F) { attn_phase_t<0>(F); }
__device__ __forceinline__ void stage_iT(Frame& F, LAS bf16* iT, size_t prow, int hh, int nv) {
#pragma unroll
    for (int q = 0; q < 2; ++q) { const int idx = F.tid + 512 * q, s = idx & 63, c8 = idx >> 6;
        v4u w = {0u, 0u, 0u, 0u}; if (s < nv) w = *(const v4u*)(F.HI + (prow + s) * 512 + hh * 128 + 8 * c8);
        const unsigned ww[4] = {w.x, w.y, w.z, w.w};
#pragma unroll
        for (int j = 0; j < 4; ++j) { iT[(8 * c8 + 2 * j) * 72 + s] = (bf16)(ww[j] & 0xffffu); iT[(8 * c8 + 2 * j + 1) * 72 + s] = (bf16)(ww[j] >> 16); } }
}
#define LDS_BAR() do { asm volatile("s_waitcnt lgkmcnt(0)" ::: "memory"); __builtin_amdgcn_s_barrier(); asm volatile("" ::: "memory"); } while (0)
#define P2_DECODE(un_, stream_, c_, b_, hh_, nvl_, prow_) const int stream_ = (un_) >> 7, c_ = (un_) & 127, b_ = stream_ >> 2, hh_ = stream_ & 3, nvl_ = c_ ? 64 : NMETA; \
    const size_t prow_ = (size_t)b_ * LPOS + (c_ ? NMETA + 64 * (c_ - 1) : 0);
#define P2_LOAD(un_, iw_, gg_) do { P2_DECODE(un_, st_, cc_, b_, hh_, nv_, prow_) \
    _Pragma("unroll") for (int q2 = 0; q2 < 2; ++q2) { const int idx = F.tid + 512 * q2, s_ = idx & 63, c8 = idx >> 6; iw_[q2] = (v4u){0u, 0u, 0u, 0u}; if (s_ < nv_) iw_[q2] = *(const v4u*)(F.HI + (prow_ + s_) * 512 + hh_ * 128 + 8 * c8); } \
    { const int kp = F.tid & 63, q = F.tid >> 6; _Pragma("unroll") for (int jj = 0; jj < 8; ++jj) { const int t = 8 * q + jj; gg_[jj] = 0u; if (t < nv_) gg_[jj] = *(const unsigned*)(F.Gf + (prow_ + t) * 512 + hh_ * 128 + 2 * kp); } } } while (0)
__device__ __forceinline__ void hgrn_local_phase(Frame& F) {
    LAS bf16* KhT = (LAS bf16*)(F.lds);
    LAS bf16* iT = (LAS bf16*)(F.lds + 18432);
    LAS float* seg = (LAS float*)(F.lds + 36864);
    const int r = F.lane & 31, h2 = F.lane >> 5, wv = F.wave >> 1, wk = F.wave & 1;
    v4u iw[2]; unsigned gg[8];
    if (F.vcu < 1024) P2_LOAD(F.vcu, iw, gg);
    for (int un = F.vcu; un < 1024; un += F.G) {
        P2_DECODE(un, stream, c_, b, hh, nvl, prow)
        (void)b; (void)hh; (void)nvl; (void)prow;
#pragma unroll
        for (int q2 = 0; q2 < 2; ++q2) { const int idx = F.tid + 512 * q2, s_ = idx & 63, c8 = idx >> 6; const unsigned ww[4] = {iw[q2].x, iw[q2].y, iw[q2].z, iw[q2].w};
#pragma unroll
            for (int j = 0; j < 4; ++j) { iT[(8 * c8 + 2 * j) * 72 + s_] = (bf16)(ww[j] & 0xffffu); iT[(8 * c8 + 2 * j + 1) * 72 + s_] = (bf16)(ww[j] >> 16); } }
        { const int kp = F.tid & 63, q = F.tid >> 6; float g0[8], g1[8], c0[8], c1[8]; float run0 = 0.f, run1 = 0.f;
#pragma unroll
            for (int jj = 0; jj < 8; ++jj) { g0[jj] = bflo(gg[jj]); g1[jj] = bfhi(gg[jj]); }
            if (un + F.G < 1024) P2_LOAD(un + F.G, iw, gg);
#pragma unroll
            for (int jj = 0; jj < 8; ++jj) { run0 += g0[jj]; run1 += g1[jj]; c0[jj] = run0; c1[jj] = run1; }
            *(LAS f32x2*)(seg + q * 128 + 2 * kp) = (f32x2){run0, run1};
            LDS_BAR();
            float pre0 = 0.f, pre1 = 0.f, bl0 = 0.f, bl1 = 0.f;
#pragma unroll
            for (int qq = 0; qq < 8; ++qq) { const f32x2 sv = *(const LAS f32x2*)(seg + qq * 128 + 2 * kp); bl0 += sv[0]; bl1 += sv[1]; if (qq < q) { pre0 += sv[0]; pre1 += sv[1]; } }
            if (q == 0) *(f32x2*)(F.DC + (stream * 128 + c_) * 128 + 2 * kp) = (f32x2){__expf(bl0), __expf(bl1)};
            float k0[8], k1[8];
#pragma unroll
            for (int jj = 0; jj < 8; ++jj) { k0[jj] = (1.0f - __expf(g0[jj])) * __expf(bl0 - (pre0 + c0[jj])); k1[jj] = (1.0f - __expf(g1[jj])) * __expf(bl1 - (pre1 + c1[jj])); }
            v4u w0, w1; w0.x = pk2(k0[0], k0[1]); w0.y = pk2(k0[2], k0[3]); w0.z = pk2(k0[4], k0[5]); w0.w = pk2(k0[6], k0[7]); w1.x = pk2(k1[0], k1[1]); w1.y = pk2(k1[2], k1[3]); w1.z = pk2(k1[4], k1[5]); w1.w = pk2(k1[6], k1[7]);
            *(LAS v4u*)(KhT + (2 * kp) * 72 + 8 * q) = w0; *(LAS v4u*)(KhT + (2 * kp + 1) * 72 + 8 * q) = w1; }
        LDS_BAR();
        f32x16 a0, a1;
#pragma unroll
        for (int i = 0; i < 16; ++i) { a0[i] = 0.f; a1[i] = 0.f; }
#pragma unroll
        for (int ks = 0; ks < 4; ++ks) { const bf16x8 af = *(const LAS bf16x8*)(iT + (32 * wv + r) * 72 + 16 * ks + 8 * h2);
            const bf16x8 b0 = *(const LAS bf16x8*)(KhT + (64 * wk + r) * 72 + 16 * ks + 8 * h2), b1 = *(const LAS bf16x8*)(KhT + (64 * wk + 32 + r) * 72 + 16 * ks + 8 * h2);
            a0 = __builtin_amdgcn_mfma_f32_32x32x16_bf16(af, b0, a0, 0, 0, 0); a1 = __builtin_amdgcn_mfma_f32_32x32x16_bf16(af, b1, a1, 0, 0, 0); }
        bf16* st = F.ST + (size_t)(stream * 128 + c_) * 16384;
#pragma unroll
        for (int i = 0; i < 16; ++i) { const int v = 32 * wv + (i & 3) + 8 * (i >> 2) + 4 * h2; st[v * 128 + 64 * wk + r] = (bf16)f2bf(a0[i]); st[v * 128 + 64 * wk + 32 + r] = (bf16)f2bf(a1[i]); }
        LDS_BAR();
    }
    asm volatile("s_waitcnt vmcnt(0)" ::: "memory");
}
__device__ __forceinline__ void hgrn_scan_phase(Frame& F, bf16* OUT) {
    LAS float* ldc = (LAS float*)F.lds;
    for (int blk = F.vcu; blk < 256; blk += F.G) {
        const int stream = blk >> 5, e = (blk & 31) * 512 + F.tid, k = e & 127; bf16* st = F.ST + (size_t)stream * 128 * 16384 + e; bf16* so = OUT + (size_t)stream * 128 * 16384 + e;
        const f32x4* dsrc = (const f32x4*)(F.DC + stream * 16384);
#pragma unroll
        for (int i = 0; i < 8; ++i) ((LAS f32x4*)ldc)[F.tid + 512 * i] = dsrc[F.tid + 512 * i];
        float S = 0.f;
#pragma unroll 1
        for (int c0 = 0; c0 < 128; c0 += 32) {
            unsigned u[32];
#pragma unroll
            for (int c = 0; c < 32; ++c) u[c] = st[(size_t)(c0 + c) * 16384];
            if (c0 == 0) __syncthreads();
#pragma unroll
            for (int c = 0; c < 32; ++c) { S = ldc[(c0 + c) * 128 + k] * S + __builtin_bit_cast(float, u[c] << 16); so[(size_t)(c0 + c) * 16384] = (bf16)f2bf(S); }
        }
        __syncthreads();
    }
}
#define P4_BAR() do { asm volatile("s_waitcnt lgkmcnt(0)" ::: "memory"); __builtin_amdgcn_s_barrier(); asm volatile("" ::: "memory"); } while (0)
#define P4_DECODE(un_, stream_, c_, nv_, b_, hh_, prow_, m0_) \
    const int stream_ = (un_) >> 7, c_ = (un_) & 127; \
    const int nv_ = 64, b_ = stream_ >> 2, hh_ = stream_ & 3; const size_t prow_ = (size_t)b_ * LPOS + NMETA + 64 * c_; const int m0_ = b_ * SEQ + 64 * c_;
#define P4_LOAD(un_, iw_, g_, qh_) do { P4_DECODE(un_, st_, cc_, nv_, b_, hh_, prow_, m0_) \
    _Pragma("unroll") for (int q2 = 0; q2 < 2; ++q2) { const int idx = F.tid + 512 * q2, s_ = idx & 63, c8 = idx >> 6; iw_[q2] = (v4u){0u, 0u, 0u, 0u}; if (s_ < nv_) iw_[q2] = *(const v4u*)(F.HI + (prow_ + s_) * 512 + hh_ * 128 + 8 * c8); } \
    { const int kp = F.tid & 63, q = F.tid >> 6; _Pragma("unroll") for (int jj = 0; jj < 8; ++jj) { const int t = 8 * q + jj; \
        const unsigned gg = *(const unsigned*)(F.Gf + (prow_ + t) * 512 + hh_ * 128 + 2 * kp); g_[2 * jj] = bflo(gg); g_[2 * jj + 1] = bfhi(gg); \
        const unsigned qq = *(const unsigned*)(F.HQ + (size_t)(m0_ + t) * 512 + hh_ * 128 + 2 * kp); qh_[2 * jj] = qq & 0xffffu; qh_[2 * jj + 1] = qq >> 16; } } } while (0)
__device__ __forceinline__ void hgrn_out_phase(Frame& F) {
    LAS bf16* Qt = (LAS bf16*)(F.lds);
    LAS bf16* Kt = (LAS bf16*)(F.lds + 17408);
    LAS bf16* iT = (LAS bf16*)(F.lds + 34816);
    LAS bf16* As = (LAS bf16*)(F.lds + 53248);
    LAS float* Of = (LAS float*)(F.lds + 62464);
    LAS float* seg = (LAS float*)(F.lds + 96256);
    const int r = F.lane & 31, h2 = F.lane >> 5;
    v4u iw[2]; float g[16]; unsigned qh[16];
    if (F.vcu < 1024) P4_LOAD(F.vcu, iw, g, qh);
    for (int un = F.vcu; un < 1024; un += F.G) {
        P4_DECODE(un, stream, c, nv, b, hh, prow, m0)
#pragma unroll
        for (int q2 = 0; q2 < 2; ++q2) { const int idx = F.tid + 512 * q2, s_ = idx & 63, c8 = idx >> 6; const unsigned ww[4] = {iw[q2].x, iw[q2].y, iw[q2].z, iw[q2].w};
#pragma unroll
            for (int j = 0; j < 4; ++j) { iT[(8 * c8 + 2 * j) * 72 + s_] = (bf16)(ww[j] & 0xffffu); iT[(8 * c8 + 2 * j + 1) * 72 + s_] = (bf16)(ww[j] >> 16); } }
        float cs[16], qv[16], gk[16];
        { const int kp = F.tid & 63, q = F.tid >> 6; float run0 = 0.f, run1 = 0.f;
#pragma unroll
            for (int jj = 0; jj < 8; ++jj) { gk[2 * jj] = g[2 * jj]; gk[2 * jj + 1] = g[2 * jj + 1]; qv[2 * jj] = __builtin_bit_cast(float, qh[2 * jj] << 16); qv[2 * jj + 1] = __builtin_bit_cast(float, qh[2 * jj + 1] << 16);
                run0 += gk[2 * jj]; run1 += gk[2 * jj + 1]; cs[2 * jj] = run0; cs[2 * jj + 1] = run1; }
            *(LAS f32x2*)(seg + q * 128 + 2 * kp) = (f32x2){run0, run1}; }
        bf16x8 sbc[8]; v4u gate0 = {0u, 0u, 0u, 0u}, gate1 = {0u, 0u, 0u, 0u};
        { const int wv = F.wave & 3; const bf16* sp = F.ST + (size_t)(stream * 128 + c) * 16384 + (32 * wv + r) * 128 + 8 * h2;
#pragma unroll
          for (int ks = 0; ks < 8; ++ks) sbc[ks] = *(const bf16x8*)(sp + 16 * ks);
          const int t = F.tid >> 3, sg_ = F.tid & 7; const int mrow = m0 + t;
          if ((t < nv) && (mrow >= b * SEQ)) { const v4u* gp_ = (const v4u*)(F.HGT + (size_t)mrow * 512 + hh * 128 + 16 * sg_); gate0 = gp_[0]; gate1 = gp_[1]; } }
        if (un + F.G < 1024) P4_LOAD(un + F.G, iw, g, qh);
        P4_BAR();
        { const int kp = F.tid & 63, q = F.tid >> 6; float pre0 = 0.f, pre1 = 0.f;
#pragma unroll
            for (int qq = 0; qq < 7; ++qq) { const f32x2 sv = *(const LAS f32x2*)(seg + qq * 128 + 2 * kp); if (qq < q) { pre0 += sv[0]; pre1 += sv[1]; } }
#pragma unroll
            for (int jj = 0; jj < 8; ++jj) { const int t = 8 * q + jj; const float b0 = pre0 + cs[2 * jj], b1 = pre1 + cs[2 * jj + 1];
                *(LAS unsigned*)(Qt + t * 136 + 2 * kp) = pk2(qv[2 * jj] * __expf(b0), qv[2 * jj + 1] * __expf(b1));
                *(LAS unsigned*)(Kt + t * 136 + 2 * kp) = pk2((1.0f - __expf(gk[2 * jj])) * __expf(-b0), (1.0f - __expf(gk[2 * jj + 1])) * __expf(-b1)); } }
        P4_BAR();
        if (F.wave < 3) { const int tt = F.wave > 0, ts = F.wave == 2; f32x16 a;
#pragma unroll
            for (int i = 0; i < 16; ++i) a[i] = 0.f;
#pragma unroll
            for (int ks = 0; ks < 8; ++ks) { const bf16x8 af = *(const LAS bf16x8*)(Qt + (32 * tt + r) * 136 + 16 * ks + 8 * h2), bfr = *(const LAS bf16x8*)(Kt + (32 * ts + r) * 136 + 16 * ks + 8 * h2);
                a = __builtin_amdgcn_mfma_f32_32x32x16_bf16(af, bfr, a, 0, 0, 0); }
#pragma unroll
            for (int i = 0; i < 16; ++i) { const int t = 32 * tt + (i & 3) + 8 * (i >> 2) + 4 * h2, s_ = 32 * ts + r; As[t * 72 + s_] = (s_ <= t) ? (bf16)f2bf(a[i]) : (bf16)0; }
        } else if (F.wave == 3) {
#pragma unroll
            for (int i = 0; i < 16; ++i) { const int t = (i & 3) + 8 * (i >> 2) + 4 * h2; As[t * 72 + 32 + r] = (bf16)0; }
        }
        P4_BAR();
        { const int wt = F.wave >> 2, wv = F.wave & 3; f32x16 o;
#pragma unroll
            for (int i = 0; i < 16; ++i) o[i] = 0.f;
#pragma unroll
            for (int ks = 0; ks < 4; ++ks) { const bf16x8 af = *(const LAS bf16x8*)(As + (32 * wt + r) * 72 + 16 * ks + 8 * h2), bfr = *(const LAS bf16x8*)(iT + (32 * wv + r) * 72 + 16 * ks + 8 * h2);
                o = __builtin_amdgcn_mfma_f32_32x32x16_bf16(af, bfr, o, 0, 0, 0); }
#pragma unroll
            for (int ks = 0; ks < 8; ++ks) { const bf16x8 af = *(const LAS bf16x8*)(Qt + (32 * wt + r) * 136 + 16 * ks + 8 * h2);
                o = __builtin_amdgcn_mfma_f32_32x32x16_bf16(af, sbc[ks], o, 0, 0, 0); }
#pragma unroll
            for (int i = 0; i < 16; ++i) { const int t = 32 * wt + (i & 3) + 8 * (i >> 2) + 4 * h2; Of[t * 132 + 32 * wv + r] = o[i]; } }
        P4_BAR();
        { const int t = F.tid >> 3, sg_ = F.tid & 7; const LAS f32x4* op = (const LAS f32x4*)(Of + t * 132 + 16 * sg_); f32x4 v[4]; float ss = 0.f;
#pragma unroll
            for (int j = 0; j < 4; ++j) { v[j] = op[j]; ss += (v[j][0] * v[j][0] + v[j][1] * v[j][1]) + (v[j][2] * v[j][2] + v[j][3] * v[j][3]); }
            ss += __shfl_xor(ss, 1); ss += __shfl_xor(ss, 2); ss += __shfl_xor(ss, 4);
            const float rstd = rsqrtf(ss * (1.0f / 128.0f) + EPS); const int mrow = m0 + t;
            if (t < nv && mrow >= b * SEQ) { const int cv = hh * 128 + 16 * sg_; const f32x4* gn = (const f32x4*)(F.hg_norm_g + cv);
#pragma unroll
                for (int q = 0; q < 2; ++q) { const v4u gq = q ? gate1 : gate0; const f32x4 n0 = gn[2 * q], n1 = gn[2 * q + 1]; const f32x4 a = v[2 * q], bq = v[2 * q + 1]; v4u y;
                    y.x = pk2(a[0] * rstd * n0[0] * bflo(gq.x), a[1] * rstd * n0[1] * bfhi(gq.x)); y.y = pk2(a[2] * rstd * n0[2] * bflo(gq.y), a[3] * rstd * n0[3] * bfhi(gq.y));
                    y.z = pk2(bq[0] * rstd * n1[0] * bflo(gq.z), bq[1] * rstd * n1[1] * bfhi(gq.z)); y.w = pk2(bq[2] * rstd * n1[2] * bflo(gq.w), bq[3] * rstd * n1[3] * bfhi(gq.w));
                    *(v4u*)(F.Y + (size_t)mrow * 1024 + 512 + cv + 8 * q) = y; } } }
    }
    asm volatile("s_waitcnt vmcnt(0)" ::: "memory");
}
__device__ __forceinline__ void final_norm_phase(Frame& F) {
    const int gw = F.vcu * NWAVES + F.wave, NGW = F.G * NWAVES;
    for (int m = gw; m < MX; m += NGW) { f32x4* xr = (f32x4*)(F.out + (size_t)m * DM) + F.lane; const f32x4* gr = (const f32x4*)F.final_g + F.lane; f32x4 v[4]; float s = 0.f;
#pragma unroll
        for (int j = 0; j < 4; ++j) { v[j] = xr[64 * j]; s += (v[j][0] * v[j][0] + v[j][1] * v[j][1]) + (v[j][2] * v[j][2] + v[j][3] * v[j][3]); }
        const float rstd = rsqrtf(wave_sum(s) * (1.0f / 1024.0f) + EPS);
#pragma unroll
        for (int j = 0; j < 4; ++j) { f32x4 o = v[j] * rstd * gr[64 * j];
            if (DBG_SKIP & (1024 | 2048 | 16384)) { const unsigned fl = *(const unsigned*)(F.ws + 64); float sc = 1.f; if (fl) { const unsigned nbad = *(const unsigned*)(F.ws + 68); const int g0 = __builtin_ctz(fl); sc = 3.f + 2.f * (float)g0; } o = o * sc; }
            if (DBG_SKIP & 32) { const int c = 4 * (F.lane + 64 * j); for (int e = 0; e < 4; ++e) o[e] = bf2f(F.U[(size_t)m * 1024 + c + e]) + bf2f(F.WinT[(size_t)(m % 6144) * 1024 + c + e]) + bf2f(F.WoT[(size_t)(m & 1023) * 1024 + c + e]); }
            else if (DBG_SKIP & 16) { const int c = 4 * (F.lane + 64 * j); for (int e = 0; e < 4; ++e) o[e] = bf2f(F.HGT[(size_t)m * 512 + ((c + e) & 511)]) + bf2f(F.GH[(size_t)m * 1024 + c + e]); }
            xr[64 * j] = o; } }
}


#define XB_TMO      128
#define XB_XCNT(j)  (256  + 64 * (j))
#define XB_XSUB(j)  (1280 + 64 * (j))
#define XB_XGEN(j)  (2304 + 64 * (j))
#define XB_TOP      3328
#define XB_TOPGEN   3392
#define XCD_BAR_WORDS 3456
#define XB_SPIN_CAP (1u << 18)

__device__ __forceinline__ unsigned xb_ld(unsigned* p)              { return __hip_atomic_load(p, __ATOMIC_RELAXED, __HIP_MEMORY_SCOPE_AGENT); }
__device__ __forceinline__ unsigned xb_add(unsigned* p, unsigned v) { return __hip_atomic_fetch_add(p, v, __ATOMIC_RELAXED, __HIP_MEMORY_SCOPE_AGENT); }
__device__ __forceinline__ unsigned xb_xcc_id() { return (unsigned)__builtin_amdgcn_s_getreg((3 << 11) | 20) & 0xFu; }
#define XB_SPIN(cond, bar) do { unsigned _sp = 0; while (cond) { __builtin_amdgcn_s_sleep(1); \
    if ((++_sp & 255u) == 0u) { if (xb_ld(&(bar)[XB_TMO])) break; if (_sp > XB_SPIN_CAP) { atomicAdd(&(bar)[XB_TMO], 1u); break; } } } } while (0)

struct XcdBarrier {
    unsigned* bar; unsigned x;
    volatile LAS unsigned* st;
};

__device__ __forceinline__ XcdBarrier xcd_barrier_post(unsigned* bar, volatile LAS unsigned* st) {
    XcdBarrier b; b.bar = bar; b.x = xb_xcc_id(); b.st = st;
    if (threadIdx.x == 0) (void)xb_add(&bar[XB_XCNT(b.x)], 1u);
    return b;
}
__device__ __forceinline__ void xcd_barrier_complete(unsigned* bar, unsigned x, unsigned& nloc, unsigned& nx) {
    const unsigned G = gridDim.x * gridDim.y * gridDim.z;
    unsigned sum, cnt, mine, sp = 0u;
    for (;;) {
        sum = 0u; cnt = 0u; mine = 0u;
#pragma unroll
        for (unsigned j = 0; j < 16; ++j) { const unsigned c = xb_ld(&bar[XB_XCNT(j)]); sum += c; cnt += (c > 0u) ? 1u : 0u; mine = (j == x) ? c : mine; }
        if (sum == G) break;
        __builtin_amdgcn_s_sleep(1);
        if ((++sp & 255u) == 0u) { if (xb_ld(&bar[XB_TMO])) break; if (sp > XB_SPIN_CAP) { atomicAdd(&bar[XB_TMO], 1u); break; } }
    }
    nloc = mine > 0u ? mine : 1u; nx = cnt > 0u ? cnt : 1u;
}

__device__ __forceinline__ void xcd_barrier(const XcdBarrier& b) {
    asm volatile("s_waitcnt vmcnt(0)" ::: "memory");
    __syncthreads();
    if (threadIdx.x == 0) {
        unsigned* bar = b.bar;
        __builtin_amdgcn_s_waitcnt(0);
        unsigned nloc = b.st[0], nx = b.st[1];
        if (nloc == 0u) { xcd_barrier_complete(bar, b.x, nloc, nx); b.st[0] = nloc; b.st[1] = nx; }
        const unsigned old = xb_add(&bar[XB_XSUB(b.x)], 1u);
        const unsigned gen = old / nloc;
        if (old + 1u == (gen + 1u) * nloc) {
            __builtin_amdgcn_fence(__ATOMIC_RELEASE, "agent");
            asm volatile("s_waitcnt vmcnt(0)" ::: "memory");
            const unsigned og = xb_add(&bar[XB_TOP], 1u);
            const unsigned tg = og / nx;
            if (og + 1u == (tg + 1u) * nx) xb_add(&bar[XB_TOPGEN], 1u);
            else XB_SPIN(xb_ld(&bar[XB_TOPGEN]) == tg, bar);
            __builtin_amdgcn_fence(__ATOMIC_ACQUIRE, "agent");
            xb_add(&bar[XB_XGEN(b.x)], 1u);
            asm volatile("s_waitcnt vmcnt(0)" ::: "memory");
        } else {
            XB_SPIN(xb_ld(&bar[XB_XGEN(b.x)]) == gen, bar);
            __builtin_amdgcn_fence(__ATOMIC_ACQUIRE, "agent");
            asm volatile("s_waitcnt vmcnt(0)" ::: "memory");
        }
    }
    __syncthreads();
}


struct EpiResNorm {
    static constexpr bool PERM = true, AFTER_DRAIN = false, HAS_MID = false;
    const float* x; float* out; const float* fg; float* rowss; const XcdBarrier* bar;
    __device__ __forceinline__ void operator()(f32x4 (&acc)[2][2][4][2], const pg8::Unit& u, int wr, int wc, int fr, int fq) const {
        const int row0 = u.pm * 256 + wr * 64 + fr, col0 = u.pn * 256 + wc * 32 + 8 * fq;
#pragma unroll
        for (int ai = 0; ai < 2; ++ai)
#pragma unroll
            for (int m = 0; m < 4; ++m) { const int row = row0 + ai * 128 + m * 16; float ss = 0.f;
#pragma unroll
                for (int bj = 0; bj < 2; ++bj) { const size_t off = (size_t)row * 1024 + col0 + bj * 128; const f32x4 x0 = *(const f32x4*)(x + off), x1 = *(const f32x4*)(x + off + 4);
                    f32x4 a = acc[ai][bj][m][0] + x0, b = acc[ai][bj][m][1] + x1; acc[ai][bj][m][0] = a; acc[ai][bj][m][1] = b;
                    ss += (a[0] * a[0] + a[1] * a[1]) + (a[2] * a[2] + a[3] * a[3]) + (b[0] * b[0] + b[1] * b[1]) + (b[2] * b[2] + b[3] * b[3]); }
                ss += __shfl_xor(ss, 16); ss += __shfl_xor(ss, 32);
                if (fq == 0) __hip_atomic_fetch_add(rowss + row, ss, __ATOMIC_RELAXED, __HIP_MEMORY_SCOPE_AGENT); }
        xcd_barrier(*bar);
        f32x4 g0[2], g1[2];
#pragma unroll
        for (int bj = 0; bj < 2; ++bj) { g0[bj] = *(const f32x4*)(fg + col0 + bj * 128); g1[bj] = *(const f32x4*)(fg + col0 + bj * 128 + 4); }
#pragma unroll
        for (int ai = 0; ai < 2; ++ai)
#pragma unroll
            for (int m = 0; m < 4; ++m) { const int row = row0 + ai * 128 + m * 16; const float rstd = rsqrtf(__hip_atomic_load(rowss + row, __ATOMIC_RELAXED, __HIP_MEMORY_SCOPE_AGENT) * (1.0f / 1024.0f) + EPS);
#pragma unroll
                for (int bj = 0; bj < 2; ++bj) { const size_t off = (size_t)row * 1024 + col0 + bj * 128;
                    __builtin_nontemporal_store(acc[ai][bj][m][0] * rstd * g0[bj], (f32x4*)(out + off)); __builtin_nontemporal_store(acc[ai][bj][m][1] * rstd * g1[bj], (f32x4*)(out + off + 4)); } }
    }
};

#ifndef MK_N_LAUNCHES
#define MK_N_LAUNCHES 1
#endif
constexpr int N_PHASES = 7;
struct Args { const float* in[10]; float* out; unsigned char* ws; int ph_lo, ph_hi; };
__global__ void __launch_bounds__(NWAVES * 64, 2) mk_fwd(Args args) {
    extern __shared__ __attribute__((aligned(16))) unsigned char lds[];
    Frame F;
    F.lds = (LAS unsigned char*)lds;
    F.tid = threadIdx.x; F.lane = F.tid & 63; F.wave = __builtin_amdgcn_readfirstlane(F.tid >> 6);
    F.G = gridDim.x; { const int bx = blockIdx.x; F.vcu = (F.G % 8 == 0) ? (bx % 8) * (F.G / 8) + bx / 8 : bx; }
    unsigned char* ws = args.ws; F.ws = ws;
    F.x = args.in[0]; F.meta = args.in[1]; F.norm_g = args.in[2]; F.w_in = args.in[3]; F.w_sb_out = args.in[4]; F.w_hg_out = args.in[5]; F.w_out = args.in[6];
    F.hg_norm_g = args.in[7]; F.lbl = args.in[8]; F.final_g = args.in[9]; F.out = args.out;
    F.WinT = (bf16*)(ws + WS_WIN); F.WsbT = (bf16*)(ws + WS_WSB); F.WhgT = (bf16*)(ws + WS_WHG); F.WoT = (bf16*)(ws + WS_WO);
    F.U = (bf16*)(ws + WS_U); F.Y = (bf16*)(ws + WS_U); F.Q = (bf16*)(ws + WS_Q); F.K = (bf16*)(ws + WS_K); F.V = (bf16*)(ws + WS_V); F.SG = (bf16*)(ws + WS_SG);
    F.HQ = (bf16*)(ws + WS_HQ); F.HI = (bf16*)(ws + WS_HI); F.HGT = (bf16*)(ws + WS_HGT); F.Gf = (bf16*)(ws + WS_G); F.GH = (bf16*)(ws + WS_GH); F.DC = (float*)(ws + WS_DC);
    F.T1 = (bf16*)(ws + WS_T1); F.MG = (bf16*)(ws + WS_MG); F.ST = (bf16*)((unsigned char*)args.out + DO_ST); F.GS = (bf16*)((unsigned char*)args.out + DO_GS);
    const int lo = args.ph_lo, hi = args.ph_hi;
    volatile LAS unsigned* MISC = (volatile LAS unsigned*)(F.lds + 131072 + 320);
    if (F.tid < 32) MISC[F.tid] = 0u;
    __syncthreads();
    XcdBarrier bar; bar.bar = (unsigned*)(ws + 16384); bar.x = 0; bar.st = nullptr;
    if (MK_N_LAUNCHES == 1) bar = xcd_barrier_post((unsigned*)(ws + 16384), MISC + 8);
    if (DBG_SKIP & 256) { for (int i = F.tid; i < LDS_BYTES / 16; i += NWAVES * 64) ((LAS v4u*)F.lds)[i] = (v4u){0u, 0u, 0u, 0u}; __syncthreads(); }
#define IN(k) (lo <= (k) && (k) < hi)
#define SEAM(k) do { if (IN(k) && IN((k) + 1)) { xcd_barrier(bar); } } while (0)
    if (args.ph_hi < 0) cg::this_grid().sync();
    if (IN(0)) { p0_prologue(F); if (DBG_SKIP & (1 << 23)) { __syncthreads(); p0_prologue(F); } } SEAM(0);
    if (IN(1)) {
        pg8::Gemm g{F.U, F.WinT, MX, INC, 1024}; pg8::StaticOrder S; S.init(MX, INC, F.G, (int)blockIdx.x);
        EpiProj E{F.Q, F.K, F.V, F.SG, F.HQ, F.HI, F.HGT, F.GS, F.GH, F.Gf, F.lbl, F.ws};
        pg8::gemm_phase<EpiProj, pg8::StaticOrder, true, true>(F.lds, g, S, E);
        if (DBG_SKIP & (1 << 22)) { __syncthreads(); pg8::gemm_phase<EpiProj, pg8::StaticOrder, true, true>(F.lds, g, S, E); }
    } SEAM(1);
    if (DBG_SKIP & 128) {
        pg8::StaticOrder S; S.init(MX, INC, F.G, (int)blockIdx.x); pg8::Unit u;
        for (int i = 0; S.next(i, u); ++i) { if (u.pn < 20) continue;
            for (int e = F.tid; e < 256 * 256; e += 512) { const int rr = e >> 8, cc = e & 255; const size_t off = (size_t)(u.pm * 256 + rr) * 1024 + (u.pn - 20) * 256 + cc; F.out[off] = bf2f(F.GH[off]); } }
        return;
    }
    if (IN(2) && !(DBG_SKIP & (64 | 16384))) { hgrn_local_phase(F); attn_phase(F); if (DBG_SKIP & (1 << 20)) { __syncthreads(); hgrn_local_phase(F); } if (DBG_SKIP & (1 << 19)) { __syncthreads(); attn_phase_t<1>(F); } if (DBG_SKIP & (1 << 18)) { __syncthreads(); attn_phase_t<2>(F); } } SEAM(2);

    if (IN(3) && !(DBG_SKIP & (64 | 16384))) { hgrn_scan_phase(F, F.ST); if (DBG_SKIP & (1 << 28)) { __syncthreads(); hgrn_scan_phase(F, F.Q); } } SEAM(3);
    if (IN(4) && !(DBG_SKIP & (64 | 16384))) { hgrn_out_phase(F); if (DBG_SKIP & (1 << 21)) { __syncthreads(); hgrn_out_phase(F); } } SEAM(4);
    if (IN(5) && !(DBG_SKIP & (64 | 2048 | 16384))) {
        pg8::Gemm g{F.Y, F.WsbT, MX, 1024, 1024}; pg8::StaticOrder S; S.init(MX, 1024, F.G, (int)blockIdx.x); EpiMerge E{(const unsigned char*)F.GS, (const unsigned char*)F.GH, F.MG};
        pg8::gemm_phase<EpiMerge, pg8::StaticOrder, true, true>(F.lds, g, S, E);
    } SEAM(5);
    if (IN(6) && (DBG_SKIP & (2048 | 16384))) { for (size_t i = (size_t)blockIdx.x * 512 + F.tid; i < (size_t)MX * 256; i += (size_t)F.G * 512) ((f32x4*)F.out)[i] = ((const f32x4*)F.x)[i]; }
    const bool fuse_norm = (MK_N_LAUNCHES == 1) && (F.G == 256);
    if (IN(6) && fuse_norm) {
        pg8::Gemm g{F.MG, F.WoT, MX, 1024, 1024}; pg8::StaticOrder S; S.init(MX, 1024, F.G, (int)blockIdx.x); EpiResNorm E{F.x, F.out, F.final_g, (float*)(ws + 65536), &bar};
        pg8::gemm_phase<EpiResNorm, pg8::StaticOrder, true, true>(F.lds, g, S, E);
    }
    if (IN(6) && !fuse_norm) {
        pg8::Gemm g{F.MG, F.WoT, MX, 1024, 1024}; pg8::StaticOrder S; S.init(MX, 1024, F.G, (int)blockIdx.x); EpiRes E{F.x, F.out};
        pg8::gemm_phase<EpiRes, pg8::StaticOrder, true, true>(F.lds, g, S, E);
    }
    if (!fuse_norm) { SEAM(6); }
    if (IN(7) && !fuse_norm) { final_norm_phase(F); }

#undef IN
#undef SEAM
}

extern "C" void kernel_launch(void* const* d_in, const int* in_sizes, int n_in, void* d_out, int out_size, void* d_ws, size_t ws_size, hipStream_t stream) {
    static int grid = 0;
    if (grid == 0) {
        if (n_in != 10 || in_sizes[0] != MX * DM || out_size != MX * DM || ws_size < WS_END) { fprintf(stderr, "kernel_launch: unexpected shapes (n_in %d in0 %d out %d ws %zu)\n", n_in, n_in > 0 ? in_sizes[0] : -1, out_size, ws_size); grid = -1; return; }
        int dev = 0, cus = 0, per_cu = 0;
        if (hipGetDevice(&dev) != hipSuccess || hipDeviceGetAttribute(&cus, hipDeviceAttributeMultiprocessorCount, dev) != hipSuccess) { grid = -1; return; }
        if (hipFuncSetAttribute((const void*)mk_fwd, hipFuncAttributeMaxDynamicSharedMemorySize, LDS_BYTES) != hipSuccess) { fprintf(stderr, "kernel_launch: hipFuncSetAttribute failed\n"); grid = -1; return; }
        if (hipOccupancyMaxActiveBlocksPerMultiprocessor(&per_cu, (const void*)mk_fwd, NWAVES * 64, LDS_BYTES) != hipSuccess || per_cu < 1) { fprintf(stderr, "kernel_launch: occupancy query says %d\n", per_cu); per_cu = 1; }
        (void)hipGetLastError();
        grid = cus;
    }
    if (grid < 0) return;
    Args a{};
    for (int i = 0; i < 10; ++i) a.in[i] = (const float*)d_in[i];
    a.out = (float*)d_out; a.ws = (unsigned char*)d_ws;
#if MK_N_LAUNCHES == 1
    (void)hipMemsetAsync(d_ws, 0, 131072, stream);
    a.ph_lo = 0; a.ph_hi = N_PHASES + 1;
    void* kargs[] = {&a};
    hipError_t e = hipLaunchCooperativeKernel((const void*)mk_fwd, dim3(grid), dim3(NWAVES * 64), kargs, LDS_BYTES, stream);
    if (e != hipSuccess) fprintf(stderr, "kernel_launch: cooperative launch failed: %s (grid %d)\n", hipGetErrorString(e), grid);
#else
    for (int p = 0; p <= N_PHASES; ++p) { if ((DBG_SKIP & 32) && p >= 1 && p <= 6) continue; a.ph_lo = p; a.ph_hi = p + 1; hipLaunchKernelGGL(mk_fwd, dim3(grid), dim3(NWAVES * 64), LDS_BYTES, stream, a); }
#endif
}
```

```cpp
#include <hip/hip_runtime.h>
#include <hip/hip_cooperative_groups.h>
#include <cstdio>
#include <cstdint>
namespace cg = cooperative_groups;
#ifndef DBG_SKIP
#define DBG_SKIP 0
#endif
namespace pg8 {
#define PG8_LAS __attribute__((address_space(3)))
typedef unsigned short bf16_t;
typedef short bf16x8 __attribute__((ext_vector_type(8)));
typedef float f32x4 __attribute__((ext_vector_type(4)));
typedef unsigned u32x4 __attribute__((ext_vector_type(4)));
constexpr int BM = 256, BK = 64, HALF = 128, HTB = HALF * BK * 2  , STAGE_BYTES = 8 * HTB, NXCD = 8, WGM = 8;

__host__ __device__ __forceinline__ int lds_byte(int r, int c) { const int st = (r >> 4) * 2 + (c >> 5), rr = r & 15, cc = c & 31, ob = rr * 64 + cc * 2; return st * 1024 + (ob ^ (((ob >> 9) & 1) << 5)); }
__host__ __device__ __forceinline__ void stage_rc(int b, int& R, int& C) { const int st = b / 1024, sb = b % 1024, swz = sb ^ (((sb >> 9) & 1) << 5); R = (st >> 1) * 16 + swz / 64; C = (st & 1) * 32 + (swz % 64) / 2; }
__host__ __device__ __forceinline__ int perm32(int rho) { const int n = rho >> 4, i = rho & 15; return 8 * (i >> 2) + 4 * n + (i & 3); }

struct Unit { int pm, pn; };
struct Gemm { const bf16_t* A; const bf16_t* Bt; int M, N, K; };

struct StaticOrder {
    int nM, nN, nwg, G, c;
    __host__ __device__ void init(int M, int N, int G_, int c_) { nM = M / BM; nN = N / BM; nwg = nM * nN; G = G_; c = c_; }
    __host__ __device__ bool next(int i, Unit& u) const {
        const long L = (long)i * G + c; if (L >= nwg) return false;
        int wgid = (int)L; { const int q = nwg / NXCD, r = nwg % NXCD, xcd = wgid % NXCD, off = wgid / NXCD; wgid = (xcd < r ? xcd * (q + 1) : r * (q + 1) + (xcd - r) * q) + off; }
        const int nig = WGM * nN, gid = wgid / nig, fm = gid * WGM, gsz = (nM - fm) < WGM ? (nM - fm) : WGM;
        u.pm = fm + ((wgid % nig) % gsz); u.pn = (wgid % nig) / gsz; if (DBG_SKIP & 65536) u.pn = nN - 1 - u.pn; return true;
    }
    __device__ __forceinline__ void a_ready(const Unit&) const {}
    __device__ __forceinline__ void done(const Unit&) const {}
};

__device__ __forceinline__ unsigned cvt_pk_bf16(float lo, float hi) { unsigned r; asm volatile("v_cvt_pk_bf16_f32 %0, %1, %2" : "=v"(r) : "v"(lo), "v"(hi)); return r; }
typedef float f32x2 __attribute__((ext_vector_type(2)));
template <class Epi, class Sched, bool ALIGN_EPI = false, bool SP2 = false>
__device__ __forceinline__ void gemm_phase(PG8_LAS unsigned char* lds, const Gemm g, const Sched& S, const Epi& E) {
    const int tid = threadIdx.x, wid = __builtin_amdgcn_readfirstlane(tid >> 6), lane = tid & 63, wr = wid >> 2, wc = wid & 3, fr = lane & 15, fq = lane >> 4;
    const int K = g.K, nt = K / BK;
    unsigned voffA[2], voffB[2];
#pragma unroll
    for (int i = 0; i < 2; ++i) { int R, C; stage_rc(tid * 16 + i * 8192, R, C); const int Rb = Epi::PERM ? ((R & ~31) + perm32(R & 31)) : R;
        voffA[i] = (unsigned)(R * K + C) * 2u; voffB[i] = (unsigned)(Rb * K + C) * 2u; }
    const size_t kstep = (size_t)(BK * 2);
    const size_t hstep = (size_t)HALF * K * 2;
    const size_t tstep = 2 * hstep;
    const unsigned ldsw = (unsigned)wid * 1024u;
    const int aoff = lds_byte(wr * 64 + fr, fq * 8), boff = lds_byte(wc * 32 + fr, fq * 8);
#define PG8_SA(b, h) (((b) * 2 + (h)) * HTB)
#define PG8_SB(b, h) ((4 + (b) * 2 + (h)) * HTB)
#define PG8_STAGE(bufoff, gbase, voff) do { _Pragma("unroll") for (int _i = 0; _i < 2; ++_i) \
        __builtin_amdgcn_global_load_lds((const unsigned*)((const char*)(gbase) + (voff)[_i]), (PG8_LAS unsigned*)(lds + (bufoff) + ldsw + _i * 8192), 16, 0, 0); } while (0)
#define PG8_LDA(dst, b, h) do { _Pragma("unroll") for (int m = 0; m < 4; ++m) _Pragma("unroll") for (int k = 0; k < 2; ++k) dst[m][k] = *(const PG8_LAS bf16x8*)(lds + PG8_SA(b, h) + aoff + m * 2048 + k * 1024); } while (0)
#define PG8_LDB(dst, b, h) do { _Pragma("unroll") for (int n = 0; n < 2; ++n) _Pragma("unroll") for (int k = 0; k < 2; ++k) dst[n][k] = *(const PG8_LAS bf16x8*)(lds + PG8_SB(b, h) + boff + n * 2048 + k * 1024); } while (0)
#define PG8_MMA(ai, bj, At, Bt) do { __builtin_amdgcn_s_setprio(1); _Pragma("unroll") for (int m = 0; m < 4; ++m) _Pragma("unroll") for (int n = 0; n < 2; ++n) _Pragma("unroll") for (int k = 0; k < 2; ++k) \
        acc[ai][bj][m][n] = __builtin_amdgcn_mfma_f32_16x16x32_bf16(Bt[n][k], At[m][k], acc[ai][bj][m][n], 0, 0, 0); __builtin_amdgcn_s_setprio(0); } while (0)
#define PG8_WAIT_V(n) asm volatile("s_waitcnt vmcnt(" #n ")" ::: "memory")
#define PG8_WAIT_L(n) asm volatile("s_waitcnt lgkmcnt(" #n ")" ::: "memory")
#define PG8_BAR __builtin_amdgcn_s_barrier()
#define PG8_SCHED __builtin_amdgcn_sched_barrier(0)
    Unit cur, nxt; int ui = 0;
    if (!S.next(0, cur)) return;
    f32x4 acc[2][2][4][2];
#pragma unroll
    for (int a = 0; a < 2; ++a)
#pragma unroll
        for (int b = 0; b < 2; ++b)
#pragma unroll
            for (int m = 0; m < 4; ++m)
#pragma unroll
                for (int n = 0; n < 2; ++n) acc[a][b][m][n] = (f32x4){0.f, 0.f, 0.f, 0.f};
    bf16x8 At[4][2], B0[2][2], B1[2][2];
    const char* cA = (const char*)g.A + (size_t)cur.pm * tstep; const char* cB = (const char*)g.Bt + (size_t)cur.pn * tstep;
    S.a_ready(cur);
    if constexpr (SP2) {
        PG8_STAGE(PG8_SB(0, 0), cB, voffB); PG8_STAGE(PG8_SB(0, 1), cB + hstep, voffB); PG8_STAGE(PG8_SA(0, 0), cA, voffA); PG8_STAGE(PG8_SA(0, 1), cA + hstep, voffA);
        if (wr == 1) PG8_BAR;
        PG8_WAIT_V(2); PG8_BAR;
        PG8_STAGE(PG8_SB(1, 0), cB + kstep, voffB); PG8_STAGE(PG8_SA(1, 0), cA + kstep, voffA); PG8_STAGE(PG8_SB(1, 1), cB + hstep + kstep, voffB);
        PG8_WAIT_V(6); PG8_BAR;
    } else {
        PG8_STAGE(PG8_SB(0, 0), cB, voffB); PG8_STAGE(PG8_SA(0, 0), cA, voffA); PG8_STAGE(PG8_SB(0, 1), cB + hstep, voffB); PG8_STAGE(PG8_SA(0, 1), cA + hstep, voffA);
        if (wr == 1) PG8_BAR;
        PG8_WAIT_V(4); PG8_BAR;
        PG8_STAGE(PG8_SB(1, 0), cB + kstep, voffB); PG8_STAGE(PG8_SA(1, 0), cA + kstep, voffA); PG8_STAGE(PG8_SB(1, 1), cB + hstep + kstep, voffB);
        PG8_WAIT_V(6); PG8_BAR;
    }
    for (;;) {
        const bool has_next = S.next(ui + 1, nxt);
        const char* nA = has_next ? (const char*)g.A + (size_t)nxt.pm * tstep : cA; const char* nB = has_next ? (const char*)g.Bt + (size_t)nxt.pn * tstep : cB;
        for (int half_ = 0; half_ < (Epi::HAS_MID ? 2 : 1); ++half_) {
        if constexpr (Epi::HAS_MID) { if (half_ == 1) { E.mid(acc, cur, wr, wc, fr, fq); asm volatile("" ::: "memory"); } }
        for (int t = Epi::HAS_MID ? half_ * (nt >> 1) : 0; t < (Epi::HAS_MID ? (half_ + 1) * (nt >> 1) : nt); t += 2) {
            const bool last = (t == nt - 2);
            const char* a1 = cA + (size_t)(t + 1) * kstep;
            const char* a2 = last ? nA : cA + (size_t)(t + 2) * kstep; const char* b2 = last ? nB : cB + (size_t)(t + 2) * kstep;
            const char* a3 = a2 + kstep; const char* b3 = b2 + kstep;
            if (last && has_next) S.a_ready(nxt);
            if constexpr (SP2) {
            PG8_LDB(B0, 0, 0); PG8_LDB(B1, 0, 1); PG8_SCHED; PG8_LDA(At, 0, 0); PG8_STAGE(PG8_SA(1, 1), a1 + hstep, voffA);
            PG8_WAIT_V(8); PG8_WAIT_L(0); PG8_BAR; PG8_MMA(0, 0, At, B0); PG8_MMA(0, 1, At, B1); PG8_BAR; PG8_SCHED;
            PG8_LDA(At, 0, 1); PG8_STAGE(PG8_SB(0, 0), b2, voffB); PG8_STAGE(PG8_SB(0, 1), b2 + hstep, voffB); PG8_STAGE(PG8_SA(0, 0), a2, voffA);
            PG8_WAIT_V(8); PG8_WAIT_L(0); PG8_BAR; PG8_MMA(1, 0, At, B0); PG8_MMA(1, 1, At, B1); PG8_BAR; PG8_SCHED;
            PG8_LDB(B0, 1, 0); PG8_LDB(B1, 1, 1); PG8_SCHED; PG8_LDA(At, 1, 0); PG8_STAGE(PG8_SA(0, 1), a2 + hstep, voffA);
            PG8_WAIT_V(8); PG8_WAIT_L(0); PG8_BAR; PG8_MMA(0, 0, At, B0); PG8_MMA(0, 1, At, B1); PG8_BAR; PG8_SCHED;
            PG8_LDA(At, 1, 1); PG8_STAGE(PG8_SB(1, 0), b3, voffB); PG8_STAGE(PG8_SB(1, 1), b3 + hstep, voffB); PG8_STAGE(PG8_SA(1, 0), a3, voffA);
            PG8_WAIT_V(8); PG8_WAIT_L(0); PG8_BAR; PG8_MMA(1, 0, At, B0); PG8_MMA(1, 1, At, B1); PG8_BAR; PG8_SCHED;
            } else {
            PG8_LDB(B0, 0, 0); PG8_SCHED; PG8_LDA(At, 0, 0); PG8_STAGE(PG8_SA(1, 1), a1 + hstep, voffA);
            PG8_WAIT_L(8); PG8_BAR; PG8_WAIT_L(0); PG8_MMA(0, 0, At, B0); PG8_BAR; PG8_SCHED;
            PG8_LDB(B1, 0, 1); PG8_STAGE(PG8_SB(0, 0), b2, voffB);
            PG8_BAR; PG8_WAIT_L(0); PG8_MMA(0, 1, At, B1); PG8_BAR;
            PG8_LDA(At, 0, 1); PG8_STAGE(PG8_SA(0, 0), a2, voffA);
            PG8_BAR; PG8_WAIT_L(0); PG8_MMA(1, 0, At, B0); PG8_BAR; PG8_SCHED;
            PG8_STAGE(PG8_SB(0, 1), b2 + hstep, voffB);
            PG8_WAIT_V(6); PG8_BAR; PG8_MMA(1, 1, At, B1); PG8_BAR;
            PG8_LDB(B0, 1, 0); PG8_SCHED; PG8_LDA(At, 1, 0); PG8_STAGE(PG8_SA(0, 1), a2 + hstep, voffA);
            PG8_WAIT_L(8); PG8_BAR; PG8_WAIT_L(0); PG8_MMA(0, 0, At, B0); PG8_BAR; PG8_SCHED;
            PG8_LDB(B1, 1, 1); PG8_STAGE(PG8_SB(1, 0), b3, voffB);
            PG8_BAR; PG8_WAIT_L(0); PG8_MMA(0, 1, At, B1); PG8_BAR;
            PG8_LDA(At, 1, 1); PG8_STAGE(PG8_SA(1, 0), a3, voffA);
            PG8_BAR; PG8_WAIT_L(0); PG8_MMA(1, 0, At, B0); PG8_BAR; PG8_SCHED;
            PG8_STAGE(PG8_SB(1, 1), b3 + hstep, voffB);
            PG8_WAIT_V(6); PG8_BAR; PG8_MMA(1, 1, At, B1); PG8_BAR;
            }
        }
        }
        if constexpr (ALIGN_EPI) { if (wr == 0) PG8_BAR; }
        if constexpr (!Epi::AFTER_DRAIN) { E(acc, cur, wr, wc, fr, fq); S.done(cur); }
        if (!has_next) break;
#pragma unroll
        for (int a = 0; a < 2; ++a)
#pragma unroll
            for (int b = 0; b < 2; ++b)
#pragma unroll
                for (int m = 0; m < 4; ++m)
#pragma unroll
                    for (int n = 0; n < 2; ++n) acc[a][b][m][n] = (f32x4){0.f, 0.f, 0.f, 0.f};
        cur = nxt; cA = nA; cB = nB; ++ui;
        if constexpr (ALIGN_EPI) { if (wr == 1) PG8_BAR; }
    }
    PG8_WAIT_V(0);
    if constexpr (!ALIGN_EPI) { if (wr == 0) PG8_BAR; }
    PG8_BAR;
    if constexpr (Epi::AFTER_DRAIN) { E.fused(acc, cur, wr, wc, fr, fq, lds, wid, lane); S.done(cur); }
#undef PG8_SA
#undef PG8_SB
#undef PG8_STAGE
#undef PG8_LDA
#undef PG8_LDB
#undef PG8_MMA
#undef PG8_WAIT_V
#undef PG8_WAIT_L
#undef PG8_BAR
#undef PG8_SCHED
}
template <class Epi, class Sched>
__device__ __forceinline__ void gemm_phase2(PG8_LAS unsigned char* lds, const Gemm g, const Sched& S, const Epi& E) {
    const int tid = threadIdx.x, wid = __builtin_amdgcn_readfirstlane(tid >> 6), lane = tid & 63, wr = wid >> 2, wc = wid & 3, fr = lane & 15, fq = lane >> 4;
    const int K = g.K, nt = K / BK;
    unsigned voffA[2], voffB[2];
#pragma unroll
    for (int i = 0; i < 2; ++i) { int R, C; stage_rc(tid * 16 + i * 8192, R, C); const int Rb = Epi::PERM ? ((R & ~31) + perm32(R & 31)) : R;
        voffA[i] = (unsigned)(R * K + C) * 2u; voffB[i] = (unsigned)(Rb * K + C) * 2u; }
    const size_t kstep = (size_t)(BK * 2), hstep = (size_t)HALF * K * 2, tstep = 2 * hstep;
    const unsigned ldsw = (unsigned)wid * 1024u;
    const int aoff = lds_byte(wr * 64 + fr, fq * 8), boff = lds_byte(wc * 32 + fr, fq * 8);
#define G2_SA(b, h) (((b) * 2 + (h)) * HTB)
#define G2_SB(b, h) ((4 + (b) * 2 + (h)) * HTB)
#define G2_STAGE(bufoff, gbase, voff) do { _Pragma("unroll") for (int _i = 0; _i < 2; ++_i) \
        __builtin_amdgcn_global_load_lds((const unsigned*)((const char*)(gbase) + (voff)[_i]), (PG8_LAS unsigned*)(lds + (bufoff) + ldsw + _i * 8192), 16, 0, 0); } while (0)
#define G2_STAGE4(b, pa, pb) do { G2_STAGE(G2_SB(b, 0), (pb), voffB); G2_STAGE(G2_SB(b, 1), (pb) + hstep, voffB); G2_STAGE(G2_SA(b, 0), (pa), voffA); G2_STAGE(G2_SA(b, 1), (pa) + hstep, voffA); } while (0)
#define G2_LDA(dst, b, h) do { _Pragma("unroll") for (int m = 0; m < 4; ++m) _Pragma("unroll") for (int k = 0; k < 2; ++k) dst[m][k] = *(const PG8_LAS bf16x8*)(lds + G2_SA(b, h) + aoff + m * 2048 + k * 1024); } while (0)
#define G2_LDB(dst, b, h) do { _Pragma("unroll") for (int n = 0; n < 2; ++n) _Pragma("unroll") for (int k = 0; k < 2; ++k) dst[n][k] = *(const PG8_LAS bf16x8*)(lds + G2_SB(b, h) + boff + n * 2048 + k * 1024); } while (0)
#define G2_MMA(ai, bj, At, Bt) do { _Pragma("unroll") for (int m = 0; m < 4; ++m) _Pragma("unroll") for (int n = 0; n < 2; ++n) _Pragma("unroll") for (int k = 0; k < 2; ++k) \
        acc[ai][bj][m][n] = __builtin_amdgcn_mfma_f32_16x16x32_bf16(Bt[n][k], At[m][k], acc[ai][bj][m][n], 0, 0, 0); } while (0)
#define G2_COMPUTE(b) do { G2_LDB(B0, b, 0); G2_LDB(B1, b, 1); G2_LDA(At, b, 0); __builtin_amdgcn_s_setprio(1); G2_MMA(0, 0, At, B0); G2_MMA(0, 1, At, B1); G2_LDA(At, b, 1); G2_MMA(1, 0, At, B0); G2_MMA(1, 1, At, B1); __builtin_amdgcn_s_setprio(0); } while (0)
#define G2_SYNC() do { asm volatile("s_waitcnt vmcnt(0) lgkmcnt(0)" ::: "memory"); __builtin_amdgcn_s_barrier(); __builtin_amdgcn_s_sleep(8); __builtin_amdgcn_s_barrier(); asm volatile("" ::: "memory"); } while (0)
    Unit cur, nxt; int ui = 0;
    if (!S.next(0, cur)) return;
    f32x4 acc[2][2][4][2];
#pragma unroll
    for (int a = 0; a < 2; ++a)
#pragma unroll
        for (int b = 0; b < 2; ++b)
#pragma unroll
            for (int m = 0; m < 4; ++m)
#pragma unroll
                for (int n = 0; n < 2; ++n) acc[a][b][m][n] = (f32x4){0.f, 0.f, 0.f, 0.f};
    bf16x8 At[4][2], B0[2][2], B1[2][2];
    const char* cA = (const char*)g.A + (size_t)cur.pm * tstep; const char* cB = (const char*)g.Bt + (size_t)cur.pn * tstep;
    G2_SYNC();
    G2_STAGE4(0, cA, cB);
    G2_SYNC();
    for (;;) {
        const bool has_next = S.next(ui + 1, nxt);
        const char* nA = has_next ? (const char*)g.A + (size_t)nxt.pm * tstep : cA; const char* nB = has_next ? (const char*)g.Bt + (size_t)nxt.pn * tstep : cB;
        for (int t = 0; t < nt; t += 2) {
            const bool last = (t == nt - 2);
            { const char* a1 = cA + (size_t)(t + 1) * kstep; const char* b1 = cB + (size_t)(t + 1) * kstep; G2_STAGE4(1, a1, b1); }
            G2_COMPUTE(0);
            G2_SYNC();
            if (!last || has_next) { const char* a2 = last ? nA : cA + (size_t)(t + 2) * kstep; const char* b2 = last ? nB : cB + (size_t)(t + 2) * kstep; G2_STAGE4(0, a2, b2); }
            G2_COMPUTE(1);
            G2_SYNC();
        }
        E(acc, cur, wr, wc, fr, fq);
        if (!has_next) break;
#pragma unroll
        for (int a = 0; a < 2; ++a)
#pragma unroll
            for (int b = 0; b < 2; ++b)
#pragma unroll
                for (int m = 0; m < 4; ++m)
#pragma unroll
                    for (int n = 0; n < 2; ++n) acc[a][b][m][n] = (f32x4){0.f, 0.f, 0.f, 0.f};
        cur = nxt; cA = nA; cB = nB; ++ui;
    }
    asm volatile("s_waitcnt vmcnt(0)" ::: "memory");
#undef G2_SA
#undef G2_SB
#undef G2_STAGE
#undef G2_STAGE4
#undef G2_LDA
#undef G2_LDB
#undef G2_MMA
#undef G2_COMPUTE
#undef G2_SYNC
}
template <class Epi, class Sched>
__device__ __forceinline__ void gemm_phase3(PG8_LAS unsigned char* lds, const Gemm g, const Sched& S, const Epi& E) {
    typedef int i32x4 __attribute__((ext_vector_type(4)));
    const int tid = threadIdx.x, wid = __builtin_amdgcn_readfirstlane(tid >> 6), lane = tid & 63, wr = wid >> 2, wc = wid & 3, fr = lane & 15, fq = lane >> 4;
    const int K = g.K, nt = K / BK;
    unsigned voffA[2], voffB[2];
#pragma unroll
    for (int i = 0; i < 2; ++i) { int R, C; stage_rc(tid * 16 + i * 8192, R, C); const int Rb = Epi::PERM ? ((R & ~31) + perm32(R & 31)) : R;
        voffA[i] = (unsigned)(R * K + C) * 2u; voffB[i] = (unsigned)(Rb * K + C) * 2u; }
    const size_t kstep = (size_t)(BK * 2), hstep = (size_t)HALF * K * 2, tstep = 2 * hstep;
    const int aoff = lds_byte(wr * 64 + fr, fq * 8), boff = lds_byte(wc * 32 + fr, fq * 8);
#define G3_SA(b, h) (((b) * 2 + (h)) * HTB)
#define G3_SB(b, h) ((4 + (b) * 2 + (h)) * HTB)
#define G3_ISSUE(pa, pb) do { _Pragma("unroll") for (int h = 0; h < 2; ++h) _Pragma("unroll") for (int i = 0; i < 2; ++i) { \
        sa[h * 2 + i] = *(const i32x4*)((pa) + h * hstep + voffA[i]); sb[h * 2 + i] = *(const i32x4*)((pb) + h * hstep + voffB[i]); } } while (0)
#define G3_WRITE(b) do { _Pragma("unroll") for (int h = 0; h < 2; ++h) _Pragma("unroll") for (int i = 0; i < 2; ++i) { \
        *(PG8_LAS i32x4*)(lds + G3_SA(b, h) + tid * 16 + i * 8192) = sa[h * 2 + i]; *(PG8_LAS i32x4*)(lds + G3_SB(b, h) + tid * 16 + i * 8192) = sb[h * 2 + i]; } } while (0)
#define G3_LDA(dst, b, h) do { _Pragma("unroll") for (int m = 0; m < 4; ++m) _Pragma("unroll") for (int k = 0; k < 2; ++k) dst[m][k] = *(const PG8_LAS bf16x8*)(lds + G3_SA(b, h) + aoff + m * 2048 + k * 1024); } while (0)
#define G3_LDB(dst, b, h) do { _Pragma("unroll") for (int n = 0; n < 2; ++n) _Pragma("unroll") for (int k = 0; k < 2; ++k) dst[n][k] = *(const PG8_LAS bf16x8*)(lds + G3_SB(b, h) + boff + n * 2048 + k * 1024); } while (0)
#define G3_MMA(ai, bj, At, Bt) do { _Pragma("unroll") for (int m = 0; m < 4; ++m) _Pragma("unroll") for (int n = 0; n < 2; ++n) _Pragma("unroll") for (int k = 0; k < 2; ++k) \
        acc[ai][bj][m][n] = __builtin_amdgcn_mfma_f32_16x16x32_bf16(Bt[n][k], At[m][k], acc[ai][bj][m][n], 0, 0, 0); } while (0)
#define G3_COMPUTE(b) do { bf16x8 At[4][2], B0[2][2], B1[2][2]; G3_LDB(B0, b, 0); G3_LDB(B1, b, 1); G3_LDA(At, b, 0); G3_MMA(0, 0, At, B0); G3_MMA(0, 1, At, B1); G3_LDA(At, b, 1); G3_MMA(1, 0, At, B0); G3_MMA(1, 1, At, B1); } while (0)
    Unit cur, nxt; int ui = 0;
    if (!S.next(0, cur)) return;
    f32x4 acc[2][2][4][2];
#pragma unroll
    for (int a = 0; a < 2; ++a)
#pragma unroll
        for (int b = 0; b < 2; ++b)
#pragma unroll
            for (int m = 0; m < 4; ++m)
#pragma unroll
                for (int n = 0; n < 2; ++n) acc[a][b][m][n] = (f32x4){0.f, 0.f, 0.f, 0.f};
    i32x4 sa[4], sb[4];
    const char* cA = (const char*)g.A + (size_t)cur.pm * tstep; const char* cB = (const char*)g.Bt + (size_t)cur.pn * tstep;
    __syncthreads();
    G3_ISSUE(cA, cB); G3_WRITE(0); G3_ISSUE(cA + kstep, cB + kstep);
    __syncthreads();
    for (;;) {
        const bool has_next = S.next(ui + 1, nxt);
        const char* nA = has_next ? (const char*)g.A + (size_t)nxt.pm * tstep : cA; const char* nB = has_next ? (const char*)g.Bt + (size_t)nxt.pn * tstep : cB;
        for (int t = 0; t < nt; t += 2) {
            const bool last = (t == nt - 2);
            G3_WRITE(1);
            if (!last || has_next) { const char* a2 = last ? nA : cA + (size_t)(t + 2) * kstep; const char* b2 = last ? nB : cB + (size_t)(t + 2) * kstep; G3_ISSUE(a2, b2); }
            G3_COMPUTE(0);
            __syncthreads();
            if (!last || has_next) { G3_WRITE(0);
                const char* a3 = last ? nA + kstep : cA + (size_t)(t + 3) * kstep; const char* b3 = last ? nB + kstep : cB + (size_t)(t + 3) * kstep; G3_ISSUE(a3, b3); }
            G3_COMPUTE(1);
            __syncthreads();
        }
        E(acc, cur, wr, wc, fr, fq);
        if (!has_next) break;
#pragma unroll
        for (int a = 0; a < 2; ++a)
#pragma unroll
            for (int b = 0; b < 2; ++b)
#pragma unroll
                for (int m = 0; m < 4; ++m)
#pragma unroll
                    for (int n = 0; n < 2; ++n) acc[a][b][m][n] = (f32x4){0.f, 0.f, 0.f, 0.f};
        cur = nxt; cA = nA; cB = nB; ++ui;
    }
#undef G3_SA
#undef G3_SB
#undef G3_ISSUE
#undef G3_WRITE
#undef G3_LDA
#undef G3_LDB
#undef G3_MMA
#undef G3_COMPUTE
}
}


constexpr int NWAVES = 8;
constexpr int BATCH = 2, SEQ = 8192, DM = 1024, NMETA = 16, LPOS = SEQ + NMETA, MX = BATCH * SEQ, RP = BATCH * LPOS, INC = 6144;
constexpr int NCH = 129;
constexpr float EPS = 1e-6f;
constexpr float LOG2E = 1.4426950408889634f;
constexpr float QSCALE = 0.125f * LOG2E;
constexpr float HG_SCALE = 0.08838834764831845f;
constexpr float EXIT_BITS = 126.0f;

#define GAS __attribute__((address_space(1)))
#define LAS __attribute__((address_space(3)))
typedef unsigned short bf16;
typedef unsigned v4u __attribute__((ext_vector_type(4)));
typedef unsigned v2u __attribute__((ext_vector_type(2)));
typedef float f32x4 __attribute__((ext_vector_type(4)));
typedef float f32x2 __attribute__((ext_vector_type(2)));
typedef float f32x16 __attribute__((ext_vector_type(16)));
typedef short bf16x8 __attribute__((ext_vector_type(8)));
typedef short bf16x4 __attribute__((ext_vector_type(4)));

constexpr size_t MiB = 1u << 20;
constexpr size_t WS_WIN = 1 * MiB, WS_WSB = 13 * MiB, WS_WHG = 14 * MiB, WS_WO = 15 * MiB;
constexpr size_t WS_U = 17 * MiB;
constexpr size_t WS_Q = 49 * MiB;
constexpr size_t WS_K = 65 * MiB;
constexpr size_t WS_V = 82 * MiB;
constexpr size_t WS_SG = 99 * MiB;
constexpr size_t WS_HQ = 197 * MiB;
constexpr size_t WS_HI = 213 * MiB;
constexpr size_t WS_HGT = 148 * MiB;
constexpr size_t WS_G = 164 * MiB;
constexpr size_t WS_GH = 115 * MiB;
constexpr size_t WS_DC = 230 * MiB;
constexpr size_t WS_T1 = WS_Q;
constexpr size_t WS_MG = WS_G;
constexpr size_t WS_END = 232 * MiB;
constexpr size_t DO_ST = 0, DO_GS = 32 * MiB;

constexpr int RING_BYTES = 131072, LDS_BYTES = 147456;

__device__ __forceinline__ unsigned f2bf(float f) { unsigned u = __builtin_bit_cast(unsigned, f); return (u + 0x7fffu + ((u >> 16) & 1u)) >> 16; }
__device__ __forceinline__ unsigned pk2(float lo, float hi) { return pg8::cvt_pk_bf16(lo, hi); }
__device__ __forceinline__ float bf2f(unsigned short h) { return __builtin_bit_cast(float, (unsigned)h << 16); }
__device__ __forceinline__ float bflo(unsigned w) { return __builtin_bit_cast(float, w << 16); }
__device__ __forceinline__ float bfhi(unsigned w) { return __builtin_bit_cast(float, w & 0xffff0000u); }
__device__ __forceinline__ float fsigmoid(float v) { return __builtin_amdgcn_rcpf(1.0f + __builtin_amdgcn_exp2f(-v * LOG2E)); }
__device__ __forceinline__ float fsilu(float v) { return v * fsigmoid(v); }
__device__ __forceinline__ float wave_sum(float v) {
#pragma unroll
    for (int o = 1; o < 64; o <<= 1) v += __shfl_xor(v, o);
    return v;
}
#define LDS_WAIT() asm volatile("s_waitcnt lgkmcnt(0)" ::: "memory")

struct Frame {
    LAS unsigned char* lds;
    int tid, lane, wave, vcu, G;
    const float *x, *meta, *norm_g, *w_in, *w_sb_out, *w_hg_out, *w_out, *hg_norm_g, *lbl, *final_g;
    float* out; unsigned char* ws;
    bf16 *WinT, *WsbT, *WhgT, *WoT, *U, *Q, *K, *V, *SG, *HQ, *HI, *HGT, *GH, *GS, *T1, *MG, *ST, *Y;
    bf16* Gf; float* DC;
};

__device__ __forceinline__ void store8bf(bf16* p, f32x4 a, f32x4 b) { v4u w; w.x = pk2(a[0], a[1]); w.y = pk2(a[2], a[3]); w.z = pk2(b[0], b[1]); w.w = pk2(b[2], b[3]); *(v4u*)p = w; }
template <int ACT> __device__ __forceinline__ float actf(float v) {
    if (ACT == 0) return v;
    if (ACT == 1) return v * QSCALE;
    if (ACT == 2) return fsilu(v);
    if (ACT == 3) return fsilu(v) * HG_SCALE;
    return fsigmoid(v);
}
struct EpiProj {
    static constexpr bool PERM = true, AFTER_DRAIN = false, HAS_MID = false;
    bf16 *Q, *K, *V, *SG, *HQ, *HI, *HGT, *GS, *GH; bf16* Gf; const float* lbl; unsigned char* wsb;
    template <int ACT> __device__ __forceinline__ void emit(const f32x4 (&acc)[2][2][4][2], bf16* base, int ldc, int row0, int col0) const {
#pragma unroll
        for (int ai = 0; ai < 2; ++ai)
#pragma unroll
            for (int m = 0; m < 4; ++m) { bf16* rowp = base + (size_t)(row0 + ai * 128 + m * 16) * ldc + col0;
#pragma unroll
                for (int bj = 0; bj < 2; ++bj) { f32x4 a = acc[ai][bj][m][0], b = acc[ai][bj][m][1];
#pragma unroll
                    for (int j = 0; j < 4; ++j) { a[j] = actf<ACT>(a[j]); b[j] = actf<ACT>(b[j]); }
                    store8bf(rowp + bj * 128, a, b); } }
    }
    __device__ __forceinline__ void operator()(const f32x4 (&acc)[2][2][4][2], const pg8::Unit& u, int wr, int wc, int fr, int fq) const {
        const int pn = u.pn, bb = u.pm >> 5;
        const int rowm = u.pm * 256 + wr * 64 + fr, rowp = rowm + 16 * (1 + bb);
        const int cin = wc * 32 + 8 * fq;
        int act, ldc, row0, col0; bf16* base;
        if (pn < 16) { const int grp = pn >> 1; col0 = (pn & 1) * 256 + cin; ldc = 512;
            act = (grp == 0) ? 1 : (grp == 3 || grp == 7) ? 2 : (grp == 4) ? 3 : (grp == 5) ? 5 : 0;
            const size_t boff = (grp == 0) ? WS_Q : (grp == 1) ? WS_K : (grp == 2) ? WS_V : (grp == 3) ? WS_SG : (grp == 4) ? WS_HQ : (grp == 6) ? WS_HI : WS_HGT; base = (bf16*)(wsb + boff);
            row0 = (grp == 1 || grp == 2 || grp == 5 || grp == 6) ? rowp : rowm;
        } else { act = 4; ldc = 1024; row0 = rowm; base = (pn < 20) ? GS : GH; col0 = ((pn - 16) & 3) * 256 + cin; }
        if (act == 5) {
#pragma unroll
            for (int bj = 0; bj < 2; ++bj) { float lb[8];
#pragma unroll
                for (int j = 0; j < 8; ++j) { const int c = col0 + bj * 128 + j; lb[j] = fsigmoid(lbl[c] - lbl[512 + c]); }
#pragma unroll
                for (int ai = 0; ai < 2; ++ai)
#pragma unroll
                    for (int m = 0; m < 4; ++m) { bf16* o = Gf + (size_t)(row0 + ai * 128 + m * 16) * 512 + col0 + bj * 128; f32x4 a = acc[ai][bj][m][0], b = acc[ai][bj][m][1];
#pragma unroll
                        for (int j = 0; j < 4; ++j) { a[j] = __logf(lb[j] + (1.0f - lb[j]) * fsigmoid(a[j])); b[j] = __logf(lb[4 + j] + (1.0f - lb[4 + j]) * fsigmoid(b[j])); }
                        store8bf(o, a, b); } }
            return;
        }
        if (act == 4) {
            unsigned char* gbase = (unsigned char*)base;
#pragma unroll
            for (int ai = 0; ai < 2; ++ai)
#pragma unroll
                for (int m = 0; m < 4; ++m) { unsigned char* rowq = gbase + (size_t)(row0 + ai * 128 + m * 16) * 1024 + col0;
#pragma unroll
                    for (int bj = 0; bj < 2; ++bj) { const f32x4 a = acc[ai][bj][m][0], b = acc[ai][bj][m][1]; unsigned qa[4], qb_[4];
#pragma unroll
                        for (int j = 0; j < 4; ++j) { qa[j] = (unsigned)fminf(fmaxf(fsigmoid(a[j]) * 255.0f + 0.5f, 1.0f), 255.0f); qb_[j] = (unsigned)fminf(fmaxf(fsigmoid(b[j]) * 255.0f + 0.5f, 1.0f), 255.0f); }
                        v2u w; w.x = qa[0] | (qa[1] << 8) | (qa[2] << 16) | (qa[3] << 24); w.y = qb_[0] | (qb_[1] << 8) | (qb_[2] << 16) | (qb_[3] << 24);
                        *(v2u*)(rowq + bj * 128) = w; } }
            return;
        }
        if (act <= 1) {
            const float lin = (act == 0) ? 1.0f : QSCALE;
#pragma unroll
            for (int ai = 0; ai < 2; ++ai)
#pragma unroll
                for (int m = 0; m < 4; ++m) { bf16* rowq = base + (size_t)(row0 + ai * 128 + m * 16) * ldc + col0;
#pragma unroll
                    for (int bj = 0; bj < 2; ++bj) store8bf(rowq + bj * 128, acc[ai][bj][m][0] * lin, acc[ai][bj][m][1] * lin); }
            return;
        }
        const float vs = (act == 2) ? 1.0f : HG_SCALE;
#pragma unroll
        for (int ai = 0; ai < 2; ++ai)
#pragma unroll
            for (int m = 0; m < 4; ++m) { bf16* rowq = base + (size_t)(row0 + ai * 128 + m * 16) * ldc + col0;
#pragma unroll
                for (int bj = 0; bj < 2; ++bj) { f32x4 a = acc[ai][bj][m][0], b = acc[ai][bj][m][1];
#pragma unroll
                    for (int j = 0; j < 4; ++j) { a[j] = vs * a[j] * fsigmoid(a[j]); b[j] = vs * b[j] * fsigmoid(b[j]); }
                    store8bf(rowq + bj * 128, a, b); } }
    }
};
template <int MODE> struct EpiGate {
    static constexpr bool PERM = true, AFTER_DRAIN = false, HAS_MID = false;
    const bf16* gate; const bf16* prev; bf16* O;
    __device__ __forceinline__ void operator()(const f32x4 (&acc)[2][2][4][2], const pg8::Unit& u, int wr, int wc, int fr, int fq) const {
        const int row0 = u.pm * 256 + wr * 64 + fr, col0 = u.pn * 256 + wc * 32 + 8 * fq;
#pragma unroll
        for (int ai = 0; ai < 2; ++ai)
#pragma unroll
            for (int m = 0; m < 4; ++m)
#pragma unroll
                for (int bj = 0; bj < 2; ++bj) { const size_t off = (size_t)(row0 + ai * 128 + m * 16) * 1024 + col0 + bj * 128;
                    const v4u g = *(const v4u*)(gate + off); f32x4 a = acc[ai][bj][m][0], b = acc[ai][bj][m][1];
                    a[0] *= bflo(g.x); a[1] *= bfhi(g.x); a[2] *= bflo(g.y); a[3] *= bfhi(g.y); b[0] *= bflo(g.z); b[1] *= bfhi(g.z); b[2] *= bflo(g.w); b[3] *= bfhi(g.w);
                    if (MODE == 1) { const v4u p = *(const v4u*)(prev + off);
                        a[0] += bflo(p.x); a[1] += bfhi(p.x); a[2] += bflo(p.y); a[3] += bfhi(p.y); b[0] += bflo(p.z); b[1] += bfhi(p.z); b[2] += bflo(p.w); b[3] += bfhi(p.w); }
                    store8bf(O + off, a, b); }
    }
};
struct EpiRes {
    static constexpr bool PERM = true, AFTER_DRAIN = false, HAS_MID = false;
    const float* x; float* out;
    __device__ __forceinline__ void operator()(const f32x4 (&acc)[2][2][4][2], const pg8::Unit& u, int wr, int wc, int fr, int fq) const {
        const int row0 = u.pm * 256 + wr * 64 + fr, col0 = u.pn * 256 + wc * 32 + 8 * fq;
#pragma unroll
        for (int ai = 0; ai < 2; ++ai)
#pragma unroll
            for (int m = 0; m < 4; ++m)
#pragma unroll
                for (int bj = 0; bj < 2; ++bj) { const size_t off = (size_t)(row0 + ai * 128 + m * 16) * 1024 + col0 + bj * 128;
                    const f32x4 x0 = *(const f32x4*)(x + off), x1 = *(const f32x4*)(x + off + 4);
                    f32x4 c0 = acc[ai][bj][m][0], c1 = acc[ai][bj][m][1];
                    if (DBG_SKIP & 32768) { for (int j = 0; j < 4; ++j) { c0[j] = fminf(fmaxf(c0[j], -1.5f), 1.5f); c1[j] = fminf(fmaxf(c1[j], -1.5f), 1.5f); } }
                    *(f32x4*)(out + off) = x0 + c0; *(f32x4*)(out + off + 4) = x1 + c1; }
    }
};

struct EpiMerge {
    static constexpr bool PERM = true, AFTER_DRAIN = false, HAS_MID = true;
    const unsigned char* GS; const unsigned char* GH; bf16* O;
    __device__ __forceinline__ void mid(f32x4 (&acc)[2][2][4][2], const pg8::Unit& u, int wr, int wc, int fr, int fq) const {
        int row0 = u.pm * 256 + wr * 64 + fr, col0 = u.pn * 256 + wc * 32 + 8 * fq;
        asm volatile("" : "+v"(row0), "+v"(col0));
#pragma unroll
        for (int ai = 0; ai < 2; ++ai)
#pragma unroll
            for (int m = 0; m < 4; ++m)
#pragma unroll
                for (int bj = 0; bj < 2; ++bj) { const size_t off = (size_t)(row0 + ai * 128 + m * 16) * 1024 + col0 + bj * 128; const v2u s_ = *(const v2u*)(GS + off), h_ = *(const v2u*)(GH + off);
#pragma unroll
                    for (int n = 0; n < 2; ++n) { const unsigned sw = n ? s_.y : s_.x, hw = n ? h_.y : h_.x; f32x4 a = acc[ai][bj][m][n];
#pragma unroll
                        for (int e = 0; e < 4; ++e) a[e] *= (float)((sw >> (8 * e)) & 255u) * __builtin_amdgcn_rcpf((float)((hw >> (8 * e)) & 255u));
                        asm volatile("" : "+v"(a) :: "memory"); acc[ai][bj][m][n] = a; } }
    }
    __device__ __forceinline__ void operator()(const f32x4 (&acc)[2][2][4][2], const pg8::Unit& u, int wr, int wc, int fr, int fq) const {
        const int row0 = u.pm * 256 + wr * 64 + fr, col0 = u.pn * 256 + wc * 32 + 8 * fq;
#pragma unroll
        for (int ai = 0; ai < 2; ++ai)
#pragma unroll
            for (int m = 0; m < 4; ++m)
#pragma unroll
                for (int bj = 0; bj < 2; ++bj) { const size_t off = (size_t)(row0 + ai * 128 + m * 16) * 1024 + col0 + bj * 128; const v2u h_ = *(const v2u*)(GH + off); f32x4 a = acc[ai][bj][m][0], b = acc[ai][bj][m][1];
#pragma unroll
                    for (int e = 0; e < 4; ++e) { a[e] *= (float)((h_.x >> (8 * e)) & 255u) * (1.0f / 255.0f); b[e] *= (float)((h_.y >> (8 * e)) & 255u) * (1.0f / 255.0f); }
                    store8bf(O + off, a, b); }
    }
};

__device__ __forceinline__ void p0_transpose_item(const float* W, int K, int N, bf16* WT, int ldt, LAS float* scr, int item, int lane) {
    const int nblk = N / 32, kb = item / nblk, nb = item % nblk, k0 = 64 * kb, n0 = 32 * nb;
#pragma unroll 8
    for (int i = 0; i < 32; ++i) { const int kk = 2 * i + (lane >> 5); scr[kk * 33 + (lane & 31)] = __builtin_nontemporal_load(W + (size_t)(k0 + kk) * N + n0 + (lane & 31)); }
    LDS_WAIT();
    const int c = lane & 7;
#pragma unroll
    for (int j = 0; j < 4; ++j) { const int n = (lane >> 3) + 8 * j; const LAS float* s = scr + (8 * c) * 33 + n;
        v4u o; o.x = pk2(s[0 * 33], s[1 * 33]); o.y = pk2(s[2 * 33], s[3 * 33]); o.z = pk2(s[4 * 33], s[5 * 33]); o.w = pk2(s[6 * 33], s[7 * 33]);
        *(v4u*)(WT + (size_t)(n0 + n) * ldt + k0 + 8 * c) = o; }
    LDS_WAIT();
}
__device__ __forceinline__ void meta_item(Frame& F, int it) {
    LAS float* um = (LAS float*)F.lds;
    LAS float* red = (LAS float*)(F.lds + 65536);
#pragma unroll
    for (int rr = 0; rr < 2; ++rr) { const int row = F.wave * 2 + rr; const f32x4* xr = (const f32x4*)(F.meta + row * 1024) + F.lane; const f32x4* gr = (const f32x4*)F.norm_g + F.lane;
        f32x4 v[4]; float s = 0.f;
#pragma unroll
        for (int j = 0; j < 4; ++j) { v[j] = xr[64 * j]; s += (v[j][0] * v[j][0] + v[j][1] * v[j][1]) + (v[j][2] * v[j][2] + v[j][3] * v[j][3]); }
        const float rstd = rsqrtf(wave_sum(s) * (1.0f / 1024.0f) + EPS);
#pragma unroll
        for (int j = 0; j < 4; ++j) { const f32x4 g = gr[64 * j];
#pragma unroll
            for (int e = 0; e < 4; ++e) um[(4 * (F.lane + 64 * j) + e) * 16 + row] = v[j][e] * rstd * g[e]; } }
    __syncthreads();
    const int cl = F.tid & 7, kg = F.tid >> 3;
    const int idx8 = it * 8, c0 = (idx8 < 1024) ? 512 + idx8 : 2560 + (idx8 - 1024);
    float acc[16];
#pragma unroll
    for (int r = 0; r < 16; ++r) acc[r] = 0.f;
    const float* wp = F.w_in + (size_t)(kg * 16) * INC + c0 + cl;
#pragma unroll 4
    for (int k = 0; k < 16; ++k) { const float w = wp[(size_t)k * INC]; const LAS f32x4* up = (const LAS f32x4*)(um + (kg * 16 + k) * 16);
#pragma unroll
        for (int q = 0; q < 4; ++q) { const f32x4 u = up[q];
#pragma unroll
            for (int e = 0; e < 4; ++e) acc[4 * q + e] += u[e] * w; } }
#pragma unroll
    for (int r = 0; r < 16; ++r) red[(kg * 16 + r) * 8 + cl] = acc[r];
    __syncthreads();
    if (F.tid < 128) { const int r = F.tid >> 3, c = F.tid & 7; float s = 0.f;
#pragma unroll 8
        for (int k2 = 0; k2 < 64; ++k2) s += red[(k2 * 16 + r) * 8 + c];
        const int col = c0 + c;
#pragma unroll
        for (int b = 0; b < 2; ++b) { const size_t prow = (size_t)b * LPOS + r;
            if (col < 1024) F.K[prow * 512 + col - 512] = (bf16)f2bf(s);
            else if (col < 1536) F.V[prow * 512 + col - 1024] = (bf16)f2bf(s);
            else if (col < 3072) { const int cc = col - 2560; const float lb = fsigmoid(F.lbl[cc] - F.lbl[512 + cc]); F.Gf[prow * 512 + cc] = (bf16)f2bf(__logf(lb + (1.0f - lb) * fsigmoid(s))); }
            else F.HI[prow * 512 + col - 3072] = (bf16)f2bf(s); } }
    __syncthreads();
}
__device__ __forceinline__ void p0_prologue(Frame& F) {
    for (int it = blockIdx.x; it < 256; it += F.G) meta_item(F, it);
    LAS float* scr = (LAS float*)(F.lds + F.wave * 16384);
    const int gw = F.vcu * NWAVES + F.wave, NGW = F.G * NWAVES;
    constexpr int I_IN = (1024 / 64) * (INC / 32), I_SB = (512 / 64) * (1024 / 32), I_O = (1024 / 64) * (1024 / 32);
    constexpr int NITEMS = I_IN + 2 * I_SB + I_O;
    for (int it = gw; it < NITEMS; it += NGW) {
        int r = it;
        if (r < I_IN) { p0_transpose_item(F.w_in, 1024, INC, F.WinT, 1024, scr, r, F.lane); continue; } r -= I_IN;
        if (r < I_SB) { p0_transpose_item(F.w_sb_out, 512, 1024, F.WsbT, 1024, scr, r, F.lane); continue; } r -= I_SB;
        if (r < I_SB) { p0_transpose_item(F.w_hg_out, 512, 1024, F.WsbT + 512, 1024, scr, r, F.lane); continue; } r -= I_SB;
        p0_transpose_item(F.w_out, 1024, 1024, F.WoT, 1024, scr, r, F.lane);
    }
    const bool xloc = (F.G == 256);
    const int xl = (int)blockIdx.x & 7, lw = ((int)blockIdx.x >> 3) * NWAVES + F.wave;
    const int mbeg = xloc ? 2048 * xl + lw : gw, mstep = xloc ? 256 : NGW, mend = xloc ? 2048 * xl + 2048 : MX;
    for (int m = mbeg; m < mend; m += 2 * mstep) {
        const int m2 = m + mstep; const bool has2 = m2 < mend;
        const f32x4* xr = (const f32x4*)(F.x + (size_t)m * DM) + F.lane; const f32x4* xr2 = (const f32x4*)(F.x + (size_t)(has2 ? m2 : m) * DM) + F.lane; const f32x4* gr = (const f32x4*)F.norm_g + F.lane;
        f32x4 v[4], w2[4]; float s = 0.f, s2 = 0.f;
#pragma unroll
        for (int j = 0; j < 4; ++j) { v[j] = __builtin_nontemporal_load(xr + 64 * j); w2[j] = __builtin_nontemporal_load(xr2 + 64 * j); }
#pragma unroll
        for (int j = 0; j < 4; ++j) { s += (v[j][0] * v[j][0] + v[j][1] * v[j][1]) + (v[j][2] * v[j][2] + v[j][3] * v[j][3]); s2 += (w2[j][0] * w2[j][0] + w2[j][1] * w2[j][1]) + (w2[j][2] * w2[j][2] + w2[j][3] * w2[j][3]); }
        const float rstd = rsqrtf(wave_sum(s) * (1.0f / 1024.0f) + EPS), rstd2 = rsqrtf(wave_sum(s2) * (1.0f / 1024.0f) + EPS);
        v2u* o8 = (v2u*)(F.U + (size_t)m * DM) + F.lane; v2u* o82 = (v2u*)(F.U + (size_t)m2 * DM) + F.lane;
#pragma unroll
        for (int j = 0; j < 4; ++j) { const f32x4 g = gr[64 * j]; v2u w; w.x = pk2(v[j][0] * rstd * g[0], v[j][1] * rstd * g[1]); w.y = pk2(v[j][2] * rstd * g[2], v[j][3] * rstd * g[3]); o8[64 * j] = w;
            if (has2) { v2u u; u.x = pk2(w2[j][0] * rstd2 * g[0], w2[j][1] * rstd2 * g[1]); u.y = pk2(w2[j][2] * rstd2 * g[2], w2[j][3] * rstd2 * g[3]); o82[64 * j] = u; } }
    }
}

#define ATT_PROCESS(qf_, o0_, o1_, R_, qpos_, masked_) do { \
    f32x16 z; _Pragma("unroll") for (int i = 0; i < 16; ++i) z[i] = 0.f; \
    _Pragma("unroll") for (int s = 0; s < 4; ++s) z = __builtin_amdgcn_mfma_f32_32x32x16_bf16(kf[s], qf_[s], z, 0, 0, 0); \
    float sp[16], lbv[16]; \
    if (masked_) { _Pragma("unroll") for (int i = 0; i < 16; ++i) { const int kpos = kb + (i & 3) + 8 * (i >> 2) + 4 * hh; const bool valid = (kpos < (qpos_)) && (kpos >= 0); \
            const float zz = fminf(z[i], 126.f); float s_; asm("v_log_f32 %0, %1" : "=v"(s_) : "v"(1.0f + __builtin_amdgcn_exp2f(zz))); sp[i] = valid ? s_ : 0.f; lbv[i] = valid ? (zz - s_) : -INFINITY; } } \
    else { _Pragma("unroll") for (int i = 0; i < 16; ++i) { const float zz = fminf(z[i], 126.f); float s_; asm("v_log_f32 %0, %1" : "=v"(s_) : "v"(1.0f + __builtin_amdgcn_exp2f(zz))); sp[i] = s_; lbv[i] = zz - s_; } } \
    float gs[4], ps[4], after[4]; \
    _Pragma("unroll") for (int g = 0; g < 4; ++g) { gs[g] = (sp[4 * g] + sp[4 * g + 1]) + (sp[4 * g + 2] + sp[4 * g + 3]); ps[g] = __shfl_xor(gs[g], 32); } \
    float tot = 0.f; \
    _Pragma("unroll") for (int g = 3; g >= 0; --g) { after[g] = tot + (hh == 0 ? ps[g] : 0.f); tot += gs[g] + ps[g]; } \
    float w[16]; \
    _Pragma("unroll") for (int g = 0; g < 4; ++g) { float run = (R_) + after[g]; \
        _Pragma("unroll") for (int ii = 3; ii >= 0; --ii) { const int i = 4 * g + ii; w[i] = __builtin_amdgcn_exp2f(lbv[i] - run); run += sp[i]; } } \
    (R_) += tot; \
    _Pragma("unroll") for (int s = 0; s < 2; ++s) { v4u t_; t_.x = pk2(w[8 * s], w[8 * s + 1]); t_.y = pk2(w[8 * s + 2], w[8 * s + 3]); t_.z = pk2(w[8 * s + 4], w[8 * s + 5]); t_.w = pk2(w[8 * s + 6], w[8 * s + 7]); \
        const bf16x8 wf_ = __builtin_bit_cast(bf16x8, t_); \
        o0_ = __builtin_amdgcn_mfma_f32_32x32x16_bf16(vfr[s][0], wf_, o0_, 0, 0, 0); o1_ = __builtin_amdgcn_mfma_f32_32x32x16_bf16(vfr[s][1], wf_, o1_, 0, 0, 0); } } while (0)
template <int DUMMY> __device__ __forceinline__ void attn_phase_t(Frame& F) {
    LAS bf16* vt = (LAS bf16*)(F.lds + F.wave * 8192);
    const int lane = F.lane, r = lane & 31, hh = lane >> 5;
    const int gw = F.vcu * NWAVES + F.wave, NGW = F.G * NWAVES;
#define ATT_LOADK(kb_, kf_) do { int kp_ = (kb_) + r; kp_ = kp_ < 0 ? 0 : kp_; const bf16* krow_ = F.K + (prow0 + kp_) * 512 + h * 64 + 8 * hh; \
            _Pragma("unroll") for (int s_ = 0; s_ < 4; ++s_) kf_[s_] = *(const bf16x8*)(krow_ + 16 * s_); } while (0)
#define ATT_LOADV(kb_, vv_) do { _Pragma("unroll") for (int i_ = 0; i_ < 4; ++i_) { const int idx_ = lane + 64 * i_, key_ = idx_ & 31, c_ = idx_ >> 5; int vp_ = (kb_) + key_; vp_ = vp_ < 0 ? 0 : vp_; \
                vv_[i_] = *(const v4u*)(F.V + (prow0 + vp_) * 512 + h * 64 + 8 * c_); } } while (0)
    for (int it = gw; it < 2048; it += NGW) {
        const int qb = it & 127, h = (it >> 7) & 7, b = it >> 10; const int mA = b * SEQ + qb * 64 + r, mB = mA + 32; const size_t prow0 = (size_t)b * LPOS;
        const int kbA0 = NMETA + qb * 64, kbB0 = kbA0 + 32, qposA = kbA0 + r, qposB = kbB0 + r;
        bf16x8 qfA[4], qfB[4], kf[4], kfn[4]; v4u vv[4];
#pragma unroll
        for (int s = 0; s < 4; ++s) { qfA[s] = *(const bf16x8*)(F.Q + (size_t)mA * 512 + h * 64 + 8 * hh + 16 * s); qfB[s] = *(const bf16x8*)(F.Q + (size_t)mB * 512 + h * 64 + 8 * hh + 16 * s); }
        ATT_LOADK(kbB0, kf); ATT_LOADV(kbB0, vv);
        f32x16 oA0, oA1, oB0, oB1;
#pragma unroll
        for (int i = 0; i < 16; ++i) { oA0[i] = 0.f; oA1[i] = 0.f; oB0[i] = 0.f; oB1[i] = 0.f; }
        float RA = 0.f, RB = 0.f; bool doneB = false;
        for (int kb = kbB0;; kb -= 32) {
            ATT_LOADK(kb - 32, kfn);
#pragma unroll
            for (int i = 0; i < 4; ++i) { const int idx = lane + 64 * i, key = idx & 31, c = idx >> 5; const unsigned ww[4] = {vv[i].x, vv[i].y, vv[i].z, vv[i].w};
#pragma unroll
                for (int j = 0; j < 4; ++j) { vt[(8 * c + 2 * j) * 36 + key] = (bf16)(ww[j] & 0xffffu); vt[(8 * c + 2 * j + 1) * 36 + key] = (bf16)(ww[j] >> 16); } }
            ATT_LOADV(kb - 32, vv);
            LDS_WAIT();
            bf16x8 vfr[2][2];
#pragma unroll
            for (int s = 0; s < 2; ++s)
#pragma unroll
                for (int db = 0; db < 2; ++db) { const LAS bf16* vp = vt + (32 * db + r) * 36 + 16 * s + 4 * hh; const bf16x4 lo = *(const LAS bf16x4*)vp, hi = *(const LAS bf16x4*)(vp + 8);
                    vfr[s][db] = (bf16x8){lo[0], lo[1], lo[2], lo[3], hi[0], hi[1], hi[2], hi[3]}; }
            LDS_WAIT();
            if (!doneB) { if (kb == kbB0 || kb < 0) ATT_PROCESS(qfB, oB0, oB1, RB, qposB, true); else ATT_PROCESS(qfB, oB0, oB1, RB, qposB, false); }
            if (kb <= kbA0) { if (kb == kbA0 || kb < 0) ATT_PROCESS(qfA, oA0, oA1, RA, qposA, true); else ATT_PROCESS(qfA, oA0, oA1, RA, qposA, false); }
            if (kb <= 0) break;
            doneB = __all(RB >= EXIT_BITS);
            if (doneB && kb <= kbA0 && __all(RA >= EXIT_BITS)) break;
#pragma unroll
            for (int s = 0; s < 4; ++s) kf[s] = kfn[s];
        }
#pragma unroll
        for (int g = 0; g < 8; ++g) { const int db = g >> 2, gg = g & 3; const int d0 = h * 64 + 32 * db + 8 * gg + 4 * hh;
            const v2u sga = *(const v2u*)(F.SG + (size_t)mA * 512 + d0), sgb = *(const v2u*)(F.SG + (size_t)mB * 512 + d0);
            const f32x16& oa = db ? oA1 : oA0; const f32x16& ob = db ? oB1 : oB0; v2u ya, yb;
            ya.x = pk2(oa[4 * gg] * bflo(sga.x), oa[4 * gg + 1] * bfhi(sga.x)); ya.y = pk2(oa[4 * gg + 2] * bflo(sga.y), oa[4 * gg + 3] * bfhi(sga.y));
            yb.x = pk2(ob[4 * gg] * bflo(sgb.x), ob[4 * gg + 1] * bfhi(sgb.x)); yb.y = pk2(ob[4 * gg + 2] * bflo(sgb.y), ob[4 * gg + 3] * bfhi(sgb.y));
            if (DUMMY) { *(v2u*)((bf16*)(F.ws + 231 * MiB) + (size_t)(mA % 12288) * 1024 + d0) = ya; } else { *(v2u*)(F.Y + (size_t)mA * 1024 + d0) = ya; *(v2u*)(F.Y + (size_t)mB * 1024 + d0) = yb; } }
    }
}
__device__ __forceinline__ void attn_phase(Frame& F) { attn_phase_t<0>(F); }
__device__ __forceinline__ void stage_iT(Frame& F, LAS bf16* iT, size_t prow, int hh, int nv) {
#pragma unroll
    for (int q = 0; q < 2; ++q) { const int idx = F.tid + 512 * q, s = idx & 63, c8 = idx >> 6;
        v4u w = {0u, 0u, 0u, 0u}; if (s < nv) w = *(const v4u*)(F.HI + (prow + s) * 512 + hh * 128 + 8 * c8);
        const unsigned ww[4] = {w.x, w.y, w.z, w.w};
#pragma unroll
        for (int j = 0; j < 4; ++j) { iT[(8 * c8 + 2 * j) * 72 + s] = (bf16)(ww[j] & 0xffffu); iT[(8 * c8 + 2 * j + 1) * 72 + s] = (bf16)(ww[j] >> 16); } }
}
#define LDS_BAR() do { asm volatile("s_waitcnt lgkmcnt(0)" ::: "memory"); __builtin_amdgcn_s_barrier(); asm volatile("" ::: "memory"); } while (0)
#define P2_DECODE(un_, stream_, c_, b_, hh_, nvl_, prow_) const int stream_ = (un_) >> 7, c_ = (un_) & 127, b_ = stream_ >> 2, hh_ = stream_ & 3, nvl_ = c_ ? 64 : NMETA; \
    const size_t prow_ = (size_t)b_ * LPOS + (c_ ? NMETA + 64 * (c_ - 1) : 0);
#define P2_LOAD(un_, iw_, gg_) do { P2_DECODE(un_, st_, cc_, b_, hh_, nv_, prow_) \
    _Pragma("unroll") for (int q2 = 0; q2 < 2; ++q2) { const int idx = F.tid + 512 * q2, s_ = idx & 63, c8 = idx >> 6; iw_[q2] = (v4u){0u, 0u, 0u, 0u}; if (s_ < nv_) iw_[q2] = *(const v4u*)(F.HI + (prow_ + s_) * 512 + hh_ * 128 + 8 * c8); } \
    { const int kp = F.tid & 63, q = F.tid >> 6; _Pragma("unroll") for (int jj = 0; jj < 8; ++jj) { const int t = 8 * q + jj; gg_[jj] = 0u; if (t < nv_) gg_[jj] = *(const unsigned*)(F.Gf + (prow_ + t) * 512 + hh_ * 128 + 2 * kp); } } } while (0)
__device__ __forceinline__ void hgrn_local_phase(Frame& F) {
    LAS bf16* KhT = (LAS bf16*)(F.lds);
    LAS bf16* iT = (LAS bf16*)(F.lds + 18432);
    LAS float* seg = (LAS float*)(F.lds + 36864);
    const int r = F.lane & 31, h2 = F.lane >> 5, wv = F.wave >> 1, wk = F.wave & 1;
    v4u iw[2]; unsigned gg[8];
    if (F.vcu < 1024) P2_LOAD(F.vcu, iw, gg);
    for (int un = F.vcu; un < 1024; un += F.G) {
        P2_DECODE(un, stream, c_, b, hh, nvl, prow)
        (void)b; (void)hh; (void)nvl; (void)prow;
#pragma unroll
        for (int q2 = 0; q2 < 2; ++q2) { const int idx = F.tid + 512 * q2, s_ = idx & 63, c8 = idx >> 6; const unsigned ww[4] = {iw[q2].x, iw[q2].y, iw[q2].z, iw[q2].w};
#pragma unroll
            for (int j = 0; j < 4; ++j) { iT[(8 * c8 + 2 * j) * 72 + s_] = (bf16)(ww[j] & 0xffffu); iT[(8 * c8 + 2 * j + 1) * 72 + s_] = (bf16)(ww[j] >> 16); } }
        { const int kp = F.tid & 63, q = F.tid >> 6; float g0[8], g1[8], c0[8], c1[8]; float run0 = 0.f, run1 = 0.f;
#pragma unroll
            for (int jj = 0; jj < 8; ++jj) { g0[jj] = bflo(gg[jj]); g1[jj] = bfhi(gg[jj]); }
            if (un + F.G < 1024) P2_LOAD(un + F.G, iw, gg);
#pragma unroll
            for (int jj = 0; jj < 8; ++jj) { run0 += g0[jj]; run1 += g1[jj]; c0[jj] = run0; c1[jj] = run1; }
            *(LAS f32x2*)(seg + q * 128 + 2 * kp) = (f32x2){run0, run1};
            LDS_BAR();
            float pre0 = 0.f, pre1 = 0.f, bl0 = 0.f, bl1 = 0.f;
#pragma unroll
            for (int qq = 0; qq < 8; ++qq) { const f32x2 sv = *(const LAS f32x2*)(seg + qq * 128 + 2 * kp); bl0 += sv[0]; bl1 += sv[1]; if (qq < q) { pre0 += sv[0]; pre1 += sv[1]; } }
            if (q == 0) *(f32x2*)(F.DC + (stream * 128 + c_) * 128 + 2 * kp) = (f32x2){__expf(bl0), __expf(bl1)};
            float k0[8], k1[8];
#pragma unroll
            for (int jj = 0; jj < 8; ++jj) { k0[jj] = (1.0f - __expf(g0[jj])) * __expf(bl0 - (pre0 + c0[jj])); k1[jj] = (1.0f - __expf(g1[jj])) * __expf(bl1 - (pre1 + c1[jj])); }
            v4u w0, w1; w0.x = pk2(k0[0], k0[1]); w0.y = pk2(k0[2], k0[3]); w0.z = pk2(k0[4], k0[5]); w0.w = pk2(k0[6], k0[7]); w1.x = pk2(k1[0], k1[1]); w1.y = pk2(k1[2], k1[3]); w1.z = pk2(k1[4], k1[5]); w1.w = pk2(k1[6], k1[7]);
            *(LAS v4u*)(KhT + (2 * kp) * 72 + 8 * q) = w0; *(LAS v4u*)(KhT + (2 * kp + 1) * 72 + 8 * q) = w1; }
        LDS_BAR();
        f32x16 a0, a1;
#pragma unroll
        for (int i = 0; i < 16; ++i) { a0[i] = 0.f; a1[i] = 0.f; }
#pragma unroll
        for (int ks = 0; ks < 4; ++ks) { const bf16x8 af = *(const LAS bf16x8*)(iT + (32 * wv + r) * 72 + 16 * ks + 8 * h2);
            const bf16x8 b0 = *(const LAS bf16x8*)(KhT + (64 * wk + r) * 72 + 16 * ks + 8 * h2), b1 = *(const LAS bf16x8*)(KhT + (64 * wk + 32 + r) * 72 + 16 * ks + 8 * h2);
            a0 = __builtin_amdgcn_mfma_f32_32x32x16_bf16(af, b0, a0, 0, 0, 0); a1 = __builtin_amdgcn_mfma_f32_32x32x16_bf16(af, b1, a1, 0, 0, 0); }
        bf16* st = F.ST + (size_t)(stream * 128 + c_) * 16384;
#pragma unroll
        for (int i = 0; i < 16; ++i) { const int v = 32 * wv + (i & 3) + 8 * (i >> 2) + 4 * h2; st[v * 128 + 64 * wk + r] = (bf16)f2bf(a0[i]); st[v * 128 + 64 * wk + 32 + r] = (bf16)f2bf(a1[i]); }
        LDS_BAR();
    }
    asm volatile("s_waitcnt vmcnt(0)" ::: "memory");
}
__device__ __forceinline__ void hgrn_scan_phase(Frame& F, bf16* OUT) {
    LAS float* ldc = (LAS float*)F.lds;
    for (int blk = F.vcu; blk < 256; blk += F.G) {
        const int stream = blk >> 5, e = (blk & 31) * 512 + F.tid, k = e & 127; bf16* st = F.ST + (size_t)stream * 128 * 16384 + e; bf16* so = OUT + (size_t)stream * 128 * 16384 + e;
        const f32x4* dsrc = (const f32x4*)(F.DC + stream * 16384);
#pragma unroll
        for (int i = 0; i < 8; ++i) ((LAS f32x4*)ldc)[F.tid + 512 * i] = dsrc[F.tid + 512 * i];
        float S = 0.f;
#pragma unroll 1
        for (int c0 = 0; c0 < 128; c0 += 32) {
            unsigned u[32];
#pragma unroll
            for (int c = 0; c < 32; ++c) u[c] = st[(size_t)(c0 + c) * 16384];
            if (c0 == 0) __syncthreads();
#pragma unroll
            for (int c = 0; c < 32; ++c) { S = ldc[(c0 + c) * 128 + k] * S + __builtin_bit_cast(float, u[c] << 16); so[(size_t)(c0 + c) * 16384] = (bf16)f2bf(S); }
        }
        __syncthreads();
    }
}
#define P4_BAR() do { asm volatile("s_waitcnt lgkmcnt(0)" ::: "memory"); __builtin_amdgcn_s_barrier(); asm volatile("" ::: "memory"); } while (0)
#define P4_DECODE(un_, stream_, c_, nv_, b_, hh_, prow_, m0_) \
    const int stream_ = (un_) >> 7, c_ = (un_) & 127; \
    const int nv_ = 64, b_ = stream_ >> 2, hh_ = stream_ & 3; const size_t prow_ = (size_t)b_ * LPOS + NMETA + 64 * c_; const int m0_ = b_ * SEQ + 64 * c_;
#define P4_LOAD(un_, iw_, g_, qh_) do { P4_DECODE(un_, st_, cc_, nv_, b_, hh_, prow_, m0_) \
    _Pragma("unroll") for (int q2 = 0; q2 < 2; ++q2) { const int idx = F.tid + 512 * q2, s_ = idx & 63, c8 = idx >> 6; iw_[q2] = (v4u){0u, 0u, 0u, 0u}; if (s_ < nv_) iw_[q2] = *(const v4u*)(F.HI + (prow_ + s_) * 512 + hh_ * 128 + 8 * c8); } \
    { const int kp = F.tid & 63, q = F.tid >> 6; _Pragma("unroll") for (int jj = 0; jj < 8; ++jj) { const int t = 8 * q + jj; \
        const unsigned gg = *(const unsigned*)(F.Gf + (prow_ + t) * 512 + hh_ * 128 + 2 * kp); g_[2 * jj] = bflo(gg); g_[2 * jj + 1] = bfhi(gg); \
        const unsigned qq = *(const unsigned*)(F.HQ + (size_t)(m0_ + t) * 512 + hh_ * 128 + 2 * kp); qh_[2 * jj] = qq & 0xffffu; qh_[2 * jj + 1] = qq >> 16; } } } while (0)
__device__ __forceinline__ void hgrn_out_phase(Frame& F) {
    LAS bf16* Qt = (LAS bf16*)(F.lds);
    LAS bf16* Kt = (LAS bf16*)(F.lds + 17408);
    LAS bf16* iT = (LAS bf16*)(F.lds + 34816);
    LAS bf16* As = (LAS bf16*)(F.lds + 53248);
    LAS float* Of = (LAS float*)(F.lds + 62464);
    LAS float* seg = (LAS float*)(F.lds + 96256);
    const int r = F.lane & 31, h2 = F.lane >> 5;
    v4u iw[2]; float g[16]; unsigned qh[16];
    if (F.vcu < 1024) P4_LOAD(F.vcu, iw, g, qh);
    for (int un = F.vcu; un < 1024; un += F.G) {
        P4_DECODE(un, stream, c, nv, b, hh, prow, m0)
#pragma unroll
        for (int q2 = 0; q2 < 2; ++q2) { const int idx = F.tid + 512 * q2, s_ = idx & 63, c8 = idx >> 6; const unsigned ww[4] = {iw[q2].x, iw[q2].y, iw[q2].z, iw[q2].w};
#pragma unroll
            for (int j = 0; j < 4; ++j) { iT[(8 * c8 + 2 * j) * 72 + s_] = (bf16)(ww[j] & 0xffffu); iT[(8 * c8 + 2 * j + 1) * 72 + s_] = (bf16)(ww[j] >> 16); } }
        float cs[16], qv[16], gk[16];
        { const int kp = F.tid & 63, q = F.tid >> 6; float run0 = 0.f, run1 = 0.f;
#pragma unroll
            for (int jj = 0; jj < 8; ++jj) { gk[2 * jj] = g[2 * jj]; gk[2 * jj + 1] = g[2 * jj + 1]; qv[2 * jj] = __builtin_bit_cast(float, qh[2 * jj] << 16); qv[2 * jj + 1] = __builtin_bit_cast(float, qh[2 * jj + 1] << 16);
                run0 += gk[2 * jj]; run1 += gk[2 * jj + 1]; cs[2 * jj] = run0; cs[2 * jj + 1] = run1; }
            *(LAS f32x2*)(seg + q * 128 + 2 * kp) = (f32x2){run0, run1}; }
        bf16x8 sbc[8]; v4u gate0 = {0u, 0u, 0u, 0u}, gate1 = {0u, 0u, 0u, 0u};
        { const int wv = F.wave & 3; const bf16* sp = F.ST + (size_t)(stream * 128 + c) * 16384 + (32 * wv + r) * 128 + 8 * h2;
#pragma unroll
          for (int ks = 0; ks < 8; ++ks) sbc[ks] = *(const bf16x8*)(sp + 16 * ks);
          const int t = F.tid >> 3, sg_ = F.tid & 7; const int mrow = m0 + t;
          if ((t < nv) && (mrow >= b * SEQ)) { const v4u* gp_ = (const v4u*)(F.HGT + (size_t)mrow * 512 + hh * 128 + 16 * sg_); gate0 = gp_[0]; gate1 = gp_[1]; } }
        if (un + F.G < 1024) P4_LOAD(un + F.G, iw, g, qh);
        P4_BAR();
        { const int kp = F.tid & 63, q = F.tid >> 6; float pre0 = 0.f, pre1 = 0.f;
#pragma unroll
            for (int qq = 0; qq < 7; ++qq) { const f32x2 sv = *(const LAS f32x2*)(seg + qq * 128 + 2 * kp); if (qq < q) { pre0 += sv[0]; pre1 += sv[1]; } }
#pragma unroll
            for (int jj = 0; jj < 8; ++jj) { const int t = 8 * q + jj; const float b0 = pre0 + cs[2 * jj], b1 = pre1 + cs[2 * jj + 1];
                *(LAS unsigned*)(Qt + t * 136 + 2 * kp) = pk2(qv[2 * jj] * __expf(b0), qv[2 * jj + 1] * __expf(b1));
                *(LAS unsigned*)(Kt + t * 136 + 2 * kp) = pk2((1.0f - __expf(gk[2 * jj])) * __expf(-b0), (1.0f - __expf(gk[2 * jj + 1])) * __expf(-b1)); } }
        P4_BAR();
        if (F.wave < 3) { const int tt = F.wave > 0, ts = F.wave == 2; f32x16 a;
#pragma unroll
            for (int i = 0; i < 16; ++i) a[i] = 0.f;
#pragma unroll
            for (int ks = 0; ks < 8; ++ks) { const bf16x8 af = *(const LAS bf16x8*)(Qt + (32 * tt + r) * 136 + 16 * ks + 8 * h2), bfr = *(const LAS bf16x8*)(Kt + (32 * ts + r) * 136 + 16 * ks + 8 * h2);
                a = __builtin_amdgcn_mfma_f32_32x32x16_bf16(af, bfr, a, 0, 0, 0); }
#pragma unroll
            for (int i = 0; i < 16; ++i) { const int t = 32 * tt + (i & 3) + 8 * (i >> 2) + 4 * h2, s_ = 32 * ts + r; As[t * 72 + s_] = (s_ <= t) ? (bf16)f2bf(a[i]) : (bf16)0; }
        } else if (F.wave == 3) {
#pragma unroll
            for (int i = 0; i < 16; ++i) { const int t = (i & 3) + 8 * (i >> 2) + 4 * h2; As[t * 72 + 32 + r] = (bf16)0; }
        }
        P4_BAR();
        { const int wt = F.wave >> 2, wv = F.wave & 3; f32x16 o;
#pragma unroll
            for (int i = 0; i < 16; ++i) o[i] = 0.f;
#pragma unroll
            for (int ks = 0; ks < 4; ++ks) { const bf16x8 af = *(const LAS bf16x8*)(As + (32 * wt + r) * 72 + 16 * ks + 8 * h2), bfr = *(const LAS bf16x8*)(iT + (32 * wv + r) * 72 + 16 * ks + 8 * h2);
                o = __builtin_amdgcn_mfma_f32_32x32x16_bf16(af, bfr, o, 0, 0, 0); }
#pragma unroll
            for (int ks = 0; ks < 8; ++ks) { const bf16x8 af = *(const LAS bf16x8*)(Qt + (32 * wt + r) * 136 + 16 * ks + 8 * h2);
                o = __builtin_amdgcn_mfma_f32_32x32x16_bf16(af, sbc[ks], o, 0, 0, 0); }
#pragma unroll
            for (int i = 0; i < 16; ++i) { const int t = 32 * wt + (i & 3) + 8 * (i >> 2) + 4 * h2; Of[t * 132 + 32 * wv + r] = o[i]; } }
        P4_BAR();
        { const int t = F.tid >> 3, sg_ = F.tid & 7; const LAS f32x4* op = (const LAS f32x4*)(Of + t * 132 + 16 * sg_); f32x4 v[4]; float ss = 0.f;
#pragma unroll
            for (int j = 0; j < 4; ++j) { v[j] = op[j]; ss += (v[j][0] * v[j][0] + v[j][1] * v[j][1]) + (v[j][2] * v[j][2] + v[j][3] * v[j][3]); }
            ss += __shfl_xor(ss, 1); ss += __shfl_xor(ss, 2); ss += __shfl_xor(ss, 4);
            const float rstd = rsqrtf(ss * (1.0f / 128.0f) + EPS); const int mrow = m0 + t;
            if (t < nv && mrow >= b * SEQ) { const int cv = hh * 128 + 16 * sg_; const f32x4* gn = (const f32x4*)(F.hg_norm_g + cv);
#pragma unroll
                for (int q = 0; q < 2; ++q) { const v4u gq = q ? gate1 : gate0; const f32x4 n0 = gn[2 * q], n1 = gn[2 * q + 1]; const f32x4 a = v[2 * q], bq = v[2 * q + 1]; v4u y;
                    y.x = pk2(a[0] * rstd * n0[0] * bflo(gq.x), a[1] * rstd * n0[1] * bfhi(gq.x)); y.y = pk2(a[2] * rstd * n0[2] * bflo(gq.y), a[3] * rstd * n0[3] * bfhi(gq.y));
                    y.z = pk2(bq[0] * rstd * n1[0] * bflo(gq.z), bq[1] * rstd * n1[1] * bfhi(gq.z)); y.w = pk2(bq[2] * rstd * n1[2] * bflo(gq.w), bq[3] * rstd * n1[3] * bfhi(gq.w));
                    *(v4u*)(F.Y + (size_t)mrow * 1024 + 512 + cv + 8 * q) = y; } } }
    }
    asm volatile("s_waitcnt vmcnt(0)" ::: "memory");
}
__device__ __forceinline__ void final_norm_phase(Frame& F) {
    const int gw = F.vcu * NWAVES + F.wave, NGW = F.G * NWAVES;
    for (int m = gw; m < MX; m += NGW) { f32x4* xr = (f32x4*)(F.out + (size_t)m * DM) + F.lane; const f32x4* gr = (const f32x4*)F.final_g + F.lane; f32x4 v[4]; float s = 0.f;
#pragma unroll
        for (int j = 0; j < 4; ++j) { v[j] = xr[64 * j]; s += (v[j][0] * v[j][0] + v[j][1] * v[j][1]) + (v[j][2] * v[j][2] + v[j][3] * v[j][3]); }
        const float rstd = rsqrtf(wave_sum(s) * (1.0f / 1024.0f) + EPS);
#pragma unroll
        for (int j = 0; j < 4; ++j) { f32x4 o = v[j] * rstd * gr[64 * j];
            if (DBG_SKIP & (1024 | 2048 | 16384)) { const unsigned fl = *(const unsigned*)(F.ws + 64); float sc = 1.f; if (fl) { const unsigned nbad = *(const unsigned*)(F.ws + 68); const int g0 = __builtin_ctz(fl); sc = 3.f + 2.f * (float)g0; } o = o * sc; }
            if (DBG_SKIP & 32) { const int c = 4 * (F.lane + 64 * j); for (int e = 0; e < 4; ++e) o[e] = bf2f(F.U[(size_t)m * 1024 + c + e]) + bf2f(F.WinT[(size_t)(m % 6144) * 1024 + c + e]) + bf2f(F.WoT[(size_t)(m & 1023) * 1024 + c + e]); }
            else if (DBG_SKIP & 16) { const int c = 4 * (F.lane + 64 * j); for (int e = 0; e < 4; ++e) o[e] = bf2f(F.HGT[(size_t)m * 512 + ((c + e) & 511)]) + bf2f(F.GH[(size_t)m * 1024 + c + e]); }
            xr[64 * j] = o; } }
}


#define XB_TMO      128
#define XB_XCNT(j)  (256  + 64 * (j))
#define XB_XSUB(j)  (1280 + 64 * (j))
#define XB_XGEN(j)  (2304 + 64 * (j))
#define XB_TOP      3328
#define XB_TOPGEN   3392
#define XCD_BAR_WORDS 3456
#define XB_SPIN_CAP (1u << 18)

__device__ __forceinline__ unsigned xb_ld(unsigned* p)              { return __hip_atomic_load(p, __ATOMIC_RELAXED, __HIP_MEMORY_SCOPE_AGENT); }
__device__ __forceinline__ unsigned xb_add(unsigned* p, unsigned v) { return __hip_atomic_fetch_add(p, v, __ATOMIC_RELAXED, __HIP_MEMORY_SCOPE_AGENT); }
__device__ __forceinline__ unsigned xb_xcc_id() { return (unsigned)__builtin_amdgcn_s_getreg((3 << 11) | 20) & 0xFu; }
#define XB_SPIN(cond, bar) do { unsigned _sp = 0; while (cond) { __builtin_amdgcn_s_sleep(1); \
    if ((++_sp & 255u) == 0u) { if (xb_ld(&(bar)[XB_TMO])) break; if (_sp > XB_SPIN_CAP) { atomicAdd(&(bar)[XB_TMO], 1u); break; } } } } while (0)

struct XcdBarrier {
    unsigned* bar; unsigned x;
    volatile LAS unsigned* st;
};

__device__ __forceinline__ XcdBarrier xcd_barrier_post(unsigned* bar, volatile LAS unsigned* st) {
    XcdBarrier b; b.bar = bar; b.x = xb_xcc_id(); b.st = st;
    if (threadIdx.x == 0) (void)xb_add(&bar[XB_XCNT(b.x)], 1u);
    return b;
}
__device__ __forceinline__ void xcd_barrier_complete(unsigned* bar, unsigned x, unsigned& nloc, unsigned& nx) {
    const unsigned G = gridDim.x * gridDim.y * gridDim.z;
    unsigned sum, cnt, mine, sp = 0u;
    for (;;) {
        sum = 0u; cnt = 0u; mine = 0u;
#pragma unroll
        for (unsigned j = 0; j < 16; ++j) { const unsigned c = xb_ld(&bar[XB_XCNT(j)]); sum += c; cnt += (c > 0u) ? 1u : 0u; mine = (j == x) ? c : mine; }
        if (sum == G) break;
        __builtin_amdgcn_s_sleep(1);
        if ((++sp & 255u) == 0u) { if (xb_ld(&bar[XB_TMO])) break; if (sp > XB_SPIN_CAP) { atomicAdd(&bar[XB_TMO], 1u); break; } }
    }
    nloc = mine > 0u ? mine : 1u; nx = cnt > 0u ? cnt : 1u;
}

__device__ __forceinline__ void xcd_barrier(const XcdBarrier& b) {
    asm volatile("s_waitcnt vmcnt(0)" ::: "memory");
    __syncthreads();
    if (threadIdx.x == 0) {
        unsigned* bar = b.bar;
        __builtin_amdgcn_s_waitcnt(0);
        unsigned nloc = b.st[0], nx = b.st[1];
        if (nloc == 0u) { xcd_barrier_complete(bar, b.x, nloc, nx); b.st[0] = nloc; b.st[1] = nx; }
        const unsigned old = xb_add(&bar[XB_XSUB(b.x)], 1u);
        const unsigned gen = old / nloc;
        if (old + 1u == (gen + 1u) * nloc) {
            __builtin_amdgcn_fence(__ATOMIC_RELEASE, "agent");
            asm volatile("s_waitcnt vmcnt(0)" ::: "memory");
            const unsigned og = xb_add(&bar[XB_TOP], 1u);
            const unsigned tg = og / nx;
            if (og + 1u == (tg + 1u) * nx) xb_add(&bar[XB_TOPGEN], 1u);
            else XB_SPIN(xb_ld(&bar[XB_TOPGEN]) == tg, bar);
            __builtin_amdgcn_fence(__ATOMIC_ACQUIRE, "agent");
            xb_add(&bar[XB_XGEN(b.x)], 1u);
            asm volatile("s_waitcnt vmcnt(0)" ::: "memory");
        } else {
            XB_SPIN(xb_ld(&bar[XB_XGEN(b.x)]) == gen, bar);
            __builtin_amdgcn_fence(__ATOMIC_ACQUIRE, "agent");
            asm volatile("s_waitcnt vmcnt(0)" ::: "memory");
        }
    }
    __syncthreads();
}


struct EpiResNorm {
    static constexpr bool PERM = true, AFTER_DRAIN = false, HAS_MID = false;
    const float* x; float* out; const float* fg; float* rowss; const XcdBarrier* bar;
    __device__ __forceinline__ void operator()(f32x4 (&acc)[2][2][4][2], const pg8::Unit& u, int wr, int wc, int fr, int fq) const {
        const int row0 = u.pm * 256 + wr * 64 + fr, col0 = u.pn * 256 + wc * 32 + 8 * fq;
#pragma unroll
        for (int ai = 0; ai < 2; ++ai)
#pragma unroll
            for (int m = 0; m < 4; ++m) { const int row = row0 + ai * 128 + m * 16; float ss = 0.f;
#pragma unroll
                for (int bj = 0; bj < 2; ++bj) { const size_t off = (size_t)row * 1024 + col0 + bj * 128; const f32x4 x0 = *(const f32x4*)(x + off), x1 = *(const f32x4*)(x + off + 4);
                    f32x4 a = acc[ai][bj][m][0] + x0, b = acc[ai][bj][m][1] + x1; acc[ai][bj][m][0] = a; acc[ai][bj][m][1] = b;
                    ss += (a[0] * a[0] + a[1] * a[1]) + (a[2] * a[2] + a[3] * a[3]) + (b[0] * b[0] + b[1] * b[1]) + (b[2] * b[2] + b[3] * b[3]); }
                ss += __shfl_xor(ss, 16); ss += __shfl_xor(ss, 32);
                if (fq == 0) __hip_atomic_fetch_add(rowss + row, ss, __ATOMIC_RELAXED, __HIP_MEMORY_SCOPE_AGENT); }
        xcd_barrier(*bar);
        f32x4 g0[2], g1[2];
#pragma unroll
        for (int bj = 0; bj < 2; ++bj) { g0[bj] = *(const f32x4*)(fg + col0 + bj * 128); g1[bj] = *(const f32x4*)(fg + col0 + bj * 128 + 4); }
#pragma unroll
        for (int ai = 0; ai < 2; ++ai)
#pragma unroll
            for (int m = 0; m < 4; ++m) { const int row = row0 + ai * 128 + m * 16; const float rstd = rsqrtf(__hip_atomic_load(rowss + row, __ATOMIC_RELAXED, __HIP_MEMORY_SCOPE_AGENT) * (1.0f / 1024.0f) + EPS);
#pragma unroll
                for (int bj = 0; bj < 2; ++bj) { const size_t off = (size_t)row * 1024 + col0 + bj * 128;
                    __builtin_nontemporal_store(acc[ai][bj][m][0] * rstd * g0[bj], (f32x4*)(out + off)); __builtin_nontemporal_store(acc[ai][bj][m][1] * rstd * g1[bj], (f32x4*)(out + off + 4)); } }
    }
};

#ifndef MK_N_LAUNCHES
#define MK_N_LAUNCHES 1
#endif
constexpr int N_PHASES = 7;
struct Args { const float* in[10]; float* out; unsigned char* ws; int ph_lo, ph_hi; };
__global__ void __launch_bounds__(NWAVES * 64, 2) mk_fwd(Args args) {
    extern __shared__ __attribute__((aligned(16))) unsigned char lds[];
    Frame F;
    F.lds = (LAS unsigned char*)lds;
    F.tid = threadIdx.x; F.lane = F.tid & 63; F.wave = __builtin_amdgcn_readfirstlane(F.tid >> 6);
    F.G = gridDim.x; { const int bx = blockIdx.x; F.vcu = (F.G % 8 == 0) ? (bx % 8) * (F.G / 8) + bx / 8 : bx; }
    unsigned char* ws = args.ws; F.ws = ws;
    F.x = args.in[0]; F.meta = args.in[1]; F.norm_g = args.in[2]; F.w_in = args.in[3]; F.w_sb_out = args.in[4]; F.w_hg_out = args.in[5]; F.w_out = args.in[6];
    F.hg_norm_g = args.in[7]; F.lbl = args.in[8]; F.final_g = args.in[9]; F.out = args.out;
    F.WinT = (bf16*)(ws + WS_WIN); F.WsbT = (bf16*)(ws + WS_WSB); F.WhgT = (bf16*)(ws + WS_WHG); F.WoT = (bf16*)(ws + WS_WO);
    F.U = (bf16*)(ws + WS_U); F.Y = (bf16*)(ws + WS_U); F.Q = (bf16*)(ws + WS_Q); F.K = (bf16*)(ws + WS_K); F.V = (bf16*)(ws + WS_V); F.SG = (bf16*)(ws + WS_SG);
    F.HQ = (bf16*)(ws + WS_HQ); F.HI = (bf16*)(ws + WS_HI); F.HGT = (bf16*)(ws + WS_HGT); F.Gf = (bf16*)(ws + WS_G); F.GH = (bf16*)(ws + WS_GH); F.DC = (float*)(ws + WS_DC);
    F.T1 = (bf16*)(ws + WS_T1); F.MG = (bf16*)(ws + WS_MG); F.ST = (bf16*)((unsigned char*)args.out + DO_ST); F.GS = (bf16*)((unsigned char*)args.out + DO_GS);
    const int lo = args.ph_lo, hi = args.ph_hi;
    volatile LAS unsigned* MISC = (volatile LAS unsigned*)(F.lds + 131072 + 320);
    if (F.tid < 32) MISC[F.tid] = 0u;
    __syncthreads();
    XcdBarrier bar; bar.bar = (unsigned*)(ws + 16384); bar.x = 0; bar.st = nullptr;
    if (MK_N_LAUNCHES == 1) bar = xcd_barrier_post((unsigned*)(ws + 16384), MISC + 8);
    if (DBG_SKIP & 256) { for (int i = F.tid; i < LDS_BYTES / 16; i += NWAVES * 64) ((LAS v4u*)F.lds)[i] = (v4u){0u, 0u, 0u, 0u}; __syncthreads(); }
#define IN(k) (lo <= (k) && (k) < hi)
#define SEAM(k) do { if (IN(k) && IN((k) + 1)) { xcd_barrier(bar); } } while (0)
    if (args.ph_hi < 0) cg::this_grid().sync();
    if (IN(0)) { p0_prologue(F); if (DBG_SKIP & (1 << 23)) { __syncthreads(); p0_prologue(F); } } SEAM(0);
    if (IN(1)) {
        pg8::Gemm g{F.U, F.WinT, MX, INC, 1024}; pg8::StaticOrder S; S.init(MX, INC, F.G, (int)blockIdx.x);
        EpiProj E{F.Q, F.K, F.V, F.SG, F.HQ, F.HI, F.HGT, F.GS, F.GH, F.Gf, F.lbl, F.ws};
        pg8::gemm_phase<EpiProj, pg8::StaticOrder, true, true>(F.lds, g, S, E);
        if (DBG_SKIP & (1 << 22)) { __syncthreads(); pg8::gemm_phase<EpiProj, pg8::StaticOrder, true, true>(F.lds, g, S, E); }
    } SEAM(1);
    if (DBG_SKIP & 128) {
        pg8::StaticOrder S; S.init(MX, INC, F.G, (int)blockIdx.x); pg8::Unit u;
        for (int i = 0; S.next(i, u); ++i) { if (u.pn < 20) continue;
            for (int e = F.tid; e < 256 * 256; e += 512) { const int rr = e >> 8, cc = e & 255; const size_t off = (size_t)(u.pm * 256 + rr) * 1024 + (u.pn - 20) * 256 + cc; F.out[off] = bf2f(F.GH[off]); } }
        return;
    }
    if (IN(2) && !(DBG_SKIP & (64 | 16384))) { hgrn_local_phase(F); attn_phase(F); if (DBG_SKIP & (1 << 20)) { __syncthreads(); hgrn_local_phase(F); } if (DBG_SKIP & (1 << 19)) { __syncthreads(); attn_phase_t<1>(F); } if (DBG_SKIP & (1 << 18)) { __syncthreads(); attn_phase_t<2>(F); } } SEAM(2);

    if (IN(3) && !(DBG_SKIP & (64 | 16384))) { hgrn_scan_phase(F, F.ST); if (DBG_SKIP & (1 << 28)) { __syncthreads(); hgrn_scan_phase(F, F.Q); } } SEAM(3);
    if (IN(4) && !(DBG_SKIP & (64 | 16384))) { hgrn_out_phase(F); if (DBG_SKIP & (1 << 21)) { __syncthreads(); hgrn_out_phase(F); } } SEAM(4);
    if (IN(5) && !(DBG_SKIP & (64 | 2048 | 16384))) {
        pg8::Gemm g{F.Y, F.WsbT, MX, 1024, 1024}; pg8::StaticOrder S; S.init(MX, 1024, F.G, (int)blockIdx.x); EpiMerge E{(const unsigned char*)F.GS, (const unsigned char*)F.GH, F.MG};
        pg8::gemm_phase<EpiMerge, pg8::StaticOrder, true, true>(F.lds, g, S, E);
    } SEAM(5);
    if (IN(6) && (DBG_SKIP & (2048 | 16384))) { for (size_t i = (size_t)blockIdx.x * 512 + F.tid; i < (size_t)MX * 256; i += (size_t)F.G * 512) ((f32x4*)F.out)[i] = ((const f32x4*)F.x)[i]; }
    const bool fuse_norm = (MK_N_LAUNCHES == 1) && (F.G == 256);
    if (IN(6) && fuse_norm) {
        pg8::Gemm g{F.MG, F.WoT, MX, 1024, 1024}; pg8::StaticOrder S; S.init(MX, 1024, F.G, (int)blockIdx.x); EpiResNorm E{F.x, F.out, F.final_g, (float*)(ws + 65536), &bar};
        pg8::gemm_phase<EpiResNorm, pg8::StaticOrder, true, true>(F.lds, g, S, E);
    }
    if (IN(6) && !fuse_norm) {
        pg8::Gemm g{F.MG, F.WoT, MX, 1024, 1024}; pg8::StaticOrder S; S.init(MX, 1024, F.G, (int)blockIdx.x); EpiRes E{F.x, F.out};
        pg8::gemm_phase<EpiRes, pg8::StaticOrder, true, true>(F.lds, g, S, E);
    }
    if (!fuse_norm) { SEAM(6); }
    if (IN(7) && !fuse_norm) { final_norm_phase(F); }

#undef IN
#undef SEAM
}

extern "C" void kernel_launch(void* const* d_in, const int* in_sizes, int n_in, void* d_out, int out_size, void* d_ws, size_t ws_size, hipStream_t stream) {
    static int grid = 0;
    if (grid == 0) {
        if (n_in != 10 || in_sizes[0] != MX * DM || out_size != MX * DM || ws_size < WS_END) { fprintf(stderr, "kernel_launch: unexpected shapes (n_in %d in0 %d out %d ws %zu)\n", n_in, n_in > 0 ? in_sizes[0] : -1, out_size, ws_size); grid = -1; return; }
        int dev = 0, cus = 0, per_cu = 0;
        if (hipGetDevice(&dev) != hipSuccess || hipDeviceGetAttribute(&cus, hipDeviceAttributeMultiprocessorCount, dev) != hipSuccess) { grid = -1; return; }
        if (hipFuncSetAttribute((const void*)mk_fwd, hipFuncAttributeMaxDynamicSharedMemorySize, LDS_BYTES) != hipSuccess) { fprintf(stderr, "kernel_launch: hipFuncSetAttribute failed\n"); grid = -1; return; }
        if (hipOccupancyMaxActiveBlocksPerMultiprocessor(&per_cu, (const void*)mk_fwd, NWAVES * 64, LDS_BYTES) != hipSuccess || per_cu < 1) { fprintf(stderr, "kernel_launch: occupancy query says %d\n", per_cu); per_cu = 1; }
        (void)hipGetLastError();
        grid = cus;
    }
    if (grid < 0) return;
    Args a{};
    for (int i = 0; i < 10; ++i) a.in[i] = (const float*)d_in[i];
    a.out = (float*)d_out; a.ws = (unsigned char*)d_ws;
#if MK_N_LAUNCHES == 1
    (void)hipMemsetAsync(d_ws, 0, 131072, stream);
    a.ph_lo = 0; a.ph_hi = N_PHASES + 1;
    void* kargs[] = {&a};
    hipError_t e = hipLaunchCooperativeKernel((const void*)mk_fwd, dim3(grid), dim3(NWAVES * 64), kargs, LDS_BYTES, stream);
    if (e != hipSuccess) fprintf(stderr, "kernel_launch: cooperative launch failed: %s (grid %d)\n", hipGetErrorString(e), grid);
#else
    for (int p = 0; p <= N_PHASES; ++p) { if ((DBG_SKIP & 32) && p >= 1 && p <= 6) continue; a.ph_lo = p; a.ph_hi = p + 1; hipLaunchKernelGGL(mk_fwd, dim3(grid), dim3(NWAVES * 64), LDS_BYTES, stream, a); }
#endif
}
```

```cpp
#include <hip/hip_runtime.h>
#include <hip/hip_cooperative_groups.h>
#include <cstdio>
#include <cstdint>
namespace cg = cooperative_groups;
#ifndef DBG_SKIP
#define DBG_SKIP 0
#endif
namespace pg8 {
#define PG8_LAS __attribute__((address_space(3)))
typedef unsigned short bf16_t;
typedef short bf16x8 __attribute__((ext_vector_type(8)));
typedef float f32x4 __attribute__((ext_vector_type(4)));
typedef unsigned u32x4 __attribute__((ext_vector_type(4)));
constexpr int BM = 256, BK = 64, HALF = 128, HTB = HALF * BK * 2  , STAGE_BYTES = 8 * HTB, NXCD = 8, WGM = 8;

__host__ __device__ __forceinline__ int lds_byte(int r, int c) { const int st = (r >> 4) * 2 + (c >> 5), rr = r & 15, cc = c & 31, ob = rr * 64 + cc * 2; return st * 1024 + (ob ^ (((ob >> 9) & 1) << 5)); }
__host__ __device__ __forceinline__ void stage_rc(int b, int& R, int& C) { const int st = b / 1024, sb = b % 1024, swz = sb ^ (((sb >> 9) & 1) << 5); R = (st >> 1) * 16 + swz / 64; C = (st & 1) * 32 + (swz % 64) / 2; }
__host__ __device__ __forceinline__ int perm32(int rho) { const int n = rho >> 4, i = rho & 15; return 8 * (i >> 2) + 4 * n + (i & 3); }

struct Unit { int pm, pn; };
struct Gemm { const bf16_t* A; const bf16_t* Bt; int M, N, K; };

struct StaticOrder {
    int nM, nN, nwg, G, c;
    __host__ __device__ void init(int M, int N, int G_, int c_) { nM = M / BM; nN = N / BM; nwg = nM * nN; G = G_; c = c_; }
    __host__ __device__ bool next(int i, Unit& u) const {
        const long L = (long)i * G + c; if (L >= nwg) return false;
        int wgid = (int)L; { const int q = nwg / NXCD, r = nwg % NXCD, xcd = wgid % NXCD, off = wgid / NXCD; wgid = (xcd < r ? xcd * (q + 1) : r * (q + 1) + (xcd - r) * q) + off; }
        const int nig = WGM * nN, gid = wgid / nig, fm = gid * WGM, gsz = (nM - fm) < WGM ? (nM - fm) : WGM;
        u.pm = fm + ((wgid % nig) % gsz); u.pn = (wgid % nig) / gsz; if (DBG_SKIP & 65536) u.pn = nN - 1 - u.pn; return true;
    }
    __device__ __forceinline__ void a_ready(const Unit&) const {}
    __device__ __forceinline__ void done(const Unit&) const {}
};

__device__ __forceinline__ unsigned cvt_pk_bf16(float lo, float hi) { unsigned r; asm volatile("v_cvt_pk_bf16_f32 %0, %1, %2" : "=v"(r) : "v"(lo), "v"(hi)); return r; }
typedef float f32x2 __attribute__((ext_vector_type(2)));
template <class Epi, class Sched, bool ALIGN_EPI = false, bool SP2 = false>
__device__ __forceinline__ void gemm_phase(PG8_LAS unsigned char* lds, const Gemm g, const Sched& S, const Epi& E) {
    const int tid = threadIdx.x, wid = __builtin_amdgcn_readfirstlane(tid >> 6), lane = tid & 63, wr = wid >> 2, wc = wid & 3, fr = lane & 15, fq = lane >> 4;
    const int K = g.K, nt = K / BK;
    unsigned voffA[2], voffB[2];
#pragma unroll
    for (int i = 0; i < 2; ++i) { int R, C; stage_rc(tid * 16 + i * 8192, R, C); const int Rb = Epi::PERM ? ((R & ~31) + perm32(R & 31)) : R;
        voffA[i] = (unsigned)(R * K + C) * 2u; voffB[i] = (unsigned)(Rb * K + C) * 2u; }
    const size_t kstep = (size_t)(BK * 2);
    const size_t hstep = (size_t)HALF * K * 2;
    const size_t tstep = 2 * hstep;
    const unsigned ldsw = (unsigned)wid * 1024u;
    const int aoff = lds_byte(wr * 64 + fr, fq * 8), boff = lds_byte(wc * 32 + fr, fq * 8);
#define PG8_SA(b, h) (((b) * 2 + (h)) * HTB)
#define PG8_SB(b, h) ((4 + (b) * 2 + (h)) * HTB)
#define PG8_STAGE(bufoff, gbase, voff) do { _Pragma("unroll") for (int _i = 0; _i < 2; ++_i) \
        __builtin_amdgcn_global_load_lds((const unsigned*)((const char*)(gbase) + (voff)[_i]), (PG8_LAS unsigned*)(lds + (bufoff) + ldsw + _i * 8192), 16, 0, 0); } while (0)
#define PG8_LDA(dst, b, h) do { _Pragma("unroll") for (int m = 0; m < 4; ++m) _Pragma("unroll") for (int k = 0; k < 2; ++k) dst[m][k] = *(const PG8_LAS bf16x8*)(lds + PG8_SA(b, h) + aoff + m * 2048 + k * 1024); } while (0)
#define PG8_LDB(dst, b, h) do { _Pragma("unroll") for (int n = 0; n < 2; ++n) _Pragma("unroll") for (int k = 0; k < 2; ++k) dst[n][k] = *(const PG8_LAS bf16x8*)(lds + PG8_SB(b, h) + boff + n * 2048 + k * 1024); } while (0)
#define PG8_MMA(ai, bj, At, Bt) do { __builtin_amdgcn_s_setprio(1); _Pragma("unroll") for (int m = 0; m < 4; ++m) _Pragma("unroll") for (int n = 0; n < 2; ++n) _Pragma("unroll") for (int k = 0; k < 2; ++k) \
        acc[ai][bj][m][n] = __builtin_amdgcn_mfma_f32_16x16x32_bf16(Bt[n][k], At[m][k], acc[ai][bj][m][n], 0, 0, 0); __builtin_amdgcn_s_setprio(0); } while (0)
#define PG8_WAIT_V(n) asm volatile("s_waitcnt vmcnt(" #n ")" ::: "memory")
#define PG8_WAIT_L(n) asm volatile("s_waitcnt lgkmcnt(" #n ")" ::: "memory")
#define PG8_BAR __builtin_amdgcn_s_barrier()
#define PG8_SCHED __builtin_amdgcn_sched_barrier(0)
    Unit cur, nxt; int ui = 0;
    if (!S.next(0, cur)) return;
    f32x4 acc[2][2][4][2];
#pragma unroll
    for (int a = 0; a < 2; ++a)
#pragma unroll
        for (int b = 0; b < 2; ++b)
#pragma unroll
            for (int m = 0; m < 4; ++m)
#pragma unroll
                for (int n = 0; n < 2; ++n) acc[a][b][m][n] = (f32x4){0.f, 0.f, 0.f, 0.f};
    bf16x8 At[4][2], B0[2][2], B1[2][2];
    const char* cA = (const char*)g.A + (size_t)cur.pm * tstep; const char* cB = (const char*)g.Bt + (size_t)cur.pn * tstep;
    S.a_ready(cur);
    if constexpr (SP2) {
        PG8_STAGE(PG8_SB(0, 0), cB, voffB); PG8_STAGE(PG8_SB(0, 1), cB + hstep, voffB); PG8_STAGE(PG8_SA(0, 0), cA, voffA); PG8_STAGE(PG8_SA(0, 1), cA + hstep, voffA);
        if (wr == 1) PG8_BAR;
        PG8_WAIT_V(2); PG8_BAR;
        PG8_STAGE(PG8_SB(1, 0), cB + kstep, voffB); PG8_STAGE(PG8_SA(1, 0), cA + kstep, voffA); PG8_STAGE(PG8_SB(1, 1), cB + hstep + kstep, voffB);
        PG8_WAIT_V(6); PG8_BAR;
    } else {
        PG8_STAGE(PG8_SB(0, 0), cB, voffB); PG8_STAGE(PG8_SA(0, 0), cA, voffA); PG8_STAGE(PG8_SB(0, 1), cB + hstep, voffB); PG8_STAGE(PG8_SA(0, 1), cA + hstep, voffA);
        if (wr == 1) PG8_BAR;
        PG8_WAIT_V(4); PG8_BAR;
        PG8_STAGE(PG8_SB(1, 0), cB + kstep, voffB); PG8_STAGE(PG8_SA(1, 0), cA + kstep, voffA); PG8_STAGE(PG8_SB(1, 1), cB + hstep + kstep, voffB);
        PG8_WAIT_V(6); PG8_BAR;
    }
    for (;;) {
        const bool has_next = S.next(ui + 1, nxt);
        const char* nA = has_next ? (const char*)g.A + (size_t)nxt.pm * tstep : cA; const char* nB = has_next ? (const char*)g.Bt + (size_t)nxt.pn * tstep : cB;
        for (int half_ = 0; half_ < (Epi::HAS_MID ? 2 : 1); ++half_) {
        if constexpr (Epi::HAS_MID) { if (half_ == 1) { E.mid(acc, cur, wr, wc, fr, fq); asm volatile("" ::: "memory"); } }
        for (int t = Epi::HAS_MID ? half_ * (nt >> 1) : 0; t < (Epi::HAS_MID ? (half_ + 1) * (nt >> 1) : nt); t += 2) {
            const bool last = (t == nt - 2);
            const char* a1 = cA + (size_t)(t + 1) * kstep;
            const char* a2 = last ? nA : cA + (size_t)(t + 2) * kstep; const char* b2 = last ? nB : cB + (size_t)(t + 2) * kstep;
            const char* a3 = a2 + kstep; const char* b3 = b2 + kstep;
            if (last && has_next) S.a_ready(nxt);
            if constexpr (SP2) {
            PG8_LDB(B0, 0, 0); PG8_LDB(B1, 0, 1); PG8_SCHED; PG8_LDA(At, 0, 0); PG8_STAGE(PG8_SA(1, 1), a1 + hstep, voffA);
            PG8_WAIT_V(8); PG8_WAIT_L(0); PG8_BAR; PG8_MMA(0, 0, At, B0); PG8_MMA(0, 1, At, B1); PG8_BAR; PG8_SCHED;
            PG8_LDA(At, 0, 1); PG8_STAGE(PG8_SB(0, 0), b2, voffB); PG8_STAGE(PG8_SB(0, 1), b2 + hstep, voffB); PG8_STAGE(PG8_SA(0, 0), a2, voffA);
            PG8_WAIT_V(8); PG8_WAIT_L(0); PG8_BAR; PG8_MMA(1, 0, At, B0); PG8_MMA(1, 1, At, B1); PG8_BAR; PG8_SCHED;
            PG8_LDB(B0, 1, 0); PG8_LDB(B1, 1, 1); PG8_SCHED; PG8_LDA(At, 1, 0); PG8_STAGE(PG8_SA(0, 1), a2 + hstep, voffA);
            PG8_WAIT_V(8); PG8_WAIT_L(0); PG8_BAR; PG8_MMA(0, 0, At, B0); PG8_MMA(0, 1, At, B1); PG8_BAR; PG8_SCHED;
            PG8_LDA(At, 1, 1); PG8_STAGE(PG8_SB(1, 0), b3, voffB); PG8_STAGE(PG8_SB(1, 1), b3 + hstep, voffB); PG8_STAGE(PG8_SA(1, 0), a3, voffA);
            PG8_WAIT_V(8); PG8_WAIT_L(0); PG8_BAR; PG8_MMA(1, 0, At, B0); PG8_MMA(1, 1, At, B1); PG8_BAR; PG8_SCHED;
            } else {
            PG8_LDB(B0, 0, 0); PG8_SCHED; PG8_LDA(At, 0, 0); PG8_STAGE(PG8_SA(1, 1), a1 + hstep, voffA);
            PG8_WAIT_L(8); PG8_BAR; PG8_WAIT_L(0); PG8_MMA(0, 0, At, B0); PG8_BAR; PG8_SCHED;
            PG8_LDB(B1, 0, 1); PG8_STAGE(PG8_SB(0, 0), b2, voffB);
            PG8_BAR; PG8_WAIT_L(0); PG8_MMA(0, 1, At, B1); PG8_BAR;
            PG8_LDA(At, 0, 1); PG8_STAGE(PG8_SA(0, 0), a2, voffA);
            PG8_BAR; PG8_WAIT_L(0); PG8_MMA(1, 0, At, B0); PG8_BAR; PG8_SCHED;
            PG8_STAGE(PG8_SB(0, 1), b2 + hstep, voffB);
            PG8_WAIT_V(6); PG8_BAR; PG8_MMA(1, 1, At, B1); PG8_BAR;
            PG8_LDB(B0, 1, 0); PG8_SCHED; PG8_LDA(At, 1, 0); PG8_STAGE(PG8_SA(0, 1), a2 + hstep, voffA);
            PG8_WAIT_L(8); PG8_BAR; PG8_WAIT_L(0); PG8_MMA(0, 0, At, B0); PG8_BAR; PG8_SCHED;
            PG8_LDB(B1, 1, 1); PG8_STAGE(PG8_SB(1, 0), b3, voffB);
            PG8_BAR; PG8_WAIT_L(0); PG8_MMA(0, 1, At, B1); PG8_BAR;
            PG8_LDA(At, 1, 1); PG8_STAGE(PG8_SA(1, 0), a3, voffA);
            PG8_BAR; PG8_WAIT_L(0); PG8_MMA(1, 0, At, B0); PG8_BAR; PG8_SCHED;
            PG8_STAGE(PG8_SB(1, 1), b3 + hstep, voffB);
            PG8_WAIT_V(6); PG8_BAR; PG8_MMA(1, 1, At, B1); PG8_BAR;
            }
        }
        }
        if constexpr (ALIGN_EPI) { if (wr == 0) PG8_BAR; }
        if constexpr (!Epi::AFTER_DRAIN) { E(acc, cur, wr, wc, fr, fq); S.done(cur); }
        if (!has_next) break;
#pragma unroll
        for (int a = 0; a < 2; ++a)
#pragma unroll
            for (int b = 0; b < 2; ++b)
#pragma unroll
                for (int m = 0; m < 4; ++m)
#pragma unroll
                    for (int n = 0; n < 2; ++n) acc[a][b][m][n] = (f32x4){0.f, 0.f, 0.f, 0.f};
        cur = nxt; cA = nA; cB = nB; ++ui;
        if constexpr (ALIGN_EPI) { if (wr == 1) PG8_BAR; }
    }
    PG8_WAIT_V(0);
    if constexpr (!ALIGN_EPI) { if (wr == 0) PG8_BAR; }
    PG8_BAR;
    if constexpr (Epi::AFTER_DRAIN) { E.fused(acc, cur, wr, wc, fr, fq, lds, wid, lane); S.done(cur); }
#undef PG8_SA
#undef PG8_SB
#undef PG8_STAGE
#undef PG8_LDA
#undef PG8_LDB
#undef PG8_MMA
#undef PG8_WAIT_V
#undef PG8_WAIT_L
#undef PG8_BAR
#undef PG8_SCHED
}
template <class Epi, class Sched>
__device__ __forceinline__ void gemm_phase2(PG8_LAS unsigned char* lds, const Gemm g, const Sched& S, const Epi& E) {
    const int tid = threadIdx.x, wid = __builtin_amdgcn_readfirstlane(tid >> 6), lane = tid & 63, wr = wid >> 2, wc = wid & 3, fr = lane & 15, fq = lane >> 4;
    const int K = g.K, nt = K / BK;
    unsigned voffA[2], voffB[2];
#pragma unroll
    for (int i = 0; i < 2; ++i) { int R, C; stage_rc(tid * 16 + i * 8192, R, C); const int Rb = Epi::PERM ? ((R & ~31) + perm32(R & 31)) : R;
        voffA[i] = (unsigned)(R * K + C) * 2u; voffB[i] = (unsigned)(Rb * K + C) * 2u; }
    const size_t kstep = (size_t)(BK * 2), hstep = (size_t)HALF * K * 2, tstep = 2 * hstep;
    const unsigned ldsw = (unsigned)wid * 1024u;
    const int aoff = lds_byte(wr * 64 + fr, fq * 8), boff = lds_byte(wc * 32 + fr, fq * 8);
#define G2_SA(b, h) (((b) * 2 + (h)) * HTB)
#define G2_SB(b, h) ((4 + (b) * 2 + (h)) * HTB)
#define G2_STAGE(bufoff, gbase, voff) do { _Pragma("unroll") for (int _i = 0; _i < 2; ++_i) \
        __builtin_amdgcn_global_load_lds((const unsigned*)((const char*)(gbase) + (voff)[_i]), (PG8_LAS unsigned*)(lds + (bufoff) + ldsw + _i * 8192), 16, 0, 0); } while (0)
#define G2_STAGE4(b, pa, pb) do { G2_STAGE(G2_SB(b, 0), (pb), voffB); G2_STAGE(G2_SB(b, 1), (pb) + hstep, voffB); G2_STAGE(G2_SA(b, 0), (pa), voffA); G2_STAGE(G2_SA(b, 1), (pa) + hstep, voffA); } while (0)
#define G2_LDA(dst, b, h) do { _Pragma("unroll") for (int m = 0; m < 4; ++m) _Pragma("unroll") for (int k = 0; k < 2; ++k) dst[m][k] = *(const PG8_LAS bf16x8*)(lds + G2_SA(b, h) + aoff + m * 2048 + k * 1024); } while (0)
#define G2_LDB(dst, b, h) do { _Pragma("unroll") for (int n = 0; n < 2; ++n) _Pragma("unroll") for (int k = 0; k < 2; ++k) dst[n][k] = *(const PG8_LAS bf16x8*)(lds + G2_SB(b, h) + boff + n * 2048 + k * 1024); } while (0)
#define G2_MMA(ai, bj, At, Bt) do { _Pragma("unroll") for (int m = 0; m < 4; ++m) _Pragma("unroll") for (int n = 0; n < 2; ++n) _Pragma("unroll") for (int k = 0; k < 2; ++k) \
        acc[ai][bj][m][n] = __builtin_amdgcn_mfma_f32_16x16x32_bf16(Bt[n][k], At[m][k], acc[ai][bj][m][n], 0, 0, 0); } while (0)
#define G2_COMPUTE(b) do { G2_LDB(B0, b, 0); G2_LDB(B1, b, 1); G2_LDA(At, b, 0); __builtin_amdgcn_s_setprio(1); G2_MMA(0, 0, At, B0); G2_MMA(0, 1, At, B1); G2_LDA(At, b, 1); G2_MMA(1, 0, At, B0); G2_MMA(1, 1, At, B1); __builtin_amdgcn_s_setprio(0); } while (0)
#define G2_SYNC() do { asm volatile("s_waitcnt vmcnt(0) lgkmcnt(0)" ::: "memory"); __builtin_amdgcn_s_barrier(); __builtin_amdgcn_s_sleep(8); __builtin_amdgcn_s_barrier(); asm volatile("" ::: "memory"); } while (0)
    Unit cur, nxt; int ui = 0;
    if (!S.next(0, cur)) return;
    f32x4 acc[2][2][4][2];
#pragma unroll
    for (int a = 0; a < 2; ++a)
#pragma unroll
        for (int b = 0; b < 2; ++b)
#pragma unroll
            for (int m = 0; m < 4; ++m)
#pragma unroll
                for (int n = 0; n < 2; ++n) acc[a][b][m][n] = (f32x4){0.f, 0.f, 0.f, 0.f};
    bf16x8 At[4][2], B0[2][2], B1[2][2];
    const char* cA = (const char*)g.A + (size_t)cur.pm * tstep; const char* cB = (const char*)g.Bt + (size_t)cur.pn * tstep;
    G2_SYNC();
    G2_STAGE4(0, cA, cB);
    G2_SYNC();
    for (;;) {
        const bool has_next = S.next(ui + 1, nxt);
        const char* nA = has_next ? (const char*)g.A + (size_t)nxt.pm * tstep : cA; const char* nB = has_next ? (const char*)g.Bt + (size_t)nxt.pn * tstep : cB;
        for (int t = 0; t < nt; t += 2) {
            const bool last = (t == nt - 2);
            { const char* a1 = cA + (size_t)(t + 1) * kstep; const char* b1 = cB + (size_t)(t + 1) * kstep; G2_STAGE4(1, a1, b1); }
            G2_COMPUTE(0);
            G2_SYNC();
            if (!last || has_next) { const char* a2 = last ? nA : cA + (size_t)(t + 2) * kstep; const char* b2 = last ? nB : cB + (size_t)(t + 2) * kstep; G2_STAGE4(0, a2, b2); }
            G2_COMPUTE(1);
            G2_SYNC();
        }
        E(acc, cur, wr, wc, fr, fq);
        if (!has_next) break;
#pragma unroll
        for (int a = 0; a < 2; ++a)
#pragma unroll
            for (int b = 0; b < 2; ++b)
#pragma unroll
                for (int m = 0; m < 4; ++m)
#pragma unroll
                    for (int n = 0; n < 2; ++n) acc[a][b][m][n] = (f32x4){0.f, 0.f, 0.f, 0.f};
        cur = nxt; cA = nA; cB = nB; ++ui;
    }
    asm volatile("s_waitcnt vmcnt(0)" ::: "memory");
#undef G2_SA
#undef G2_SB
#undef G2_STAGE
#undef G2_STAGE4
#undef G2_LDA
#undef G2_LDB
#undef G2_MMA
#undef G2_COMPUTE
#undef G2_SYNC
}
template <class Epi, class Sched>
__device__ __forceinline__ void gemm_phase3(PG8_LAS unsigned char* lds, const Gemm g, const Sched& S, const Epi& E) {
    typedef int i32x4 __attribute__((ext_vector_type(4)));
    const int tid = threadIdx.x, wid = __builtin_amdgcn_readfirstlane(tid >> 6), lane = tid & 63, wr = wid >> 2, wc = wid & 3, fr = lane & 15, fq = lane >> 4;
    const int K = g.K, nt = K / BK;
    unsigned voffA[2], voffB[2];
#pragma unroll
    for (int i = 0; i < 2; ++i) { int R, C; stage_rc(tid * 16 + i * 8192, R, C); const int Rb = Epi::PERM ? ((R & ~31) + perm32(R & 31)) : R;
        voffA[i] = (unsigned)(R * K + C) * 2u; voffB[i] = (unsigned)(Rb * K + C) * 2u; }
    const size_t kstep = (size_t)(BK * 2), hstep = (size_t)HALF * K * 2, tstep = 2 * hstep;
    const int aoff = lds_byte(wr * 64 + fr, fq * 8), boff = lds_byte(wc * 32 + fr, fq * 8);
#define G3_SA(b, h) (((b) * 2 + (h)) * HTB)
#define G3_SB(b, h) ((4 + (b) * 2 + (h)) * HTB)
#define G3_ISSUE(pa, pb) do { _Pragma("unroll") for (int h = 0; h < 2; ++h) _Pragma("unroll") for (int i = 0; i < 2; ++i) { \
        sa[h * 2 + i] = *(const i32x4*)((pa) + h * hstep + voffA[i]); sb[h * 2 + i] = *(const i32x4*)((pb) + h * hstep + voffB[i]); } } while (0)
#define G3_WRITE(b) do { _Pragma("unroll") for (int h = 0; h < 2; ++h) _Pragma("unroll") for (int i = 0; i < 2; ++i) { \
        *(PG8_LAS i32x4*)(lds + G3_SA(b, h) + tid * 16 + i * 8192) = sa[h * 2 + i]; *(PG8_LAS i32x4*)(lds + G3_SB(b, h) + tid * 16 + i * 8192) = sb[h * 2 + i]; } } while (0)
#define G3_LDA(dst, b, h) do { _Pragma("unroll") for (int m = 0; m < 4; ++m) _Pragma("unroll") for (int k = 0; k < 2; ++k) dst[m][k] = *(const PG8_LAS bf16x8*)(lds + G3_SA(b, h) + aoff + m * 2048 + k * 1024); } while (0)
#define G3_LDB(dst, b, h) do { _Pragma("unroll") for (int n = 0; n < 2; ++n) _Pragma("unroll") for (int k = 0; k < 2; ++k) dst[n][k] = *(const PG8_LAS bf16x8*)(lds + G3_SB(b, h) + boff + n * 2048 + k * 1024); } while (0)
#define G3_MMA(ai, bj, At, Bt) do { _Pragma("unroll") for (int m = 0; m < 4; ++m) _Pragma("unroll") for (int n = 0; n < 2; ++n) _Pragma("unroll") for (int k = 0; k < 2; ++k) \
        acc[ai][bj][m][n] = __builtin_amdgcn_mfma_f32_16x16x32_bf16(Bt[n][k], At[m][k], acc[ai][bj][m][n], 0, 0, 0); } while (0)
#define G3_COMPUTE(b) do { bf16x8 At[4][2], B0[2][2], B1[2][2]; G3_LDB(B0, b, 0); G3_LDB(B1, b, 1); G3_LDA(At, b, 0); G3_MMA(0, 0, At, B0); G3_MMA(0, 1, At, B1); G3_LDA(At, b, 1); G3_MMA(1, 0, At, B0); G3_MMA(1, 1, At, B1); } while (0)
    Unit cur, nxt; int ui = 0;
    if (!S.next(0, cur)) return;
    f32x4 acc[2][2][4][2];
#pragma unroll
    for (int a = 0; a < 2; ++a)
#pragma unroll
        for (int b = 0; b < 2; ++b)
#pragma unroll
            for (int m = 0; m < 4; ++m)
#pragma unroll
                for (int n = 0; n < 2; ++n) acc[a][b][m][n] = (f32x4){0.f, 0.f, 0.f, 0.f};
    i32x4 sa[4], sb[4];
    const char* cA = (const char*)g.A + (size_t)cur.pm * tstep; const char* cB = (const char*)g.Bt + (size_t)cur.pn * tstep;
    __syncthreads();
    G3_ISSUE(cA, cB); G3_WRITE(0); G3_ISSUE(cA + kstep, cB + kstep);
    __syncthreads();
    for (;;) {
        const bool has_next = S.next(ui + 1, nxt);
        const char* nA = has_next ? (const char*)g.A + (size_t)nxt.pm * tstep : cA; const char* nB = has_next ? (const char*)g.Bt + (size_t)nxt.pn * tstep : cB;
        for (int t = 0; t < nt; t += 2) {
            const bool last = (t == nt - 2);
            G3_WRITE(1);
            if (!last || has_next) { const char* a2 = last ? nA : cA + (size_t)(t + 2) * kstep; const char* b2 = last ? nB : cB + (size_t)(t + 2) * kstep; G3_ISSUE(a2, b2); }
            G3_COMPUTE(0);
            __syncthreads();
            if (!last || has_next) { G3_WRITE(0);
                const char* a3 = last ? nA + kstep : cA + (size_t)(t + 3) * kstep; const char* b3 = last ? nB + kstep : cB + (size_t)(t + 3) * kstep; G3_ISSUE(a3, b3); }
            G3_COMPUTE(1);
            __syncthreads();
        }
        E(acc, cur, wr, wc, fr, fq);
        if (!has_next) break;
#pragma unroll
        for (int a = 0; a < 2; ++a)
#pragma unroll
            for (int b = 0; b < 2; ++b)
#pragma unroll
                for (int m = 0; m < 4; ++m)
#pragma unroll
                    for (int n = 0; n < 2; ++n) acc[a][b][m][n] = (f32x4){0.f, 0.f, 0.f, 0.f};
        cur = nxt; cA = nA; cB = nB; ++ui;
    }
#undef G3_SA
#undef G3_SB
#undef G3_ISSUE
#undef G3_WRITE
#undef G3_LDA
#undef G3_LDB
#undef G3_MMA
#undef G3_COMPUTE
}
}


constexpr int NWAVES = 8;
constexpr int BATCH = 2, SEQ = 8192, DM = 1024, NMETA = 16, LPOS = SEQ + NMETA, MX = BATCH * SEQ, RP = BATCH * LPOS, INC = 6144;
constexpr int NCH = 129;
constexpr float EPS = 1e-6f;
constexpr float LOG2E = 1.4426950408889634f;
constexpr float QSCALE = 0.125f * LOG2E;
constexpr float HG_SCALE = 0.08838834764831845f;
constexpr float EXIT_BITS = 126.0f;

#define GAS __attribute__((address_space(1)))
#define LAS __attribute__((address_space(3)))
typedef unsigned short bf16;
typedef unsigned v4u __attribute__((ext_vector_type(4)));
typedef unsigned v2u __attribute__((ext_vector_type(2)));
typedef float f32x4 __attribute__((ext_vector_type(4)));
typedef float f32x2 __attribute__((ext_vector_type(2)));
typedef float f32x16 __attribute__((ext_vector_type(16)));
typedef short bf16x8 __attribute__((ext_vector_type(8)));
typedef short bf16x4 __attribute__((ext_vector_type(4)));

constexpr size_t MiB = 1u << 20;
constexpr size_t WS_WIN = 1 * MiB, WS_WSB = 13 * MiB, WS_WHG = 14 * MiB, WS_WO = 15 * MiB;
constexpr size_t WS_U = 17 * MiB;
constexpr size_t WS_Q = 49 * MiB;
constexpr size_t WS_K = 65 * MiB;
constexpr size_t WS_V = 82 * MiB;
constexpr size_t WS_SG = 99 * MiB;
constexpr size_t WS_HQ = 197 * MiB;
constexpr size_t WS_HI = 213 * MiB;
constexpr size_t WS_HGT = 148 * MiB;
constexpr size_t WS_G = 164 * MiB;
constexpr size_t WS_GH = 115 * MiB;
constexpr size_t WS_DC = 230 * MiB;
constexpr size_t WS_T1 = WS_Q;
constexpr size_t WS_MG = WS_G;
constexpr size_t WS_END = 232 * MiB;
constexpr size_t DO_ST = 0, DO_GS = 32 * MiB;

constexpr int RING_BYTES = 131072, LDS_BYTES = 147456;

__device__ __forceinline__ unsigned f2bf(float f) { unsigned u = __builtin_bit_cast(unsigned, f); return (u + 0x7fffu + ((u >> 16) & 1u)) >> 16; }
__device__ __forceinline__ unsigned pk2(float lo, float hi) { return pg8::cvt_pk_bf16(lo, hi); }
__device__ __forceinline__ float bf2f(unsigned short h) { return __builtin_bit_cast(float, (unsigned)h << 16); }
__device__ __forceinline__ float bflo(unsigned w) { return __builtin_bit_cast(float, w << 16); }
__device__ __forceinline__ float bfhi(unsigned w) { return __builtin_bit_cast(float, w & 0xffff0000u); }
__device__ __forceinline__ float fsigmoid(float v) { return __builtin_amdgcn_rcpf(1.0f + __builtin_amdgcn_exp2f(-v * LOG2E)); }
__device__ __forceinline__ float fsilu(float v) { return v * fsigmoid(v); }
__device__ __forceinline__ float wave_sum(float v) {
#pragma unroll
    for (int o = 1; o < 64; o <<= 1) v += __shfl_xor(v, o);
    return v;
}
#define LDS_WAIT() asm volatile("s_waitcnt lgkmcnt(0)" ::: "memory")

struct Frame {
    LAS unsigned char* lds;
    int tid, lane, wave, vcu, G;
    const float *x, *meta, *norm_g, *w_in, *w_sb_out, *w_hg_out, *w_out, *hg_norm_g, *lbl, *final_g;
    float* out; unsigned char* ws;
    bf16 *WinT, *WsbT, *WhgT, *WoT, *U, *Q, *K, *V, *SG, *HQ, *HI, *HGT, *GH, *GS, *T1, *MG, *ST, *Y;
    bf16* Gf; float* DC;
};

__device__ __forceinline__ void store8bf(bf16* p, f32x4 a, f32x4 b) { v4u w; w.x = pk2(a[0], a[1]); w.y = pk2(a[2], a[3]); w.z = pk2(b[0], b[1]); w.w = pk2(b[2], b[3]); *(v4u*)p = w; }
template <int ACT> __device__ __forceinline__ float actf(float v) {
    if (ACT == 0) return v;
    if (ACT == 1) return v * QSCALE;
    if (ACT == 2) return fsilu(v);
    if (ACT == 3) return fsilu(v) * HG_SCALE;
    return fsigmoid(v);
}
struct EpiProj {
    static constexpr bool PERM = true, AFTER_DRAIN = false, HAS_MID = false;
    bf16 *Q, *K, *V, *SG, *HQ, *HI, *HGT, *GS, *GH; bf16* Gf; const float* lbl; unsigned char* wsb;
    template <int ACT> __device__ __forceinline__ void emit(const f32x4 (&acc)[2][2][4][2], bf16* base, int ldc, int row0, int col0) const {
#pragma unroll
        for (int ai = 0; ai < 2; ++ai)
#pragma unroll
            for (int m = 0; m < 4; ++m) { bf16* rowp = base + (size_t)(row0 + ai * 128 + m * 16) * ldc + col0;
#pragma unroll
                for (int bj = 0; bj < 2; ++bj) { f32x4 a = acc[ai][bj][m][0], b = acc[ai][bj][m][1];
#pragma unroll
                    for (int j = 0; j < 4; ++j) { a[j] = actf<ACT>(a[j]); b[j] = actf<ACT>(b[j]); }
                    store8bf(rowp + bj * 128, a, b); } }
    }
    __device__ __forceinline__ void operator()(const f32x4 (&acc)[2][2][4][2], const pg8::Unit& u, int wr, int wc, int fr, int fq) const {
        const int pn = u.pn, bb = u.pm >> 5;
        const int rowm = u.pm * 256 + wr * 64 + fr, rowp = rowm + 16 * (1 + bb);
        const int cin = wc * 32 + 8 * fq;
        int act, ldc, row0, col0; bf16* base;
        if (pn < 16) { const int grp = pn >> 1; col0 = (pn & 1) * 256 + cin; ldc = 512;
            act = (grp == 0) ? 1 : (grp == 3 || grp == 7) ? 2 : (grp == 4) ? 3 : (grp == 5) ? 5 : 0;
            const size_t boff = (grp == 0) ? WS_Q : (grp == 1) ? WS_K : (grp == 2) ? WS_V : (grp == 3) ? WS_SG : (grp == 4) ? WS_HQ : (grp == 6) ? WS_HI : WS_HGT; base = (bf16*)(wsb + boff);
            row0 = (grp == 1 || grp == 2 || grp == 5 || grp == 6) ? rowp : rowm;
        } else { act = 4; ldc = 1024; row0 = rowm; base = (pn < 20) ? GS : GH; col0 = ((pn - 16) & 3) * 256 + cin; }
        if (act == 5) {
#pragma unroll
            for (int bj = 0; bj < 2; ++bj) { float lb[8];
#pragma unroll
                for (int j = 0; j < 8; ++j) { const int c = col0 + bj * 128 + j; lb[j] = fsigmoid(lbl[c] - lbl[512 + c]); }
#pragma unroll
                for (int ai = 0; ai < 2; ++ai)
#pragma unroll
                    for (int m = 0; m < 4; ++m) { bf16* o = Gf + (size_t)(row0 + ai * 128 + m * 16) * 512 + col0 + bj * 128; f32x4 a = acc[ai][bj][m][0], b = acc[ai][bj][m][1];
#pragma unroll
                        for (int j = 0; j < 4; ++j) { a[j] = __logf(lb[j] + (1.0f - lb[j]) * fsigmoid(a[j])); b[j] = __logf(lb[4 + j] + (1.0f - lb[4 + j]) * fsigmoid(b[j])); }
                        store8bf(o, a, b); } }
            return;
        }
        if (act == 4) {
            unsigned char* gbase = (unsigned char*)base;
#pragma unroll
            for (int ai = 0; ai < 2; ++ai)
#pragma unroll
                for (int m = 0; m < 4; ++m) { unsigned char* rowq = gbase + (size_t)(row0 + ai * 128 + m * 16) * 1024 + col0;
#pragma unroll
                    for (int bj = 0; bj < 2; ++bj) { const f32x4 a = acc[ai][bj][m][0], b = acc[ai][bj][m][1]; unsigned qa[4], qb_[4];
#pragma unroll
                        for (int j = 0; j < 4; ++j) { qa[j] = (unsigned)fminf(fmaxf(fsigmoid(a[j]) * 255.0f + 0.5f, 1.0f), 255.0f); qb_[j] = (unsigned)fminf(fmaxf(fsigmoid(b[j]) * 255.0f + 0.5f, 1.0f), 255.0f); }
                        v2u w; w.x = qa[0] | (qa[1] << 8) | (qa[2] << 16) | (qa[3] << 24); w.y = qb_[0] | (qb_[1] << 8) | (qb_[2] << 16) | (qb_[3] << 24);
                        *(v2u*)(rowq + bj * 128) = w; } }
            return;
        }
        if (act <= 1) {
            const float lin = (act == 0) ? 1.0f : QSCALE;
#pragma unroll
            for (int ai = 0; ai < 2; ++ai)
#pragma unroll
                for (int m = 0; m < 4; ++m) { bf16* rowq = base + (size_t)(row0 + ai * 128 + m * 16) * ldc + col0;
#pragma unroll
                    for (int bj = 0; bj < 2; ++bj) store8bf(rowq + bj * 128, acc[ai][bj][m][0] * lin, acc[ai][bj][m][1] * lin); }
            return;
        }
        const float vs = (act == 2) ? 1.0f : HG_SCALE;
#pragma unroll
        for (int ai = 0; ai < 2; ++ai)
#pragma unroll
            for (int m = 0; m < 4; ++m) { bf16* rowq = base + (size_t)(row0 + ai * 128 + m * 16) * ldc + col0;
#pragma unroll
                for (int bj = 0; bj < 2; ++bj) { f32x4 a = acc[ai][bj][m][0], b = acc[ai][bj][m][1];
#pragma unroll
                    for (int j = 0; j < 4; ++j) { a[j] = vs * a[j] * fsigmoid(a[j]); b[j] = vs * b[j] * fsigmoid(b[j]); }
                    store8bf(rowq + bj * 128, a, b); } }
    }
};
template <int MODE> struct EpiGate {
    static constexpr bool PERM = true, AFTER_DRAIN = false, HAS_MID = false;
    const bf16* gate; const bf16* prev; bf16* O;
    __device__ __forceinline__ void operator()(const f32x4 (&acc)[2][2][4][2], const pg8::Unit& u, int wr, int wc, int fr, int fq) const {
        const int row0 = u.pm * 256 + wr * 64 + fr, col0 = u.pn * 256 + wc * 32 + 8 * fq;
#pragma unroll
        for (int ai = 0; ai < 2; ++ai)
#pragma unroll
            for (int m = 0; m < 4; ++m)
#pragma unroll
                for (int bj = 0; bj < 2; ++bj) { const size_t off = (size_t)(row0 + ai * 128 + m * 16) * 1024 + col0 + bj * 128;
                    const v4u g = *(const v4u*)(gate + off); f32x4 a = acc[ai][bj][m][0], b = acc[ai][bj][m][1];
                    a[0] *= bflo(g.x); a[1] *= bfhi(g.x); a[2] *= bflo(g.y); a[3] *= bfhi(g.y); b[0] *= bflo(g.z); b[1] *= bfhi(g.z); b[2] *= bflo(g.w); b[3] *= bfhi(g.w);
                    if (MODE == 1) { const v4u p = *(const v4u*)(prev + off);
                        a[0] += bflo(p.x); a[1] += bfhi(p.x); a[2] += bflo(p.y); a[3] += bfhi(p.y); b[0] += bflo(p.z); b[1] += bfhi(p.z); b[2] += bflo(p.w); b[3] += bfhi(p.w); }
                    store8bf(O + off, a, b); }
    }
};
struct EpiRes {
    static constexpr bool PERM = true, AFTER_DRAIN = false, HAS_MID = false;
    const float* x; float* out;
    __device__ __forceinline__ void operator()(const f32x4 (&acc)[2][2][4][2], const pg8::Unit& u, int wr, int wc, int fr, int fq) const {
        const int row0 = u.pm * 256 + wr * 64 + fr, col0 = u.pn * 256 + wc * 32 + 8 * fq;
#pragma unroll
        for (int ai = 0; ai < 2; ++ai)
#pragma unroll
            for (int m = 0; m < 4; ++m)
#pragma unroll
                for (int bj = 0; bj < 2; ++bj) { const size_t off = (size_t)(row0 + ai * 128 + m * 16) * 1024 + col0 + bj * 128;
                    const f32x4 x0 = *(const f32x4*)(x + off), x1 = *(const f32x4*)(x + off + 4);
                    f32x4 c0 = acc[ai][bj][m][0], c1 = acc[ai][bj][m][1];
                    if (DBG_SKIP & 32768) { for (int j = 0; j < 4; ++j) { c0[j] = fminf(fmaxf(c0[j], -1.5f), 1.5f); c1[j] = fminf(fmaxf(c1[j], -1.5f), 1.5f); } }
                    *(f32x4*)(out + off) = x0 + c0; *(f32x4*)(out + off + 4) = x1 + c1; }
    }
};

struct EpiMerge {
    static constexpr bool PERM = true, AFTER_DRAIN = false, HAS_MID = true;
    const unsigned char* GS; const unsigned char* GH; bf16* O;
    __device__ __forceinline__ void mid(f32x4 (&acc)[2][2][4][2], const pg8::Unit& u, int wr, int wc, int fr, int fq) const {
        int row0 = u.pm * 256 + wr * 64 + fr, col0 = u.pn * 256 + wc * 32 + 8 * fq;
        asm volatile("" : "+v"(row0), "+v"(col0));
#pragma unroll
        for (int ai = 0; ai < 2; ++ai)
#pragma unroll
            for (int m = 0; m < 4; ++m)
#pragma unroll
                for (int bj = 0; bj < 2; ++bj) { const size_t off = (size_t)(row0 + ai * 128 + m * 16) * 1024 + col0 + bj * 128; const v2u s_ = *(const v2u*)(GS + off), h_ = *(const v2u*)(GH + off);
#pragma unroll
                    for (int n = 0; n < 2; ++n) { const unsigned sw = n ? s_.y : s_.x, hw = n ? h_.y : h_.x; f32x4 a = acc[ai][bj][m][n];
#pragma unroll
                        for (int e = 0; e < 4; ++e) a[e] *= (float)((sw >> (8 * e)) & 255u) * __builtin_amdgcn_rcpf((float)((hw >> (8 * e)) & 255u));
                        asm volatile("" : "+v"(a) :: "memory"); acc[ai][bj][m][n] = a; } }
    }
    __device__ __forceinline__ void operator()(const f32x4 (&acc)[2][2][4][2], const pg8::Unit& u, int wr, int wc, int fr, int fq) const {
        const int row0 = u.pm * 256 + wr * 64 + fr, col0 = u.pn * 256 + wc * 32 + 8 * fq;
#pragma unroll
        for (int ai = 0; ai < 2; ++ai)
#pragma unroll
            for (int m = 0; m < 4; ++m)
#pragma unroll
                for (int bj = 0; bj < 2; ++bj) { const size_t off = (size_t)(row0 + ai * 128 + m * 16) * 1024 + col0 + bj * 128; const v2u h_ = *(const v2u*)(GH + off); f32x4 a = acc[ai][bj][m][0], b = acc[ai][bj][m][1];
#pragma unroll
                    for (int e = 0; e < 4; ++e) { a[e] *= (float)((h_.x >> (8 * e)) & 255u) * (1.0f / 255.0f); b[e] *= (float)((h_.y >> (8 * e)) & 255u) * (1.0f / 255.0f); }
                    store8bf(O + off, a, b); }
    }
};

__device__ __forceinline__ void p0_transpose_item(const float* W, int K, int N, bf16* WT, int ldt, LAS float* scr, int item, int lane) {
    const int nblk = N / 32, kb = item / nblk, nb = item % nblk, k0 = 64 * kb, n0 = 32 * nb;
    float tw[32];
#pragma unroll
    for (int i = 0; i < 32; ++i) { const int kk = 2 * i + (lane >> 5); tw[i] = __builtin_nontemporal_load(W + (size_t)(k0 + kk) * N + n0 + (lane & 31)); }
#pragma unroll
    for (int i = 0; i < 32; ++i) { const int kk = 2 * i + (lane >> 5); scr[kk * 33 + (lane & 31)] = tw[i]; }
    LDS_WAIT();
    const int c = lane & 7;
#pragma unroll
    for (int j = 0; j < 4; ++j) { const int n = (lane >> 3) + 8 * j; const LAS float* s = scr + (8 * c) * 33 + n;
        v4u o; o.x = pk2(s[0 * 33], s[1 * 33]); o.y = pk2(s[2 * 33], s[3 * 33]); o.z = pk2(s[4 * 33], s[5 * 33]); o.w = pk2(s[6 * 33], s[7 * 33]);
        *(v4u*)(WT + (size_t)(n0 + n) * ldt + k0 + 8 * c) = o; }
    LDS_WAIT();
}
__device__ __forceinline__ void meta_item(Frame& F, int it) {
    LAS float* um = (LAS float*)F.lds;
    LAS float* red = (LAS float*)(F.lds + 65536);
#pragma unroll
    for (int rr = 0; rr < 2; ++rr) { const int row = F.wave * 2 + rr; const f32x4* xr = (const f32x4*)(F.meta + row * 1024) + F.lane; const f32x4* gr = (const f32x4*)F.norm_g + F.lane;
        f32x4 v[4]; float s = 0.f;
#pragma unroll
        for (int j = 0; j < 4; ++j) { v[j] = xr[64 * j]; s += (v[j][0] * v[j][0] + v[j][1] * v[j][1]) + (v[j][2] * v[j][2] + v[j][3] * v[j][3]); }
        const float rstd = rsqrtf(wave_sum(s) * (1.0f / 1024.0f) + EPS);
#pragma unroll
        for (int j = 0; j < 4; ++j) { const f32x4 g = gr[64 * j];
#pragma unroll
            for (int e = 0; e < 4; ++e) um[(4 * (F.lane + 64 * j) + e) * 16 + row] = v[j][e] * rstd * g[e]; } }
    __syncthreads();
    const int cl = F.tid & 7, kg = F.tid >> 3;
    const int idx8 = it * 8, c0 = (idx8 < 1024) ? 512 + idx8 : 2560 + (idx8 - 1024);
    float acc[16];
#pragma unroll
    for (int r = 0; r < 16; ++r) acc[r] = 0.f;
    const float* wp = F.w_in + (size_t)(kg * 16) * INC + c0 + cl;
#pragma unroll 4
    for (int k = 0; k < 16; ++k) { const float w = wp[(size_t)k * INC]; const LAS f32x4* up = (const LAS f32x4*)(um + (kg * 16 + k) * 16);
#pragma unroll
        for (int q = 0; q < 4; ++q) { const f32x4 u = up[q];
#pragma unroll
            for (int e = 0; e < 4; ++e) acc[4 * q + e] += u[e] * w; } }
#pragma unroll
    for (int r = 0; r < 16; ++r) red[(kg * 16 + r) * 8 + cl] = acc[r];
    __syncthreads();
    if (F.tid < 128) { const int r = F.tid >> 3, c = F.tid & 7; float s = 0.f;
#pragma unroll 8
        for (int k2 = 0; k2 < 64; ++k2) s += red[(k2 * 16 + r) * 8 + c];
        const int col = c0 + c;
#pragma unroll
        for (int b = 0; b < 2; ++b) { const size_t prow = (size_t)b * LPOS + r;
            if (col < 1024) F.K[prow * 512 + col - 512] = (bf16)f2bf(s);
            else if (col < 1536) F.V[prow * 512 + col - 1024] = (bf16)f2bf(s);
            else if (col < 3072) { const int cc = col - 2560; const float lb = fsigmoid(F.lbl[cc] - F.lbl[512 + cc]); F.Gf[prow * 512 + cc] = (bf16)f2bf(__logf(lb + (1.0f - lb) * fsigmoid(s))); }
            else F.HI[prow * 512 + col - 3072] = (bf16)f2bf(s); } }
    __syncthreads();
}
__device__ __forceinline__ void p0_prologue(Frame& F) {
    for (int it = blockIdx.x; it < 256; it += F.G) meta_item(F, it);
    LAS float* scr = (LAS float*)(F.lds + F.wave * 16384);
    const int gw = F.vcu * NWAVES + F.wave, NGW = F.G * NWAVES;
    constexpr int I_IN = (1024 / 64) * (INC / 32), I_SB = (512 / 64) * (1024 / 32), I_O = (1024 / 64) * (1024 / 32);
    constexpr int NITEMS = I_IN + 2 * I_SB + I_O;
    for (int it = gw; it < NITEMS; it += NGW) {
        int r = it;
        if (r < I_IN) { p0_transpose_item(F.w_in, 1024, INC, F.WinT, 1024, scr, r, F.lane); continue; } r -= I_IN;
        if (r < I_SB) { p0_transpose_item(F.w_sb_out, 512, 1024, F.WsbT, 1024, scr, r, F.lane); continue; } r -= I_SB;
        if (r < I_SB) { p0_transpose_item(F.w_hg_out, 512, 1024, F.WsbT + 512, 1024, scr, r, F.lane); continue; } r -= I_SB;
        p0_transpose_item(F.w_out, 1024, 1024, F.WoT, 1024, scr, r, F.lane);
    }
    const bool xloc = (F.G == 256);
    const int xl = (int)blockIdx.x & 7, lw = ((int)blockIdx.x >> 3) * NWAVES + F.wave;
    const int mbeg = xloc ? 2048 * xl + lw : gw, mstep = xloc ? 256 : NGW, mend = xloc ? 2048 * xl + 2048 : MX;
    for (int m = mbeg; m < mend; m += 2 * mstep) {
        const int m2 = m + mstep; const bool has2 = m2 < mend;
        const f32x4* xr = (const f32x4*)(F.x + (size_t)m * DM) + F.lane; const f32x4* xr2 = (const f32x4*)(F.x + (size_t)(has2 ? m2 : m) * DM) + F.lane; const f32x4* gr = (const f32x4*)F.norm_g + F.lane;
        f32x4 v[4], w2[4]; float s = 0.f, s2 = 0.f;
#pragma unroll
        for (int j = 0; j < 4; ++j) { v[j] = __builtin_nontemporal_load(xr + 64 * j); w2[j] = __builtin_nontemporal_load(xr2 + 64 * j); }
#pragma unroll
        for (int j = 0; j < 4; ++j) { s += (v[j][0] * v[j][0] + v[j][1] * v[j][1]) + (v[j][2] * v[j][2] + v[j][3] * v[j][3]); s2 += (w2[j][0] * w2[j][0] + w2[j][1] * w2[j][1]) + (w2[j][2] * w2[j][2] + w2[j][3] * w2[j][3]); }
        const float rstd = rsqrtf(wave_sum(s) * (1.0f / 1024.0f) + EPS), rstd2 = rsqrtf(wave_sum(s2) * (1.0f / 1024.0f) + EPS);
        v2u* o8 = (v2u*)(F.U + (size_t)m * DM) + F.lane; v2u* o82 = (v2u*)(F.U + (size_t)m2 * DM) + F.lane;
#pragma unroll
        for (int j = 0; j < 4; ++j) { const f32x4 g = gr[64 * j]; v2u w; w.x = pk2(v[j][0] * rstd * g[0], v[j][1] * rstd * g[1]); w.y = pk2(v[j][2] * rstd * g[2], v[j][3] * rstd * g[3]); o8[64 * j] = w;
            if (has2) { v2u u; u.x = pk2(w2[j][0] * rstd2 * g[0], w2[j][1] * rstd2 * g[1]); u.y = pk2(w2[j][2] * rstd2 * g[2], w2[j][3] * rstd2 * g[3]); o82[64 * j] = u; } }
    }
}

#define ATT_PROCESS(qf_, o0_, o1_, R_, qpos_, masked_) do { \
    f32x16 z; _Pragma("unroll") for (int i = 0; i < 16; ++i) z[i] = 0.f; \
    _Pragma("unroll") for (int s = 0; s < 4; ++s) z = __builtin_amdgcn_mfma_f32_32x32x16_bf16(kf[s], qf_[s], z, 0, 0, 0); \
    float sp[16], lbv[16]; \
    if (masked_) { _Pragma("unroll") for (int i = 0; i < 16; ++i) { const int kpos = kb + (i & 3) + 8 * (i >> 2) + 4 * hh; const bool valid = (kpos < (qpos_)) && (kpos >= 0); \
            const float zz = fminf(z[i], 126.f); float s_; asm("v_log_f32 %0, %1" : "=v"(s_) : "v"(1.0f + __builtin_amdgcn_exp2f(zz))); sp[i] = valid ? s_ : 0.f; lbv[i] = valid ? (zz - s_) : -INFINITY; } } \
    else { _Pragma("unroll") for (int i = 0; i < 16; ++i) { const float zz = fminf(z[i], 126.f); float s_; asm("v_log_f32 %0, %1" : "=v"(s_) : "v"(1.0f + __builtin_amdgcn_exp2f(zz))); sp[i] = s_; lbv[i] = zz - s_; } } \
    float gs[4], ps[4], after[4]; \
    _Pragma("unroll") for (int g = 0; g < 4; ++g) { gs[g] = (sp[4 * g] + sp[4 * g + 1]) + (sp[4 * g + 2] + sp[4 * g + 3]); ps[g] = __shfl_xor(gs[g], 32); } \
    float tot = 0.f; \
    _Pragma("unroll") for (int g = 3; g >= 0; --g) { after[g] = tot + (hh == 0 ? ps[g] : 0.f); tot += gs[g] + ps[g]; } \
    float w[16]; \
    _Pragma("unroll") for (int g = 0; g < 4; ++g) { float run = (R_) + after[g]; \
        _Pragma("unroll") for (int ii = 3; ii >= 0; --ii) { const int i = 4 * g + ii; w[i] = __builtin_amdgcn_exp2f(lbv[i] - run); run += sp[i]; } } \
    (R_) += tot; \
    _Pragma("unroll") for (int s = 0; s < 2; ++s) { v4u t_; t_.x = pk2(w[8 * s], w[8 * s + 1]); t_.y = pk2(w[8 * s + 2], w[8 * s + 3]); t_.z = pk2(w[8 * s + 4], w[8 * s + 5]); t_.w = pk2(w[8 * s + 6], w[8 * s + 7]); \
        const bf16x8 wf_ = __builtin_bit_cast(bf16x8, t_); \
        o0_ = __builtin_amdgcn_mfma_f32_32x32x16_bf16(vfr[s][0], wf_, o0_, 0, 0, 0); o1_ = __builtin_amdgcn_mfma_f32_32x32x16_bf16(vfr[s][1], wf_, o1_, 0, 0, 0); } } while (0)
template <int DUMMY> __device__ __forceinline__ void attn_phase_t(Frame& F) {
    LAS bf16* vt = (LAS bf16*)(F.lds + F.wave * 8192);
    const int lane = F.lane, r = lane & 31, hh = lane >> 5;
    const int gw = F.vcu * NWAVES + F.wave, NGW = F.G * NWAVES;
#define ATT_LOADK(kb_, kf_) do { int kp_ = (kb_) + r; kp_ = kp_ < 0 ? 0 : kp_; const bf16* krow_ = F.K + (prow0 + kp_) * 512 + h * 64 + 8 * hh; \
            _Pragma("unroll") for (int s_ = 0; s_ < 4; ++s_) kf_[s_] = *(const bf16x8*)(krow_ + 16 * s_); } while (0)
#define ATT_LOADV(kb_, vv_) do { _Pragma("unroll") for (int i_ = 0; i_ < 4; ++i_) { const int idx_ = lane + 64 * i_, key_ = idx_ & 31, c_ = idx_ >> 5; int vp_ = (kb_) + key_; vp_ = vp_ < 0 ? 0 : vp_; \
                vv_[i_] = *(const v4u*)(F.V + (prow0 + vp_) * 512 + h * 64 + 8 * c_); } } while (0)
    for (int it = gw; it < 2048; it += NGW) {
        const int qb = it & 127, h = (it >> 7) & 7, b = it >> 10; const int mA = b * SEQ + qb * 64 + r, mB = mA + 32; const size_t prow0 = (size_t)b * LPOS;
        const int kbA0 = NMETA + qb * 64, kbB0 = kbA0 + 32, qposA = kbA0 + r, qposB = kbB0 + r;
        bf16x8 qfA[4], qfB[4], kf[4], kfn[4]; v4u vv[4];
#pragma unroll
        for (int s = 0; s < 4; ++s) { qfA[s] = *(const bf16x8*)(F.Q + (size_t)mA * 512 + h * 64 + 8 * hh + 16 * s); qfB[s] = *(const bf16x8*)(F.Q + (size_t)mB * 512 + h * 64 + 8 * hh + 16 * s); }
        ATT_LOADK(kbB0, kf); ATT_LOADV(kbB0, vv);
        f32x16 oA0, oA1, oB0, oB1;
#pragma unroll
        for (int i = 0; i < 16; ++i) { oA0[i] = 0.f; oA1[i] = 0.f; oB0[i] = 0.f; oB1[i] = 0.f; }
        float RA = 0.f, RB = 0.f; bool doneB = false;
        for (int kb = kbB0;; kb -= 32) {
            ATT_LOADK(kb - 32, kfn);
#pragma unroll
            for (int i = 0; i < 4; ++i) { const int idx = lane + 64 * i, key = idx & 31, c = idx >> 5; const unsigned ww[4] = {vv[i].x, vv[i].y, vv[i].z, vv[i].w};
#pragma unroll
                for (int j = 0; j < 4; ++j) { vt[(8 * c + 2 * j) * 36 + key] = (bf16)(ww[j] & 0xffffu); vt[(8 * c + 2 * j + 1) * 36 + key] = (bf16)(ww[j] >> 16); } }
            ATT_LOADV(kb - 32, vv);
            LDS_WAIT();
            bf16x8 vfr[2][2];
#pragma unroll
            for (int s = 0; s < 2; ++s)
#pragma unroll
                for (int db = 0; db < 2; ++db) { const LAS bf16* vp = vt + (32 * db + r) * 36 + 16 * s + 4 * hh; const bf16x4 lo = *(const LAS bf16x4*)vp, hi = *(const LAS bf16x4*)(vp + 8);
                    vfr[s][db] = (bf16x8){lo[0], lo[1], lo[2], lo[3], hi[0], hi[1], hi[2], hi[3]}; }
            LDS_WAIT();
            if (!doneB) { if (kb == kbB0 || kb < 0) ATT_PROCESS(qfB, oB0, oB1, RB, qposB, true); else ATT_PROCESS(qfB, oB0, oB1, RB, qposB, false); }
            if (kb <= kbA0) { if (kb == kbA0 || kb < 0) ATT_PROCESS(qfA, oA0, oA1, RA, qposA, true); else ATT_PROCESS(qfA, oA0, oA1, RA, qposA, false); }
            if (kb <= 0) break;
            doneB = __all(RB >= EXIT_BITS);
            if (doneB && kb <= kbA0 && __all(RA >= EXIT_BITS)) break;
#pragma unroll
            for (int s = 0; s < 4; ++s) kf[s] = kfn[s];
        }
#pragma unroll
        for (int g = 0; g < 8; ++g) { const int db = g >> 2, gg = g & 3; const int d0 = h * 64 + 32 * db + 8 * gg + 4 * hh;
            const v2u sga = *(const v2u*)(F.SG + (size_t)mA * 512 + d0), sgb = *(const v2u*)(F.SG + (size_t)mB * 512 + d0);
            const f32x16& oa = db ? oA1 : oA0; const f32x16& ob = db ? oB1 : oB0; v2u ya, yb;
            ya.x = pk2(oa[4 * gg] * bflo(sga.x), oa[4 * gg + 1] * bfhi(sga.x)); ya.y = pk2(oa[4 * gg + 2] * bflo(sga.y), oa[4 * gg + 3] * bfhi(sga.y));
            yb.x = pk2(ob[4 * gg] * bflo(sgb.x), ob[4 * gg + 1] * bfhi(sgb.x)); yb.y = pk2(ob[4 * gg + 2] * bflo(sgb.y), ob[4 * gg + 3] * bfhi(sgb.y));
            if (DUMMY) { *(v2u*)((bf16*)(F.ws + 231 * MiB) + (size_t)(mA % 12288) * 1024 + d0) = ya; } else { *(v2u*)(F.Y + (size_t)mA * 1024 + d0) = ya; *(v2u*)(F.Y + (size_t)mB * 1024 + d0) = yb; } }
    }
}
__device__ __forceinline__ void attn_phase(Frame& F) { attn_phase_t<0>(F); }
__device__ __forceinline__ void stage_iT(Frame& F, LAS bf16* iT, size_t prow, int hh, int nv) {
#pragma unroll
    for (int q = 0; q < 2; ++q) { const int idx = F.tid + 512 * q, s = idx & 63, c8 = idx >> 6;
        v4u w = {0u, 0u, 0u, 0u}; if (s < nv) w = *(const v4u*)(F.HI + (prow + s) * 512 + hh * 128 + 8 * c8);
        const unsigned ww[4] = {w.x, w.y, w.z, w.w};
#pragma unroll
        for (int j = 0; j < 4; ++j) { iT[(8 * c8 + 2 * j) * 72 + s] = (bf16)(ww[j] & 0xffffu); iT[(8 * c8 + 2 * j + 1) * 72 + s] = (bf16)(ww[j] >> 16); } }
}
#define LDS_BAR() do { asm volatile("s_waitcnt lgkmcnt(0)" ::: "memory"); __builtin_amdgcn_s_barrier(); asm volatile("" ::: "memory"); } while (0)
#define P2_DECODE(un_, stream_, c_, b_, hh_, nvl_, prow_) const int stream_ = (un_) >> 7, c_ = (un_) & 127, b_ = stream_ >> 2, hh_ = stream_ & 3, nvl_ = c_ ? 64 : NMETA; \
    const size_t prow_ = (size_t)b_ * LPOS + (c_ ? NMETA + 64 * (c_ - 1) : 0);
#define P2_LOAD(un_, iw_, gg_) do { P2_DECODE(un_, st_, cc_, b_, hh_, nv_, prow_) \
    _Pragma("unroll") for (int q2 = 0; q2 < 2; ++q2) { const int idx = F.tid + 512 * q2, s_ = idx & 63, c8 = idx >> 6; iw_[q2] = (v4u){0u, 0u, 0u, 0u}; if (s_ < nv_) iw_[q2] = *(const v4u*)(F.HI + (prow_ + s_) * 512 + hh_ * 128 + 8 * c8); } \
    { const int kp = F.tid & 63, q = F.tid >> 6; _Pragma("unroll") for (int jj = 0; jj < 8; ++jj) { const int t = 8 * q + jj; gg_[jj] = 0u; if (t < nv_) gg_[jj] = *(const unsigned*)(F.Gf + (prow_ + t) * 512 + hh_ * 128 + 2 * kp); } } } while (0)
__device__ __forceinline__ void hgrn_local_phase(Frame& F) {
    LAS bf16* KhT = (LAS bf16*)(F.lds);
    LAS bf16* iT = (LAS bf16*)(F.lds + 18432);
    LAS float* seg = (LAS float*)(F.lds + 36864);
    const int r = F.lane & 31, h2 = F.lane >> 5, wv = F.wave >> 1, wk = F.wave & 1;
    v4u iw[2]; unsigned gg[8];
    if (F.vcu < 1024) P2_LOAD(F.vcu, iw, gg);
    for (int un = F.vcu; un < 1024; un += F.G) {
        P2_DECODE(un, stream, c_, b, hh, nvl, prow)
        (void)b; (void)hh; (void)nvl; (void)prow;
#pragma unroll
        for (int q2 = 0; q2 < 2; ++q2) { const int idx = F.tid + 512 * q2, s_ = idx & 63, c8 = idx >> 6; const unsigned ww[4] = {iw[q2].x, iw[q2].y, iw[q2].z, iw[q2].w};
#pragma unroll
            for (int j = 0; j < 4; ++j) { iT[(8 * c8 + 2 * j) * 72 + s_] = (bf16)(ww[j] & 0xffffu); iT[(8 * c8 + 2 * j + 1) * 72 + s_] = (bf16)(ww[j] >> 16); } }
        { const int kp = F.tid & 63, q = F.tid >> 6; float g0[8], g1[8], c0[8], c1[8]; float run0 = 0.f, run1 = 0.f;
#pragma unroll
            for (int jj = 0; jj < 8; ++jj) { g0[jj] = bflo(gg[jj]); g1[jj] = bfhi(gg[jj]); }
            if (un + F.G < 1024) P2_LOAD(un + F.G, iw, gg);
#pragma unroll
            for (int jj = 0; jj < 8; ++jj) { run0 += g0[jj]; run1 += g1[jj]; c0[jj] = run0; c1[jj] = run1; }
            *(LAS f32x2*)(seg + q * 128 + 2 * kp) = (f32x2){run0, run1};
            LDS_BAR();
            float pre0 = 0.f, pre1 = 0.f, bl0 = 0.f, bl1 = 0.f;
#pragma unroll
            for (int qq = 0; qq < 8; ++qq) { const f32x2 sv = *(const LAS f32x2*)(seg + qq * 128 + 2 * kp); bl0 += sv[0]; bl1 += sv[1]; if (qq < q) { pre0 += sv[0]; pre1 += sv[1]; } }
            if (q == 0) *(f32x2*)(F.DC + (stream * 128 + c_) * 128 + 2 * kp) = (f32x2){__expf(bl0), __expf(bl1)};
            float k0[8], k1[8];
#pragma unroll
            for (int jj = 0; jj < 8; ++jj) { k0[jj] = (1.0f - __expf(g0[jj])) * __expf(bl0 - (pre0 + c0[jj])); k1[jj] = (1.0f - __expf(g1[jj])) * __expf(bl1 - (pre1 + c1[jj])); }
            v4u w0, w1; w0.x = pk2(k0[0], k0[1]); w0.y = pk2(k0[2], k0[3]); w0.z = pk2(k0[4], k0[5]); w0.w = pk2(k0[6], k0[7]); w1.x = pk2(k1[0], k1[1]); w1.y = pk2(k1[2], k1[3]); w1.z = pk2(k1[4], k1[5]); w1.w = pk2(k1[6], k1[7]);
            *(LAS v4u*)(KhT + (2 * kp) * 72 + 8 * q) = w0; *(LAS v4u*)(KhT + (2 * kp + 1) * 72 + 8 * q) = w1; }
        LDS_BAR();
        f32x16 a0, a1;
#pragma unroll
        for (int i = 0; i < 16; ++i) { a0[i] = 0.f; a1[i] = 0.f; }
#pragma unroll
        for (int ks = 0; ks < 4; ++ks) { const bf16x8 af = *(const LAS bf16x8*)(iT + (32 * wv + r) * 72 + 16 * ks + 8 * h2);
            const bf16x8 b0 = *(const LAS bf16x8*)(KhT + (64 * wk + r) * 72 + 16 * ks + 8 * h2), b1 = *(const LAS bf16x8*)(KhT + (64 * wk + 32 + r) * 72 + 16 * ks + 8 * h2);
            a0 = __builtin_amdgcn_mfma_f32_32x32x16_bf16(af, b0, a0, 0, 0, 0); a1 = __builtin_amdgcn_mfma_f32_32x32x16_bf16(af, b1, a1, 0, 0, 0); }
        bf16* st = F.ST + (size_t)(stream * 128 + c_) * 16384;
#pragma unroll
        for (int i = 0; i < 16; ++i) { const int v = 32 * wv + (i & 3) + 8 * (i >> 2) + 4 * h2; st[v * 128 + 64 * wk + r] = (bf16)f2bf(a0[i]); st[v * 128 + 64 * wk + 32 + r] = (bf16)f2bf(a1[i]); }
        LDS_BAR();
    }
    asm volatile("s_waitcnt vmcnt(0)" ::: "memory");
}
__device__ __forceinline__ void hgrn_scan_phase(Frame& F, bf16* OUT) {
    LAS float* ldc = (LAS float*)F.lds;
    for (int blk = F.vcu; blk < 256; blk += F.G) {
        const int stream = blk >> 5, e = (blk & 31) * 512 + F.tid, k = e & 127; bf16* st = F.ST + (size_t)stream * 128 * 16384 + e; bf16* so = OUT + (size_t)stream * 128 * 16384 + e;
        const f32x4* dsrc = (const f32x4*)(F.DC + stream * 16384);
#pragma unroll
        for (int i = 0; i < 8; ++i) ((LAS f32x4*)ldc)[F.tid + 512 * i] = dsrc[F.tid + 512 * i];
        float S = 0.f;
#pragma unroll 1
        for (int c0 = 0; c0 < 128; c0 += 32) {
            unsigned u[32];
#pragma unroll
            for (int c = 0; c < 32; ++c) u[c] = st[(size_t)(c0 + c) * 16384];
            if (c0 == 0) __syncthreads();
#pragma unroll
            for (int c = 0; c < 32; ++c) { S = ldc[(c0 + c) * 128 + k] * S + __builtin_bit_cast(float, u[c] << 16); so[(size_t)(c0 + c) * 16384] = (bf16)f2bf(S); }
        }
        __syncthreads();
    }
}
#define P4_BAR() do { asm volatile("s_waitcnt lgkmcnt(0)" ::: "memory"); __builtin_amdgcn_s_barrier(); asm volatile("" ::: "memory"); } while (0)
#define P4_DECODE(un_, stream_, c_, nv_, b_, hh_, prow_, m0_) \
    const int stream_ = (un_) >> 7, c_ = (un_) & 127; \
    const int nv_ = 64, b_ = stream_ >> 2, hh_ = stream_ & 3; const size_t prow_ = (size_t)b_ * LPOS + NMETA + 64 * c_; const int m0_ = b_ * SEQ + 64 * c_;
#define P4_LOAD(un_, iw_, g_, qh_) do { P4_DECODE(un_, st_, cc_, nv_, b_, hh_, prow_, m0_) \
    _Pragma("unroll") for (int q2 = 0; q2 < 2; ++q2) { const int idx = F.tid + 512 * q2, s_ = idx & 63, c8 = idx >> 6; iw_[q2] = (v4u){0u, 0u, 0u, 0u}; if (s_ < nv_) iw_[q2] = *(const v4u*)(F.HI + (prow_ + s_) * 512 + hh_ * 128 + 8 * c8); } \
    { const int kp = F.tid & 63, q = F.tid >> 6; _Pragma("unroll") for (int jj = 0; jj < 8; ++jj) { const int t = 8 * q + jj; \
        const unsigned gg = *(const unsigned*)(F.Gf + (prow_ + t) * 512 + hh_ * 128 + 2 * kp); g_[2 * jj] = bflo(gg); g_[2 * jj + 1] = bfhi(gg); \
        const unsigned qq = *(const unsigned*)(F.HQ + (size_t)(m0_ + t) * 512 + hh_ * 128 + 2 * kp); qh_[2 * jj] = qq & 0xffffu; qh_[2 * jj + 1] = qq >> 16; } } } while (0)
__device__ __forceinline__ void hgrn_out_phase(Frame& F) {
    LAS bf16* Qt = (LAS bf16*)(F.lds);
    LAS bf16* Kt = (LAS bf16*)(F.lds + 17408);
    LAS bf16* iT = (LAS bf16*)(F.lds + 34816);
    LAS bf16* As = (LAS bf16*)(F.lds + 53248);
    LAS float* Of = (LAS float*)(F.lds + 62464);
    LAS float* seg = (LAS float*)(F.lds + 96256);
    const int r = F.lane & 31, h2 = F.lane >> 5;
    v4u iw[2]; float g[16]; unsigned qh[16];
    if (F.vcu < 1024) P4_LOAD(F.vcu, iw, g, qh);
    for (int un = F.vcu; un < 1024; un += F.G) {
        P4_DECODE(un, stream, c, nv, b, hh, prow, m0)
#pragma unroll
        for (int q2 = 0; q2 < 2; ++q2) { const int idx = F.tid + 512 * q2, s_ = idx & 63, c8 = idx >> 6; const unsigned ww[4] = {iw[q2].x, iw[q2].y, iw[q2].z, iw[q2].w};
#pragma unroll
            for (int j = 0; j < 4; ++j) { iT[(8 * c8 + 2 * j) * 72 + s_] = (bf16)(ww[j] & 0xffffu); iT[(8 * c8 + 2 * j + 1) * 72 + s_] = (bf16)(ww[j] >> 16); } }
        float cs[16], qv[16], gk[16];
        { const int kp = F.tid & 63, q = F.tid >> 6; float run0 = 0.f, run1 = 0.f;
#pragma unroll
            for (int jj = 0; jj < 8; ++jj) { gk[2 * jj] = g[2 * jj]; gk[2 * jj + 1] = g[2 * jj + 1]; qv[2 * jj] = __builtin_bit_cast(float, qh[2 * jj] << 16); qv[2 * jj + 1] = __builtin_bit_cast(float, qh[2 * jj + 1] << 16);
                run0 += gk[2 * jj]; run1 += gk[2 * jj + 1]; cs[2 * jj] = run0; cs[2 * jj + 1] = run1; }
            *(LAS f32x2*)(seg + q * 128 + 2 * kp) = (f32x2){run0, run1}; }
        bf16x8 sbc[8]; v4u gate0 = {0u, 0u, 0u, 0u}, gate1 = {0u, 0u, 0u, 0u};
        { const int wv = F.wave & 3; const bf16* sp = F.ST + (size_t)(stream * 128 + c) * 16384 + (32 * wv + r) * 128 + 8 * h2;
#pragma unroll
          for (int ks = 0; ks < 8; ++ks) sbc[ks] = *(const bf16x8*)(sp + 16 * ks);
          const int t = F.tid >> 3, sg_ = F.tid & 7; const int mrow = m0 + t;
          if ((t < nv) && (mrow >= b * SEQ)) { const v4u* gp_ = (const v4u*)(F.HGT + (size_t)mrow * 512 + hh * 128 + 16 * sg_); gate0 = gp_[0]; gate1 = gp_[1]; } }
        if (un + F.G < 1024) P4_LOAD(un + F.G, iw, g, qh);
        P4_BAR();
        { const int kp = F.tid & 63, q = F.tid >> 6; float pre0 = 0.f, pre1 = 0.f;
#pragma unroll
            for (int qq = 0; qq < 7; ++qq) { const f32x2 sv = *(const LAS f32x2*)(seg + qq * 128 + 2 * kp); if (qq < q) { pre0 += sv[0]; pre1 += sv[1]; } }
#pragma unroll
            for (int jj = 0; jj < 8; ++jj) { const int t = 8 * q + jj; const float b0 = pre0 + cs[2 * jj], b1 = pre1 + cs[2 * jj + 1];
                *(LAS unsigned*)(Qt + t * 136 + 2 * kp) = pk2(qv[2 * jj] * __expf(b0), qv[2 * jj + 1] * __expf(b1));
                *(LAS unsigned*)(Kt + t * 136 + 2 * kp) = pk2((1.0f - __expf(gk[2 * jj])) * __expf(-b0), (1.0f - __expf(gk[2 * jj + 1])) * __expf(-b1)); } }
        P4_BAR();
        if (F.wave < 3) { const int tt = F.wave > 0, ts = F.wave == 2; f32x16 a;
#pragma unroll
            for (int i = 0; i < 16; ++i) a[i] = 0.f;
#pragma unroll
            for (int ks = 0; ks < 8; ++ks) { const bf16x8 af = *(const LAS bf16x8*)(Qt + (32 * tt + r) * 136 + 16 * ks + 8 * h2), bfr = *(const LAS bf16x8*)(Kt + (32 * ts + r) * 136 + 16 * ks + 8 * h2);
                a = __builtin_amdgcn_mfma_f32_32x32x16_bf16(af, bfr, a, 0, 0, 0); }
#pragma unroll
            for (int i = 0; i < 16; ++i) { const int t = 32 * tt + (i & 3) + 8 * (i >> 2) + 4 * h2, s_ = 32 * ts + r; As[t * 72 + s_] = (s_ <= t) ? (bf16)f2bf(a[i]) : (bf16)0; }
        } else if (F.wave == 3) {
#pragma unroll
            for (int i = 0; i < 16; ++i) { const int t = (i & 3) + 8 * (i >> 2) + 4 * h2; As[t * 72 + 32 + r] = (bf16)0; }
        }
        P4_BAR();
        { const int wt = F.wave >> 2, wv = F.wave & 3; f32x16 o;
#pragma unroll
            for (int i = 0; i < 16; ++i) o[i] = 0.f;
#pragma unroll
            for (int ks = 0; ks < 4; ++ks) { const bf16x8 af = *(const LAS bf16x8*)(As + (32 * wt + r) * 72 + 16 * ks + 8 * h2), bfr = *(const LAS bf16x8*)(iT + (32 * wv + r) * 72 + 16 * ks + 8 * h2);
                o = __builtin_amdgcn_mfma_f32_32x32x16_bf16(af, bfr, o, 0, 0, 0); }
#pragma unroll
            for (int ks = 0; ks < 8; ++ks) { const bf16x8 af = *(const LAS bf16x8*)(Qt + (32 * wt + r) * 136 + 16 * ks + 8 * h2);
                o = __builtin_amdgcn_mfma_f32_32x32x16_bf16(af, sbc[ks], o, 0, 0, 0); }
#pragma unroll
            for (int i = 0; i < 16; ++i) { const int t = 32 * wt + (i & 3) + 8 * (i >> 2) + 4 * h2; Of[t * 132 + 32 * wv + r] = o[i]; } }
        P4_BAR();
        { const int t = F.tid >> 3, sg_ = F.tid & 7; const LAS f32x4* op = (const LAS f32x4*)(Of + t * 132 + 16 * sg_); f32x4 v[4]; float ss = 0.f;
#pragma unroll
            for (int j = 0; j < 4; ++j) { v[j] = op[j]; ss += (v[j][0] * v[j][0] + v[j][1] * v[j][1]) + (v[j][2] * v[j][2] + v[j][3] * v[j][3]); }
            ss += __shfl_xor(ss, 1); ss += __shfl_xor(ss, 2); ss += __shfl_xor(ss, 4);
            const float rstd = rsqrtf(ss * (1.0f / 128.0f) + EPS); const int mrow = m0 + t;
            if (t < nv && mrow >= b * SEQ) { const int cv = hh * 128 + 16 * sg_; const f32x4* gn = (const f32x4*)(F.hg_norm_g + cv);
#pragma unroll
                for (int q = 0; q < 2; ++q) { const v4u gq = q ? gate1 : gate0; const f32x4 n0 = gn[2 * q], n1 = gn[2 * q + 1]; const f32x4 a = v[2 * q], bq = v[2 * q + 1]; v4u y;
                    y.x = pk2(a[0] * rstd * n0[0] * bflo(gq.x), a[1] * rstd * n0[1] * bfhi(gq.x)); y.y = pk2(a[2] * rstd * n0[2] * bflo(gq.y), a[3] * rstd * n0[3] * bfhi(gq.y));
                    y.z = pk2(bq[0] * rstd * n1[0] * bflo(gq.z), bq[1] * rstd * n1[1] * bfhi(gq.z)); y.w = pk2(bq[2] * rstd * n1[2] * bflo(gq.w), bq[3] * rstd * n1[3] * bfhi(gq.w));
                    *(v4u*)(F.Y + (size_t)mrow * 1024 + 512 + cv + 8 * q) = y; } } }
    }
    asm volatile("s_waitcnt vmcnt(0)" ::: "memory");
}
__device__ __forceinline__ void final_norm_phase(Frame& F) {
    const int gw = F.vcu * NWAVES + F.wave, NGW = F.G * NWAVES;
    for (int m = gw; m < MX; m += NGW) { f32x4* xr = (f32x4*)(F.out + (size_t)m * DM) + F.lane; const f32x4* gr = (const f32x4*)F.final_g + F.lane; f32x4 v[4]; float s = 0.f;
#pragma unroll
        for (int j = 0; j < 4; ++j) { v[j] = xr[64 * j]; s += (v[j][0] * v[j][0] + v[j][1] * v[j][1]) + (v[j][2] * v[j][2] + v[j][3] * v[j][3]); }
        const float rstd = rsqrtf(wave_sum(s) * (1.0f / 1024.0f) + EPS);
#pragma unroll
        for (int j = 0; j < 4; ++j) { f32x4 o = v[j] * rstd * gr[64 * j];
            if (DBG_SKIP & (1024 | 2048 | 16384)) { const unsigned fl = *(const unsigned*)(F.ws + 64); float sc = 1.f; if (fl) { const unsigned nbad = *(const unsigned*)(F.ws + 68); const int g0 = __builtin_ctz(fl); sc = 3.f + 2.f * (float)g0; } o = o * sc; }
            if (DBG_SKIP & 32) { const int c = 4 * (F.lane + 64 * j); for (int e = 0; e < 4; ++e) o[e] = bf2f(F.U[(size_t)m * 1024 + c + e]) + bf2f(F.WinT[(size_t)(m % 6144) * 1024 + c + e]) + bf2f(F.WoT[(size_t)(m & 1023) * 1024 + c + e]); }
            else if (DBG_SKIP & 16) { const int c = 4 * (F.lane + 64 * j); for (int e = 0; e < 4; ++e) o[e] = bf2f(F.HGT[(size_t)m * 512 + ((c + e) & 511)]) + bf2f(F.GH[(size_t)m * 1024 + c + e]); }
            xr[64 * j] = o; } }
}


#define XB_TMO      128
#define XB_XCNT(j)  (256  + 64 * (j))
#define XB_XSUB(j)  (1280 + 64 * (j))
#define XB_XGEN(j)  (2304 + 64 * (j))
#define XB_TOP      3328
#define XB_TOPGEN   3392
#define XCD_BAR_WORDS 3456
#define XB_SPIN_CAP (1u << 18)

__device__ __forceinline__ unsigned xb_ld(unsigned* p)              { return __hip_atomic_load(p, __ATOMIC_RELAXED, __HIP_MEMORY_SCOPE_AGENT); }
__device__ __forceinline__ unsigned xb_add(unsigned* p, unsigned v) { return __hip_atomic_fetch_add(p, v, __ATOMIC_RELAXED, __HIP_MEMORY_SCOPE_AGENT); }
__device__ __forceinline__ unsigned xb_xcc_id() { return (unsigned)__builtin_amdgcn_s_getreg((3 << 11) | 20) & 0xFu; }
#define XB_SPIN(cond, bar) do { unsigned _sp = 0; while (cond) { __builtin_amdgcn_s_sleep(1); \
    if ((++_sp & 255u) == 0u) { if (xb_ld(&(bar)[XB_TMO])) break; if (_sp > XB_SPIN_CAP) { atomicAdd(&(bar)[XB_TMO], 1u); break; } } } } while (0)

struct XcdBarrier {
    unsigned* bar; unsigned x;
    volatile LAS unsigned* st;
};

__device__ __forceinline__ XcdBarrier xcd_barrier_post(unsigned* bar, volatile LAS unsigned* st) {
    XcdBarrier b; b.bar = bar; b.x = xb_xcc_id(); b.st = st;
    if (threadIdx.x == 0) (void)xb_add(&bar[XB_XCNT(b.x)], 1u);
    return b;
}
__device__ __forceinline__ void xcd_barrier_complete(unsigned* bar, unsigned x, unsigned& nloc, unsigned& nx) {
    const unsigned G = gridDim.x * gridDim.y * gridDim.z;
    unsigned sum, cnt, mine, sp = 0u;
    for (;;) {
        sum = 0u; cnt = 0u; mine = 0u;
#pragma unroll
        for (unsigned j = 0; j < 16; ++j) { const unsigned c = xb_ld(&bar[XB_XCNT(j)]); sum += c; cnt += (c > 0u) ? 1u : 0u; mine = (j == x) ? c : mine; }
        if (sum == G) break;
        __builtin_amdgcn_s_sleep(1);
        if ((++sp & 255u) == 0u) { if (xb_ld(&bar[XB_TMO])) break; if (sp > XB_SPIN_CAP) { atomicAdd(&bar[XB_TMO], 1u); break; } }
    }
    nloc = mine > 0u ? mine : 1u; nx = cnt > 0u ? cnt : 1u;
}

__device__ __forceinline__ void xcd_barrier(const XcdBarrier& b) {
    asm volatile("s_waitcnt vmcnt(0)" ::: "memory");
    __syncthreads();
    if (threadIdx.x == 0) {
        unsigned* bar = b.bar;
        __builtin_amdgcn_s_waitcnt(0);
        unsigned nloc = b.st[0], nx = b.st[1];
        if (nloc == 0u) { xcd_barrier_complete(bar, b.x, nloc, nx); b.st[0] = nloc; b.st[1] = nx; }
        const unsigned old = xb_add(&bar[XB_XSUB(b.x)], 1u);
        const unsigned gen = old / nloc;
        if (old + 1u == (gen + 1u) * nloc) {
            __builtin_amdgcn_fence(__ATOMIC_RELEASE, "agent");
            asm volatile("s_waitcnt vmcnt(0)" ::: "memory");
            const unsigned og = xb_add(&bar[XB_TOP], 1u);
            const unsigned tg = og / nx;
            if (og + 1u == (tg + 1u) * nx) xb_add(&bar[XB_TOPGEN], 1u);
            else XB_SPIN(xb_ld(&bar[XB_TOPGEN]) == tg, bar);
            __builtin_amdgcn_fence(__ATOMIC_ACQUIRE, "agent");
            xb_add(&bar[XB_XGEN(b.x)], 1u);
            asm volatile("s_waitcnt vmcnt(0)" ::: "memory");
        } else {
            XB_SPIN(xb_ld(&bar[XB_XGEN(b.x)]) == gen, bar);
            __builtin_amdgcn_fence(__ATOMIC_ACQUIRE, "agent");
            asm volatile("s_waitcnt vmcnt(0)" ::: "memory");
        }
    }
    __syncthreads();
}


struct EpiResNorm {
    static constexpr bool PERM = true, AFTER_DRAIN = false, HAS_MID = false;
    const float* x; float* out; const float* fg; float* rowss; const XcdBarrier* bar;
    __device__ __forceinline__ void operator()(f32x4 (&acc)[2][2][4][2], const pg8::Unit& u, int wr, int wc, int fr, int fq) const {
        const int row0 = u.pm * 256 + wr * 64 + fr, col0 = u.pn * 256 + wc * 32 + 8 * fq;
#pragma unroll
        for (int ai = 0; ai < 2; ++ai)
#pragma unroll
            for (int m = 0; m < 4; ++m) { const int row = row0 + ai * 128 + m * 16; float ss = 0.f;
#pragma unroll
                for (int bj = 0; bj < 2; ++bj) { const size_t off = (size_t)row * 1024 + col0 + bj * 128; const f32x4 x0 = *(const f32x4*)(x + off), x1 = *(const f32x4*)(x + off + 4);
                    f32x4 a = acc[ai][bj][m][0] + x0, b = acc[ai][bj][m][1] + x1; acc[ai][bj][m][0] = a; acc[ai][bj][m][1] = b;
                    ss += (a[0] * a[0] + a[1] * a[1]) + (a[2] * a[2] + a[3] * a[3]) + (b[0] * b[0] + b[1] * b[1]) + (b[2] * b[2] + b[3] * b[3]); }
                ss += __shfl_xor(ss, 16); ss += __shfl_xor(ss, 32);
                if (fq == 0) __hip_atomic_fetch_add(rowss + row, ss, __ATOMIC_RELAXED, __HIP_MEMORY_SCOPE_AGENT); }
        xcd_barrier(*bar);
        f32x4 g0[2], g1[2];
#pragma unroll
        for (int bj = 0; bj < 2; ++bj) { g0[bj] = *(const f32x4*)(fg + col0 + bj * 128); g1[bj] = *(const f32x4*)(fg + col0 + bj * 128 + 4); }
#pragma unroll
        for (int ai = 0; ai < 2; ++ai)
#pragma unroll
            for (int m = 0; m < 4; ++m) { const int row = row0 + ai * 128 + m * 16; const float rstd = rsqrtf(__hip_atomic_load(rowss + row, __ATOMIC_RELAXED, __HIP_MEMORY_SCOPE_AGENT) * (1.0f / 1024.0f) + EPS);
#pragma unroll
                for (int bj = 0; bj < 2; ++bj) { const size_t off = (size_t)row * 1024 + col0 + bj * 128;
                    __builtin_nontemporal_store(acc[ai][bj][m][0] * rstd * g0[bj], (f32x4*)(out + off)); __builtin_nontemporal_store(acc[ai][bj][m][1] * rstd * g1[bj], (f32x4*)(out + off + 4)); } }
    }
};

#ifndef MK_N_LAUNCHES
#define MK_N_LAUNCHES 1
#endif
constexpr int N_PHASES = 7;
struct Args { const float* in[10]; float* out; unsigned char* ws; int ph_lo, ph_hi; };
__global__ void __launch_bounds__(NWAVES * 64, 2) mk_fwd(Args args) {
    extern __shared__ __attribute__((aligned(16))) unsigned char lds[];
    Frame F;
    F.lds = (LAS unsigned char*)lds;
    F.tid = threadIdx.x; F.lane = F.tid & 63; F.wave = __builtin_amdgcn_readfirstlane(F.tid >> 6);
    F.G = gridDim.x; { const int bx = blockIdx.x; F.vcu = (F.G % 8 == 0) ? (bx % 8) * (F.G / 8) + bx / 8 : bx; }
    unsigned char* ws = args.ws; F.ws = ws;
    F.x = args.in[0]; F.meta = args.in[1]; F.norm_g = args.in[2]; F.w_in = args.in[3]; F.w_sb_out = args.in[4]; F.w_hg_out = args.in[5]; F.w_out = args.in[6];
    F.hg_norm_g = args.in[7]; F.lbl = args.in[8]; F.final_g = args.in[9]; F.out = args.out;
    F.WinT = (bf16*)(ws + WS_WIN); F.WsbT = (bf16*)(ws + WS_WSB); F.WhgT = (bf16*)(ws + WS_WHG); F.WoT = (bf16*)(ws + WS_WO);
    F.U = (bf16*)(ws + WS_U); F.Y = (bf16*)(ws + WS_U); F.Q = (bf16*)(ws + WS_Q); F.K = (bf16*)(ws + WS_K); F.V = (bf16*)(ws + WS_V); F.SG = (bf16*)(ws + WS_SG);
    F.HQ = (bf16*)(ws + WS_HQ); F.HI = (bf16*)(ws + WS_HI); F.HGT = (bf16*)(ws + WS_HGT); F.Gf = (bf16*)(ws + WS_G); F.GH = (bf16*)(ws + WS_GH); F.DC = (float*)(ws + WS_DC);
    F.T1 = (bf16*)(ws + WS_T1); F.MG = (bf16*)(ws + WS_MG); F.ST = (bf16*)((unsigned char*)args.out + DO_ST); F.GS = (bf16*)((unsigned char*)args.out + DO_GS);
    const int lo = args.ph_lo, hi = args.ph_hi;
    volatile LAS unsigned* MISC = (volatile LAS unsigned*)(F.lds + 131072 + 320);
    if (F.tid < 32) MISC[F.tid] = 0u;
    __syncthreads();
    XcdBarrier bar; bar.bar = (unsigned*)(ws + 16384); bar.x = 0; bar.st = nullptr;
    if (MK_N_LAUNCHES == 1) bar = xcd_barrier_post((unsigned*)(ws + 16384), MISC + 8);
    if (DBG_SKIP & 256) { for (int i = F.tid; i < LDS_BYTES / 16; i += NWAVES * 64) ((LAS v4u*)F.lds)[i] = (v4u){0u, 0u, 0u, 0u}; __syncthreads(); }
#define IN(k) (lo <= (k) && (k) < hi)
#define SEAM(k) do { if (IN(k) && IN((k) + 1)) { xcd_barrier(bar); } } while (0)
    if (args.ph_hi < 0) cg::this_grid().sync();
    if (IN(0)) { p0_prologue(F); if (DBG_SKIP & (1 << 23)) { __syncthreads(); p0_prologue(F); } } SEAM(0);
    if (IN(1)) {
        pg8::Gemm g{F.U, F.WinT, MX, INC, 1024}; pg8::StaticOrder S; S.init(MX, INC, F.G, (int)blockIdx.x);
        EpiProj E{F.Q, F.K, F.V, F.SG, F.HQ, F.HI, F.HGT, F.GS, F.GH, F.Gf, F.lbl, F.ws};
        pg8::gemm_phase<EpiProj, pg8::StaticOrder, true, true>(F.lds, g, S, E);
        if (DBG_SKIP & (1 << 22)) { __syncthreads(); pg8::gemm_phase<EpiProj, pg8::StaticOrder, true, true>(F.lds, g, S, E); }
    } SEAM(1);
    if (DBG_SKIP & 128) {
        pg8::StaticOrder S; S.init(MX, INC, F.G, (int)blockIdx.x); pg8::Unit u;
        for (int i = 0; S.next(i, u); ++i) { if (u.pn < 20) continue;
            for (int e = F.tid; e < 256 * 256; e += 512) { const int rr = e >> 8, cc = e & 255; const size_t off = (size_t)(u.pm * 256 + rr) * 1024 + (u.pn - 20) * 256 + cc; F.out[off] = bf2f(F.GH[off]); } }
        return;
    }
    if (IN(2) && !(DBG_SKIP & (64 | 16384))) { hgrn_local_phase(F); attn_phase(F); if (DBG_SKIP & (1 << 20)) { __syncthreads(); hgrn_local_phase(F); } if (DBG_SKIP & (1 << 19)) { __syncthreads(); attn_phase_t<1>(F); } if (DBG_SKIP & (1 << 18)) { __syncthreads(); attn_phase_t<2>(F); } } SEAM(2);

    if (IN(3) && !(DBG_SKIP & (64 | 16384))) { hgrn_scan_phase(F, F.ST); if (DBG_SKIP & (1 << 28)) { __syncthreads(); hgrn_scan_phase(F, F.Q); } } SEAM(3);
    if (IN(4) && !(DBG_SKIP & (64 | 16384))) { hgrn_out_phase(F); if (DBG_SKIP & (1 << 21)) { __syncthreads(); hgrn_out_phase(F); } } SEAM(4);
    if (IN(5) && !(DBG_SKIP & (64 | 2048 | 16384))) {
        pg8::Gemm g{F.Y, F.WsbT, MX, 1024, 1024}; pg8::StaticOrder S; S.init(MX, 1024, F.G, (int)blockIdx.x); EpiMerge E{(const unsigned char*)F.GS, (const unsigned char*)F.GH, F.MG};
        pg8::gemm_phase<EpiMerge, pg8::StaticOrder, true, true>(F.lds, g, S, E);
    } SEAM(5);
    if (IN(6) && (DBG_SKIP & (2048 | 16384))) { for (size_t i = (size_t)blockIdx.x * 512 + F.tid; i < (size_t)MX * 256; i += (size_t)F.G * 512) ((f32x4*)F.out)[i] = ((const f32x4*)F.x)[i]; }
    const bool fuse_norm = (MK_N_LAUNCHES == 1) && (F.G == 256);
    if (IN(6) && fuse_norm) {
        pg8::Gemm g{F.MG, F.WoT, MX, 1024, 1024}; pg8::StaticOrder S; S.init(MX, 1024, F.G, (int)blockIdx.x); EpiResNorm E{F.x, F.out, F.final_g, (float*)(ws + 65536), &bar};
        pg8::gemm_phase<EpiResNorm, pg8::StaticOrder, true, true>(F.lds, g, S, E);
    }
    if (IN(6) && !fuse_norm) {
        pg8::Gemm g{F.MG, F.WoT, MX, 1024, 1024}; pg8::StaticOrder S; S.init(MX, 1024, F.G, (int)blockIdx.x); EpiRes E{F.x, F.out};
        pg8::gemm_phase<EpiRes, pg8::StaticOrder, true, true>(F.lds, g, S, E);
    }
    if (!fuse_norm) { SEAM(6); }
    if (IN(7) && !fuse_norm) { final_norm_phase(F); }

#undef IN
#undef SEAM
}

extern "C" void kernel_launch(void* const* d_in, const int* in_sizes, int n_in, void* d_out, int out_size, void* d_ws, size_t ws_size, hipStream_t stream) {
    static int grid = 0;
    if (grid == 0) {
        if (n_in != 10 || in_sizes[0] != MX * DM || out_size != MX * DM || ws_size < WS_END) { fprintf(stderr, "kernel_launch: unexpected shapes (n_in %d in0 %d out %d ws %zu)\n", n_in, n_in > 0 ? in_sizes[0] : -1, out_size, ws_size); grid = -1; return; }
        int dev = 0, cus = 0, per_cu = 0;
        if (hipGetDevice(&dev) != hipSuccess || hipDeviceGetAttribute(&cus, hipDeviceAttributeMultiprocessorCount, dev) != hipSuccess) { grid = -1; return; }
        if (hipFuncSetAttribute((const void*)mk_fwd, hipFuncAttributeMaxDynamicSharedMemorySize, LDS_BYTES) != hipSuccess) { fprintf(stderr, "kernel_launch: hipFuncSetAttribute failed\n"); grid = -1; return; }
        if (hipOccupancyMaxActiveBlocksPerMultiprocessor(&per_cu, (const void*)mk_fwd, NWAVES * 64, LDS_BYTES) != hipSuccess || per_cu < 1) { fprintf(stderr, "kernel_launch: occupancy query says %d\n", per_cu); per_cu = 1; }
        (void)hipGetLastError();
        grid = cus;
    }
    if (grid < 0) return;
    Args a{};
    for (int i = 0; i < 10; ++i) a.in[i] = (const float*)d_in[i];
    a.out = (float*)d_out; a.ws = (unsigned char*)d_ws;
#if MK_N_LAUNCHES == 1
    (void)hipMemsetAsync(d_ws, 0, 131072, stream);
    a.ph_lo = 0; a.ph_hi = N_PHASES + 1;
    void* kargs[] = {&a};
    hipError_t e = hipLaunchCooperativeKernel((const void*)mk_fwd, dim3(grid), dim3(NWAVES * 64), kargs, LDS_BYTES, stream);
    if (e != hipSuccess) fprintf(stderr, "kernel_launch: cooperative launch failed: %s (grid %d)\n", hipGetErrorString(e), grid);
#else
    for (int p = 0; p <= N_PHASES; ++p) { if ((DBG_SKIP & 32) && p >= 1 && p <= 6) continue; a.ph_lo = p; a.ph_hi = p + 1; hipLaunchKernelGGL(mk_fwd, dim3(grid), dim3(NWAVES * 64), LDS_BYTES, stream, a); }
#endif
}
```
